# Optimizing an MI355X kernel written in HIP

```python
import math
import jax, jax.numpy as jnp
from jax import lax
import numpy as np

D_MODEL = 1024
BATCH = 2
SEQ = 16384
DEPTH = 2

N_HEADS_ATTN = 8
HEAD_DIM = 64
N_KV_GROUPS = 2
HEADS_PER_GROUP = N_HEADS_ATTN // N_KV_GROUPS
D_ATTN = N_HEADS_ATTN * HEAD_DIM
D_KV = N_KV_GROUPS * HEAD_DIM
D_CONV = D_MODEL - D_ATTN
CONV_WIDTH = 3
CMP_BLOCK = 32
CMP_STRIDE = 16
CMP_OVERLAP = CMP_BLOCK // CMP_STRIDE
CMP_HIDDEN = 256
SEL_BLOCK = 64
SEL_RATIO = SEL_BLOCK // CMP_STRIDE
N_SELECT = 16
WINDOW = 512
Q_BLOCK = 128
ROPE_THETA = 500000.0
ROPE_DIM = HEAD_DIM // 4
D_FF = 2816
N_GATES = 3 * N_HEADS_ATTN
D_IN_PROJ = D_ATTN + 6 * D_KV + N_GATES + 3 * D_CONV
EPS = 1e-6
NEG_INF = -1e30
FORCE_SCORE = 1e9
MAX_POS_OFFSET = 1024
SCALE = 1.0 / math.sqrt(HEAD_DIM)

kernel_name = "hybrid_nsa_shortconv_macaron"


def rms_norm(x, g):
    xf = x.astype(jnp.float32)
    y = xf * lax.rsqrt(jnp.mean(xf * xf, axis=-1, keepdims=True) + EPS)
    return (y * g.astype(jnp.float32)).astype(x.dtype)


def swiglu(x, w_gate, w_up, w_down):
    return (jax.nn.silu(x @ w_gate) * (x @ w_up)) @ w_down


def partial_rope(x, positions):
    half = ROPE_DIM // 2
    inv_freq = ROPE_THETA ** (-jnp.arange(half, dtype=jnp.float32) * 2.0 / ROPE_DIM)
    ang = positions.astype(jnp.float32)[..., None] * inv_freq
    cos = jnp.cos(ang)[:, :, None, :]
    sin = jnp.sin(ang)[:, :, None, :]
    xf = x.astype(jnp.float32)
    x1, x2, rest = xf[..., :half], xf[..., half:ROPE_DIM], xf[..., ROPE_DIM:]
    out = jnp.concatenate([x1 * cos - x2 * sin, x2 * cos + x1 * sin, rest], axis=-1)
    return out.astype(x.dtype)


def compress_blocks(k, pe, w1, w2):
    B, S, G, dk = k.shape
    n_chunks = S // CMP_STRIDE
    n_cmp = n_chunks - CMP_OVERLAP + 1
    chunks = k.reshape(B, n_chunks, CMP_STRIDE, G, dk)
    blocks = jnp.concatenate([chunks[:, j:j + n_cmp] for j in range(CMP_OVERLAP)], axis=2)
    blocks = blocks + pe[None, None, :, None, :]
    flat = blocks.transpose(0, 1, 3, 2, 4).reshape(B, n_cmp, G, CMP_BLOCK * dk)
    return jax.nn.gelu(flat @ w1) @ w2


def nsa_group(q, k_cmp, v_cmp, k_slc, v_slc, k_win, v_win, gates, positions,
              pe_k, w1_k, w2_k, pe_v, w1_v, w2_v):
    B, S = q.shape[:2]
    H, G, HPG, dk = N_HEADS_ATTN, N_KV_GROUPS, HEADS_PER_GROUP, HEAD_DIM
    q_raw = q.reshape(B, S, H, dk)
    q_rot = partial_rope(q_raw, positions)
    k_slc = partial_rope(k_slc.reshape(B, S, G, dk), positions)
    v_slc = v_slc.reshape(B, S, G, dk)
    k_win = partial_rope(k_win.reshape(B, S, G, dk), positions)
    v_win = v_win.reshape(B, S, G, dk)
    kc = compress_blocks(k_cmp.reshape(B, S, G, dk), pe_k, w1_k, w2_k)
    vc = compress_blocks(v_cmp.reshape(B, S, G, dk), pe_v, w1_v, w2_v)
    n_cmp = kc.shape[1]
    cmp_end = jnp.arange(n_cmp) * CMP_STRIDE + CMP_BLOCK - 1
    n_sel = S // SEL_BLOCK
    k_top = min(N_SELECT, n_sel)
    kb = k_slc.reshape(B, n_sel, SEL_BLOCK, G, dk).transpose(0, 3, 1, 2, 4)
    vb = v_slc.reshape(B, n_sel, SEL_BLOCK, G, dk).transpose(0, 3, 1, 2, 4)
    kw = jnp.pad(k_win, ((0, 0), (WINDOW, 0), (0, 0), (0, 0)))
    vw = jnp.pad(v_win, ((0, 0), (WINDOW, 0), (0, 0), (0, 0)))
    g = jax.nn.sigmoid(gates.astype(jnp.float32)).reshape(B, S, H, 3)
    agg_w = [float(c) for c in np.convolve(np.ones(SEL_RATIO), np.ones(CMP_OVERLAP))]
    pad_front = CMP_OVERLAP - 1
    pad_back = SEL_RATIO * n_sel + len(agg_w) - 1 - SEL_RATIO - n_cmp - pad_front + 1
    b_idx = jnp.arange(B)[:, None, None, None]
    g_idx = jnp.arange(G)[None, :, None, None]
    blk_j = jnp.arange(n_sel)

    def one_block(qb):
        s0 = qb * Q_BLOCK
        t = s0 + jnp.arange(Q_BLOCK)
        qr = lax.dynamic_slice_in_dim(q_raw, s0, Q_BLOCK, axis=1).reshape(B, Q_BLOCK, G, HPG, dk)
        qs = lax.dynamic_slice_in_dim(q_rot, s0, Q_BLOCK, axis=1).reshape(B, Q_BLOCK, G, HPG, dk)
        gb = lax.dynamic_slice_in_dim(g, s0, Q_BLOCK, axis=1)
        sc = jnp.einsum('bqghd,bngd->bghqn', qr, kc).astype(jnp.float32) * SCALE
        valid_c = cmp_end[None, :] <= t[:, None]
        pc = jax.nn.softmax(jnp.where(valid_c, sc, NEG_INF), axis=-1) * valid_c.astype(jnp.float32)
        o_cmp = jnp.einsum('bghqn,bngd->bqghd', pc.astype(vc.dtype), vc)
        imp = jnp.pad(pc.sum(axis=2), ((0, 0), (0, 0), (0, 0), (pad_front, pad_back)))
        p_slc = agg_w[0] * imp[..., 0:SEL_RATIO * n_sel:SEL_RATIO]
        for o in range(1, len(agg_w)):
            p_slc = p_slc + agg_w[o] * imp[..., o:o + SEL_RATIO * n_sel:SEL_RATIO]
        cur = (t // SEL_BLOCK)[:, None]
        valid_b = blk_j[None, :] * SEL_BLOCK <= t[:, None]
        forced = (blk_j[None, :] == 0) | (blk_j[None, :] == cur) | (blk_j[None, :] == cur - 1)
        score = jnp.where(valid_b, jnp.where(forced, FORCE_SCORE, p_slc), NEG_INF)
        _, idx = lax.top_k(score, k_top)
        kg = kb[b_idx, g_idx, idx].reshape(B, G, Q_BLOCK, k_top * SEL_BLOCK, dk)
        vg = vb[b_idx, g_idx, idx].reshape(B, G, Q_BLOCK, k_top * SEL_BLOCK, dk)
        tok = idx[..., None] * SEL_BLOCK + jnp.arange(SEL_BLOCK)
        mask_s = (tok <= t[None, None, :, None, None]).reshape(B, G, Q_BLOCK, k_top * SEL_BLOCK)
        ss = jnp.einsum('bqghd,bgqkd->bghqk', qs, kg).astype(jnp.float32) * SCALE
        ps = jax.nn.softmax(jnp.where(mask_s[:, :, None], ss, NEG_INF), axis=-1)
        o_slc = jnp.einsum('bghqk,bgqkd->bqghd', ps.astype(vg.dtype), vg)
        kwb = lax.dynamic_slice_in_dim(kw, s0, WINDOW + Q_BLOCK, axis=1)
        vwb = lax.dynamic_slice_in_dim(vw, s0, WINDOW + Q_BLOCK, axis=1)
        kpos = s0 - WINDOW + jnp.arange(WINDOW + Q_BLOCK)
        diff = t[:, None] - kpos[None, :]
        mask_w = (diff >= 0) & (diff < WINDOW) & (kpos[None, :] >= 0)
        sw = jnp.einsum('bqghd,bkgd->bghqk', qs, kwb).astype(jnp.float32) * SCALE
        pw = jax.nn.softmax(jnp.where(mask_w, sw, NEG_INF), axis=-1)
        o_win = jnp.einsum('bghqk,bkgd->bqghd', pw.astype(vwb.dtype), vwb)
        o = (gb[..., 0:1] * o_cmp.reshape(B, Q_BLOCK, H, dk).astype(jnp.float32)
             + gb[..., 1:2] * o_slc.reshape(B, Q_BLOCK, H, dk).astype(jnp.float32)
             + gb[..., 2:3] * o_win.reshape(B, Q_BLOCK, H, dk).astype(jnp.float32))
        return o.astype(q.dtype).reshape(B, Q_BLOCK, H * dk)

    out = lax.map(one_block, jnp.arange(S // Q_BLOCK))
    return out.transpose(1, 0, 2, 3).reshape(B, S, D_ATTN)


def short_conv_group(bg, cg, xc, w_conv):
    u = cg * xc
    y = lax.conv_general_dilated(u, w_conv[:, None, :].astype(u.dtype), window_strides=(1,),
                                 padding=[(CONV_WIDTH - 1, 0)],
                                 dimension_numbers=('NWC', 'WIO', 'NWC'),
                                 feature_group_count=D_CONV)
    return bg * y


def hybrid_mixer(h, positions, w_in, pe_k, w1_k, w2_k, pe_v, w1_v, w2_v,
                 w_conv, attn_out_norm, conv_out_norm, w_out):
    z = h @ w_in
    sizes = [D_ATTN] + [D_KV] * 6 + [N_GATES] + [D_CONV] * 3
    cuts = [int(c) for c in np.cumsum(sizes)[:-1]]
    q, kc, vc, ks, vs, kw, vw, gates, bg, cg, xc = jnp.split(z, cuts, axis=-1)
    attn = nsa_group(q, kc, vc, ks, vs, kw, vw, gates, positions, pe_k, w1_k, w2_k, pe_v, w1_v, w2_v)
    conv = short_conv_group(bg, cg, xc, w_conv)
    merged = jnp.concatenate([rms_norm(attn, attn_out_norm), rms_norm(conv, conv_out_norm)], axis=-1)
    return merged @ w_out


def setup_inputs(seed: int = 0) -> dict:
    key = jax.random.key(seed)
    ks = jax.random.split(key, 26)
    L = DEPTH

    def nrm(k, shape, scale):
        return jax.random.normal(k, shape, jnp.float32) * scale

    def gain(k, n):
        return 1.0 + 0.05 * jax.random.normal(k, (L, n), jnp.float32)

    x = nrm(ks[0], (BATCH, SEQ, D_MODEL), 1.0)
    positions = (jnp.arange(SEQ, dtype=jnp.int32)[None, :]
                 + jax.random.randint(ks[1], (BATCH, 1), 0, MAX_POS_OFFSET, dtype=jnp.int32))
    return {
        "x": x,
        "positions": positions,
        "ffn1_norm_pre": gain(ks[2], D_MODEL),
        "ffn1_w_gate": nrm(ks[3], (L, D_MODEL, D_FF), D_MODEL ** -0.5),
        "ffn1_w_up": nrm(ks[4], (L, D_MODEL, D_FF), D_MODEL ** -0.5),
        "ffn1_w_down": nrm(ks[5], (L, D_FF, D_MODEL), D_FF ** -0.5),
        "ffn1_norm_post": gain(ks[6], D_MODEL),
        "mix_norm_pre": gain(ks[7], D_MODEL),
        "w_in": nrm(ks[8], (L, D_MODEL, D_IN_PROJ), D_MODEL ** -0.5),
        "cmp_pe_k": nrm(ks[9], (L, CMP_BLOCK, HEAD_DIM), 0.02),
        "cmp_w1_k": nrm(ks[10], (L, CMP_BLOCK * HEAD_DIM, CMP_HIDDEN), (CMP_BLOCK * HEAD_DIM) ** -0.5),
        "cmp_w2_k": nrm(ks[11], (L, CMP_HIDDEN, HEAD_DIM), CMP_HIDDEN ** -0.5),
        "cmp_pe_v": nrm(ks[12], (L, CMP_BLOCK, HEAD_DIM), 0.02),
        "cmp_w1_v": nrm(ks[13], (L, CMP_BLOCK * HEAD_DIM, CMP_HIDDEN), (CMP_BLOCK * HEAD_DIM) ** -0.5),
        "cmp_w2_v": nrm(ks[14], (L, CMP_HIDDEN, HEAD_DIM), CMP_HIDDEN ** -0.5),
        "conv_w": nrm(ks[15], (L, CONV_WIDTH, D_CONV), CONV_WIDTH ** -0.5),
        "attn_out_norm": gain(ks[16], D_ATTN),
        "conv_out_norm": gain(ks[17], D_CONV),
        "w_out": nrm(ks[18], (L, D_MODEL, D_MODEL), D_MODEL ** -0.5),
        "mix_norm_post": gain(ks[19], D_MODEL),
        "ffn2_norm_pre": gain(ks[20], D_MODEL),
        "ffn2_w_gate": nrm(ks[21], (L, D_MODEL, D_FF), D_MODEL ** -0.5),
        "ffn2_w_up": nrm(ks[22], (L, D_MODEL, D_FF), D_MODEL ** -0.5),
        "ffn2_w_down": nrm(ks[23], (L, D_FF, D_MODEL), D_FF ** -0.5),
        "ffn2_norm_post": gain(ks[24], D_MODEL),
    }


def reference(x, positions, ffn1_norm_pre, ffn1_w_gate, ffn1_w_up, ffn1_w_down, ffn1_norm_post,
              mix_norm_pre, w_in, cmp_pe_k, cmp_w1_k, cmp_w2_k, cmp_pe_v, cmp_w1_v, cmp_w2_v,
              conv_w, attn_out_norm, conv_out_norm, w_out, mix_norm_post,
              ffn2_norm_pre, ffn2_w_gate, ffn2_w_up, ffn2_w_down, ffn2_norm_post):
    for l in range(DEPTH):
        h = swiglu(rms_norm(x, ffn1_norm_pre[l]), ffn1_w_gate[l], ffn1_w_up[l], ffn1_w_down[l])
        x = x + 0.5 * rms_norm(h, ffn1_norm_post[l])
        h = hybrid_mixer(rms_norm(x, mix_norm_pre[l]), positions, w_in[l],
                         cmp_pe_k[l], cmp_w1_k[l], cmp_w2_k[l], cmp_pe_v[l], cmp_w1_v[l], cmp_w2_v[l],
                         conv_w[l], attn_out_norm[l], conv_out_norm[l], w_out[l])
        x = x + rms_norm(h, mix_norm_post[l])
        h = swiglu(rms_norm(x, ffn2_norm_pre[l]), ffn2_w_gate[l], ffn2_w_up[l], ffn2_w_down[l])
        x = x + 0.5 * rms_norm(h, ffn2_norm_post[l])
    return x
```

```cpp
#include <hip/hip_runtime.h>
#include <cstdio>
#include <cstdint>
constexpr int NWAVES = 8;
constexpr int BATCH = 2, SEQ = 16384, DM = 1024, M = BATCH * SEQ, DFF = 2816, NIN = 3072, NLAYER = 2;
constexpr int DATT = 512, NGATE = 24, NSELB = 256, KTOP = 16;
constexpr float EPS = 1e-6f;
constexpr float C2 = 0.125f * 1.4426950408889634f;
constexpr size_t MiB = 1u << 20;
constexpr size_t WS_CTL = 0, CTL_ZERO_BYTES = 1 * MiB;
constexpr size_t WS_W = 2 * MiB, W_LAYER = 43 * MiB;
constexpr size_t WO_GU1 = 0, WO_D1 = 11 * MiB, WO_IN = 11 * MiB + 5632 * 1024, WO_O = WO_IN + 6 * MiB, WO_GU2 = WO_O + 2 * MiB, WO_D2 = WO_GU2 + 11 * MiB, WO_W1 = WO_D2 + 5632 * 1024;
static_assert(WO_W1 + 2 * MiB == W_LAYER, "weight map");
constexpr size_t WS_XB = 88 * MiB;
constexpr size_t WS_H = 152 * MiB;
constexpr size_t WS_BIG = 216 * MiB;
constexpr size_t WS_QRAW = WS_BIG, WS_QROT = WS_BIG + 32 * MiB, WS_OSLC = WS_BIG + 64 * MiB, WS_BG = WS_BIG + 96 * MiB, WS_CG = WS_BIG + 128 * MiB, WS_KRAW = WS_BIG + 160 * MiB, WS_VRAW = WS_KRAW + 8 * MiB;
constexpr size_t WS_XC = 392 * MiB, WS_KS_T = 424 * MiB, WS_KW_T = 432 * MiB, WS_VS_T = 440 * MiB, WS_VW_T = 448 * MiB, WS_GATES = 456 * MiB, WS_IDX = 460 * MiB, WS_HID = 464 * MiB;
constexpr size_t WS_KC_T = 472 * MiB, WS_VC_T = WS_KC_T + 512 * 1024, WS_ROPE = 473 * MiB, WS_RSTD = 475 * MiB, WS_BIAS = 476 * MiB, WS_END = 477 * MiB;
constexpr size_t WS_VS_RM = WS_H, WS_VW_RM = WS_H + 8 * MiB, WS_SCORES = WS_H, WS_MERGED = WS_XB;
constexpr int CW_BAR = 4096;

constexpr int RING_BYTES = 131072, MISC_OFF = RING_BYTES + 320, LDS_BYTES = 147456;

constexpr int PH_PER_LAYER = 16, N_PHASES = 1 + NLAYER * PH_PER_LAYER;
#ifndef PH_MASK
#define PH_MASK 0x1ffff
#endif
#define EN(k) (((PH_MASK) >> (k)) & 1)
#ifndef MK_ONE_LAUNCH
#define MK_ONE_LAUNCH 0
#endif

namespace pg8 {
#define PG8_LAS __attribute__((address_space(3)))
typedef unsigned short bf16_t;
typedef short bf16x8 __attribute__((ext_vector_type(8)));
typedef float f32x4 __attribute__((ext_vector_type(4)));
typedef unsigned u32x4 __attribute__((ext_vector_type(4)));
constexpr int BM = 256, BK = 64, HALF = 128, HTB = HALF * BK * 2  , STAGE_BYTES = 8 * HTB, NXCD = 8, WGM = 8;

__host__ __device__ __forceinline__ int lds_byte(int r, int c) { const int st = (r >> 4) * 2 + (c >> 5), rr = r & 15, cc = c & 31, ob = rr * 64 + cc * 2; return st * 1024 + (ob ^ (((ob >> 9) & 1) << 5)); }
__host__ __device__ __forceinline__ void stage_rc(int b, int& R, int& C) { const int st = b / 1024, sb = b % 1024, swz = sb ^ (((sb >> 9) & 1) << 5); R = (st >> 1) * 16 + swz / 64; C = (st & 1) * 32 + (swz % 64) / 2; }
__host__ __device__ __forceinline__ int perm32(int rho) { const int n = rho >> 4, i = rho & 15; return 8 * (i >> 2) + 4 * n + (i & 3); }

struct Unit { int pm, pn; };
struct Gemm { const bf16_t* A; const bf16_t* Bt; int M, N, K, lda, ldb; };

struct StaticOrder {
    int nM, nN, nwg, G, c;
    __host__ __device__ void init(int M, int N, int G_, int c_) { nM = M / BM; nN = N / BM; nwg = nM * nN; G = G_; c = c_; }
    __host__ __device__ bool next(int i, Unit& u) const {
        const long L = (long)i * G + c; if (L >= nwg) return false;
        int wgid = (int)L; { const int q = nwg / NXCD, r = nwg % NXCD, xcd = wgid % NXCD, off = wgid / NXCD; wgid = (xcd < r ? xcd * (q + 1) : r * (q + 1) + (xcd - r) * q) + off; }
        const int nig = WGM * nN, gid = wgid / nig, fm = gid * WGM, gsz = (nM - fm) < WGM ? (nM - fm) : WGM;
        u.pm = fm + ((wgid % nig) % gsz); u.pn = (wgid % nig) / gsz; return true;
    }
    __device__ __forceinline__ void a_ready(const Unit&) const {}
    __device__ __forceinline__ void done(const Unit&) const {}
};

__device__ __forceinline__ unsigned cvt_pk_bf16(float lo, float hi) { unsigned r; asm volatile("v_cvt_pk_bf16_f32 %0, %1, %2" : "=v"(r) : "v"(lo), "v"(hi)); return r; }
typedef float f32x2 __attribute__((ext_vector_type(2)));
__device__ __forceinline__ f32x2 gelu_pk(f32x2 v) {
    const f32x2 av = __builtin_elementwise_abs(v), d = av * 0.2316418882f + 1.0f;
    f32x2 t; t.x = __builtin_amdgcn_rcpf(d.x); t.y = __builtin_amdgcn_rcpf(d.y);
    f32x2 q = t * 0.5307027145f + (-0.7265760135f); q = q * t + 0.7107068705f; q = q * t + (-0.142248368f); q = q * t + 0.127414796f; q = q * t;
    const f32x2 s = (v * v) * (-0.72134752044f);
    f32x2 e; e.x = __builtin_amdgcn_exp2f(s.x); e.y = __builtin_amdgcn_exp2f(s.y);
    const f32x2 m = v * (q * e), r = v - m;
    f32x2 o; o.x = v.x < 0.f ? m.x : r.x; o.y = v.y < 0.f ? m.y : r.y; return o;
}

template <int ACT  > struct EpiBf16 {
    static constexpr bool PERM = true, AFTER_DRAIN = false; static_assert(ACT == 0 || ACT == 1, "EpiBf16: ACT is 0 (none) or 1 (gelu_pk)");
    bf16_t* O; int ldc; const float* bias; int split_cols; size_t split_stride; float scale0;
    __device__ __forceinline__ void operator()(const f32x4 (&acc)[2][2][4][2], const Unit& u, int wr, int wc, int fr, int fq) const {
        const int row0 = u.pm * BM + wr * 64 + fr; int colt = u.pn * BM; bf16_t* base = O;
        float sc = 1.f; if (split_cols) { const int t = colt / split_cols; base += (size_t)t * split_stride; colt -= t * split_cols; if (t == 0) sc = scale0; }
        const int col0 = colt + wc * 32 + 8 * fq, bcol0 = u.pn * BM + wc * 32 + 8 * fq;
        f32x4 bv[2][2];
#pragma unroll
        for (int bj = 0; bj < 2; ++bj)
#pragma unroll
            for (int n = 0; n < 2; ++n) bv[bj][n] = bias ? *(const f32x4*)(bias + bcol0 + bj * HALF + 4 * n) : (f32x4){0.f, 0.f, 0.f, 0.f};
#pragma unroll
        for (int ai = 0; ai < 2; ++ai)
#pragma unroll
            for (int m = 0; m < 4; ++m) { bf16_t* rowp = base + (size_t)(row0 + ai * HALF + m * 16) * ldc + col0;
#pragma unroll
                for (int bj = 0; bj < 2; ++bj) { f32x4 v0 = acc[ai][bj][m][0] + bv[bj][0], v1 = acc[ai][bj][m][1] + bv[bj][1];
                    if (ACT == 1) { f32x2 a = gelu_pk((f32x2){v0[0], v0[1]}), b = gelu_pk((f32x2){v0[2], v0[3]}), c = gelu_pk((f32x2){v1[0], v1[1]}), d = gelu_pk((f32x2){v1[2], v1[3]});
                        v0 = (f32x4){a.x, a.y, b.x, b.y}; v1 = (f32x4){c.x, c.y, d.x, d.y}; }
                    v0 = v0 * sc; v1 = v1 * sc; u32x4 w; w.x = cvt_pk_bf16(v0[0], v0[1]); w.y = cvt_pk_bf16(v0[2], v0[3]); w.z = cvt_pk_bf16(v1[0], v1[1]); w.w = cvt_pk_bf16(v1[2], v1[3]);
                    *(u32x4*)(rowp + bj * HALF) = w; } }
    }
};

constexpr int SEQ_ = SEQ;
__device__ __forceinline__ unsigned pk2c(float lo, float hi) { typedef float f2_t __attribute__((ext_vector_type(2))); typedef __bf16 b2_t __attribute__((ext_vector_type(2))); f2_t v = {lo, hi}; b2_t b = __builtin_convertvector(v, b2_t); return __builtin_bit_cast(unsigned, b); }
__device__ __forceinline__ void store8(bf16_t* dst, const f32x4& v0, const f32x4& v1) { u32x4 w; w.x = pk2c(v0[0], v0[1]); w.y = pk2c(v0[2], v0[3]); w.z = pk2c(v1[0], v1[1]); w.w = pk2c(v1[2], v1[3]); *(u32x4*)dst = w; }
__device__ __forceinline__ float silu_f(float x) { return x * __builtin_amdgcn_rcpf(1.0f + __builtin_amdgcn_exp2f(-1.4426950408889634f * x)); }
__device__ __forceinline__ float sigmoid_f(float x) { return __builtin_amdgcn_rcpf(1.0f + __builtin_amdgcn_exp2f(-1.4426950408889634f * x)); }

struct EpiSwiGLU {
    static constexpr bool PERM = true, AFTER_DRAIN = false;
    bf16_t* O; int ldc; const float* rstd;
    __device__ __forceinline__ void operator()(const f32x4 (&acc)[2][2][4][2], const Unit& u, int wr, int wc, int fr, int fq) const {
        const int row0 = u.pm * BM + wr * 64 + fr, col0 = u.pn * 128 + wc * 32 + 8 * fq;
#pragma unroll
        for (int ai = 0; ai < 2; ++ai)
#pragma unroll
            for (int m = 0; m < 4; ++m) { const int r = row0 + ai * HALF + m * 16; const float rs = rstd[r];
                const f32x4 g0 = acc[ai][0][m][0] * rs, g1 = acc[ai][0][m][1] * rs, u0 = acc[ai][1][m][0] * rs, u1 = acc[ai][1][m][1] * rs;
                f32x4 o0, o1;
#pragma unroll
                for (int j = 0; j < 4; ++j) { o0[j] = silu_f(g0[j]) * u0[j]; o1[j] = silu_f(g1[j]) * u1[j]; }
                store8(O + (size_t)r * ldc + col0, o0, o1); }
    }
};

struct EpiHid {
    static constexpr bool PERM = false, AFTER_DRAIN = false;
    float* C;
    __device__ __forceinline__ void operator()(const f32x4 (&acc)[2][2][4][2], const Unit& u, int wr, int wc, int fr, int fq) const {
        const int row0 = u.pm * BM + wr * 64 + fr, col0 = wc * 32 + 4 * fq;
#pragma unroll
        for (int ai = 0; ai < 2; ++ai)
#pragma unroll
            for (int m = 0; m < 4; ++m) { float* rowp = C + (size_t)(row0 + ai * HALF + m * 16) * 256 + col0;
#pragma unroll
                for (int bj = 0; bj < 2; ++bj)
#pragma unroll
                    for (int n = 0; n < 2; ++n) *(f32x4*)(rowp + bj * HALF + n * 16) = acc[ai][bj][m][n]; }
    }
};

__device__ __forceinline__ void rope8(f32x4& v0, f32x4& v1, const float* rope_row, int wc, int fq) {
    if ((wc & 1) == 0) {
        f32x4 o0, o1;
#pragma unroll
        for (int j = 0; j < 4; ++j) { o0[j] = __shfl_xor(v0[j], 16); o1[j] = __shfl_xor(v1[j], 16); }
        if (fq < 2) {
            const f32x4 c0 = *(const f32x4*)(rope_row), c1 = *(const f32x4*)(rope_row + 4), s0 = *(const f32x4*)(rope_row + 8), s1 = *(const f32x4*)(rope_row + 12);
            if (fq == 0) { v0 = v0 * c0 - o0 * s0; v1 = v1 * c1 - o1 * s1; }
            else         { v0 = v0 * c0 + o0 * s0; v1 = v1 * c1 + o1 * s1; }
        }
    }
}

struct EpiInProj {
    static constexpr bool PERM = true, AFTER_DRAIN = false;
    unsigned char* ws;
    __device__ __forceinline__ void operator()(const f32x4 (&acc)[2][2][4][2], const Unit& u, int wr, int wc, int fr, int fq) const {
        const float* rstd = (const float*)(ws + WS_RSTD); const float* rope = (const float*)(ws + WS_ROPE);
        bf16_t* qraw = (bf16_t*)(ws + WS_QRAW); bf16_t* qrot = (bf16_t*)(ws + WS_QROT); bf16_t* kraw = (bf16_t*)(ws + WS_KRAW); bf16_t* vraw = (bf16_t*)(ws + WS_VRAW);
        bf16_t* ks_t = (bf16_t*)(ws + WS_KS_T); bf16_t* vs_rm = (bf16_t*)(ws + WS_VS_RM); bf16_t* kw_t = (bf16_t*)(ws + WS_KW_T); bf16_t* vw_rm = (bf16_t*)(ws + WS_VW_RM);
        bf16_t* bg = (bf16_t*)(ws + WS_BG); bf16_t* cg = (bf16_t*)(ws + WS_CG); bf16_t* xc = (bf16_t*)(ws + WS_XC); float* gates = (float*)(ws + WS_GATES);
        const int pn = u.pn, row0 = u.pm * BM + wr * 64 + fr;
#pragma unroll
        for (int ai = 0; ai < 2; ++ai)
#pragma unroll
            for (int m = 0; m < 4; ++m) {
                const int r = row0 + ai * HALF + m * 16; const float rs = rstd[r];
                const int b = r >> 14, s = r & (SEQ_ - 1);
                const float* rrow = rope + (size_t)r * 16;
#pragma unroll
                for (int bj = 0; bj < 2; ++bj) {
                    f32x4 v0 = acc[ai][bj][m][0] * rs, v1 = acc[ai][bj][m][1] * rs;
                    const int ct = bj * HALF + wc * 32 + 8 * fq;
                    const int c = wc * 32 + 8 * fq, g = c >> 6, d0 = c & 63;
                    if (pn <= 1) {
                        const size_t o = (size_t)r * 512 + pn * 256 + ct;
                        store8(qraw + o, v0, v1);
                        rope8(v0, v1, rrow, wc, fq);
                        store8(qrot + o, v0, v1);
                    } else if (pn == 2) {
                        bf16_t* dst = (bj == 0 ? kraw : vraw) + ((size_t)((b * 2 + g) * SEQ_ + s)) * 64 + d0;
                        store8(dst, v0, v1);
                    } else if (pn <= 4) {
                        if (bj == 0) {
                            rope8(v0, v1, rrow, wc, fq);
                            bf16_t* base = (pn == 3 ? ks_t : kw_t) + (size_t)(b * 2 + g) * SEQ_ * 64;
                            const int off = (((s >> 4) * 2 + (d0 >> 5)) * 64 + ((d0 & 31) >> 3) * 16 + (s & 15)) * 8;
                            store8(base + off, v0, v1);
                        } else {
                            bf16_t* dst = (pn == 3 ? vs_rm : vw_rm) + ((size_t)((b * 2 + g) * SEQ_ + s)) * 64 + d0;
                            store8(dst, v0, v1);
                        }
                    } else if (pn <= 10) {
                        bf16_t* base = pn <= 6 ? bg : (pn <= 8 ? cg : xc);
                        store8(base + (size_t)r * 512 + ((pn - 5) & 1) * 256 + ct, v0, v1);
                    } else {
                        if (bj == 0 && wc == 0 && fq < 3) {
                            f32x4 a, bb;
#pragma unroll
                            for (int j = 0; j < 4; ++j) { a[j] = sigmoid_f(v0[j]); bb[j] = sigmoid_f(v1[j]); }
                            float* dst = gates + (size_t)r * 24 + 8 * fq;
                            *(f32x4*)dst = a; *(f32x4*)(dst + 4) = bb;
                        }
                    }
                }
            }
    }
};

struct CmpOrder {
    int G, c;
    __device__ __forceinline__ bool next(int i, Unit& u) const { const int L = i * G + c; if (L >= 32) return false; u.pm = L; u.pn = L >> 4; return true; }
    __device__ __forceinline__ void a_ready(const Unit&) const {}
    __device__ __forceinline__ void done(const Unit&) const {}
};
template <class Epi, class Sched, bool ALIGN_EPI = false, bool SP2 = false>
__device__ __forceinline__ void gemm_phase(PG8_LAS unsigned char* lds, const Gemm g, const Sched& S, const Epi& E) {
    int tid_ = threadIdx.x; asm volatile("" : "+v"(tid_));
    const int tid = tid_, wid = __builtin_amdgcn_readfirstlane(tid >> 6), lane = tid & 63, wr = wid >> 2, wc = wid & 3, fr = lane & 15, fq = lane >> 4;
    const int K = g.K, nt = K / BK;
    unsigned voffA[2], voffB[2];
#pragma unroll
    for (int i = 0; i < 2; ++i) { int R, C; stage_rc(tid * 16 + i * 8192, R, C); const int Rb = Epi::PERM ? ((R & ~31) + perm32(R & 31)) : R;
        voffA[i] = (unsigned)(R * g.lda + C) * 2u; voffB[i] = (unsigned)(Rb * g.ldb + C) * 2u; }
    const size_t kstep = (size_t)(BK * 2);
    const size_t hstepA = (size_t)HALF * g.lda * 2, hstepB = (size_t)HALF * g.ldb * 2;
    const size_t tstepA = 2 * hstepA, tstepB = 2 * hstepB;
    const unsigned ldsw = (unsigned)wid * 1024u;
    const int aoff = lds_byte(wr * 64 + fr, fq * 8), boff = lds_byte(wc * 32 + fr, fq * 8);
#define PG8_SA(b, h) (((b) * 2 + (h)) * HTB)
#define PG8_SB(b, h) ((4 + (b) * 2 + (h)) * HTB)
#define PG8_STAGE(bufoff, gbase, voff) do { _Pragma("unroll") for (int _i = 0; _i < 2; ++_i) \
        __builtin_amdgcn_global_load_lds((const unsigned*)((const char*)(gbase) + (voff)[_i]), (PG8_LAS unsigned*)(lds + (bufoff) + ldsw + _i * 8192), 16, 0, 0); } while (0)
#define PG8_LDA(dst, b, h) do { _Pragma("unroll") for (int m = 0; m < 4; ++m) _Pragma("unroll") for (int k = 0; k < 2; ++k) dst[m][k] = *(const PG8_LAS bf16x8*)(lds + PG8_SA(b, h) + aoff + m * 2048 + k * 1024); } while (0)
#define PG8_LDB(dst, b, h) do { _Pragma("unroll") for (int n = 0; n < 2; ++n) _Pragma("unroll") for (int k = 0; k < 2; ++k) dst[n][k] = *(const PG8_LAS bf16x8*)(lds + PG8_SB(b, h) + boff + n * 2048 + k * 1024); } while (0)
#define PG8_MMA(ai, bj, At, Bt) do { __builtin_amdgcn_s_setprio(1); _Pragma("unroll") for (int m = 0; m < 4; ++m) _Pragma("unroll") for (int n = 0; n < 2; ++n) _Pragma("unroll") for (int k = 0; k < 2; ++k) \
        acc[ai][bj][m][n] = __builtin_amdgcn_mfma_f32_16x16x32_bf16(Bt[n][k], At[m][k], acc[ai][bj][m][n], 0, 0, 0); __builtin_amdgcn_s_setprio(0); } while (0)
#define PG8_WAIT_V(n) asm volatile("s_waitcnt vmcnt(" #n ")" ::: "memory")
#define PG8_WAIT_L(n) asm volatile("s_waitcnt lgkmcnt(" #n ")" ::: "memory")
#define PG8_BAR __builtin_amdgcn_s_barrier()
#define PG8_SCHED __builtin_amdgcn_sched_barrier(0)
    Unit cur, nxt; int ui = 0;
    if (!S.next(0, cur)) return;
    f32x4 acc[2][2][4][2];
#pragma unroll
    for (int a = 0; a < 2; ++a)
#pragma unroll
        for (int b = 0; b < 2; ++b)
#pragma unroll
            for (int m = 0; m < 4; ++m)
#pragma unroll
                for (int n = 0; n < 2; ++n) acc[a][b][m][n] = (f32x4){0.f, 0.f, 0.f, 0.f};
    bf16x8 At[4][2], B0[2][2], B1[2][2];
    const char* cA = (const char*)g.A + (size_t)cur.pm * tstepA; const char* cB = (const char*)g.Bt + (size_t)cur.pn * tstepB;
    S.a_ready(cur);
    if constexpr (SP2) {
        PG8_STAGE(PG8_SB(0, 0), cB, voffB); PG8_STAGE(PG8_SB(0, 1), cB + hstepB, voffB); PG8_STAGE(PG8_SA(0, 0), cA, voffA); PG8_STAGE(PG8_SA(0, 1), cA + hstepA, voffA);
        if (wr == 1) PG8_BAR;
        PG8_WAIT_V(2); PG8_BAR;
        PG8_STAGE(PG8_SB(1, 0), cB + kstep, voffB); PG8_STAGE(PG8_SA(1, 0), cA + kstep, voffA); PG8_STAGE(PG8_SB(1, 1), cB + hstepB + kstep, voffB);
        PG8_WAIT_V(6); PG8_BAR;
    } else {
        PG8_STAGE(PG8_SB(0, 0), cB, voffB); PG8_STAGE(PG8_SA(0, 0), cA, voffA); PG8_STAGE(PG8_SB(0, 1), cB + hstepB, voffB); PG8_STAGE(PG8_SA(0, 1), cA + hstepA, voffA);
        if (wr == 1) PG8_BAR;
        PG8_WAIT_V(4); PG8_BAR;
        PG8_STAGE(PG8_SB(1, 0), cB + kstep, voffB); PG8_STAGE(PG8_SA(1, 0), cA + kstep, voffA); PG8_STAGE(PG8_SB(1, 1), cB + hstepB + kstep, voffB);
        PG8_WAIT_V(6); PG8_BAR;
    }
    for (;;) {
        const bool has_next = S.next(ui + 1, nxt);
        const char* nA = has_next ? (const char*)g.A + (size_t)nxt.pm * tstepA : cA; const char* nB = has_next ? (const char*)g.Bt + (size_t)nxt.pn * tstepB : cB;
        for (int t = 0; t < nt; t += 2) {
            const bool last = (t == nt - 2);
            const char* a1 = cA + (size_t)(t + 1) * kstep;
            const char* a2 = last ? nA : cA + (size_t)(t + 2) * kstep; const char* b2 = last ? nB : cB + (size_t)(t + 2) * kstep;
            const char* a3 = a2 + kstep; const char* b3 = b2 + kstep;
            if (last && has_next) S.a_ready(nxt);
            if constexpr (SP2) {
            PG8_LDB(B0, 0, 0); PG8_LDB(B1, 0, 1); PG8_SCHED; PG8_LDA(At, 0, 0); PG8_STAGE(PG8_SA(1, 1), a1 + hstepA, voffA);
            PG8_WAIT_V(8); PG8_WAIT_L(0); PG8_BAR; PG8_MMA(0, 0, At, B0); PG8_MMA(0, 1, At, B1); PG8_BAR; PG8_SCHED;
            PG8_LDA(At, 0, 1); PG8_STAGE(PG8_SB(0, 0), b2, voffB); PG8_STAGE(PG8_SB(0, 1), b2 + hstepB, voffB); PG8_STAGE(PG8_SA(0, 0), a2, voffA);
            PG8_WAIT_V(8); PG8_WAIT_L(0); PG8_BAR; PG8_MMA(1, 0, At, B0); PG8_MMA(1, 1, At, B1); PG8_BAR; PG8_SCHED;
            PG8_LDB(B0, 1, 0); PG8_LDB(B1, 1, 1); PG8_SCHED; PG8_LDA(At, 1, 0); PG8_STAGE(PG8_SA(0, 1), a2 + hstepA, voffA);
            PG8_WAIT_V(8); PG8_WAIT_L(0); PG8_BAR; PG8_MMA(0, 0, At, B0); PG8_MMA(0, 1, At, B1); PG8_BAR; PG8_SCHED;
            PG8_LDA(At, 1, 1); PG8_STAGE(PG8_SB(1, 0), b3, voffB); PG8_STAGE(PG8_SB(1, 1), b3 + hstepB, voffB); PG8_STAGE(PG8_SA(1, 0), a3, voffA);
            PG8_WAIT_V(8); PG8_WAIT_L(0); PG8_BAR; PG8_MMA(1, 0, At, B0); PG8_MMA(1, 1, At, B1); PG8_BAR; PG8_SCHED;
            } else {
            PG8_LDB(B0, 0, 0); PG8_SCHED; PG8_LDA(At, 0, 0); PG8_STAGE(PG8_SA(1, 1), a1 + hstepA, voffA);
            PG8_WAIT_L(8); PG8_BAR; PG8_WAIT_L(0); PG8_MMA(0, 0, At, B0); PG8_BAR; PG8_SCHED;
            PG8_LDB(B1, 0, 1); PG8_STAGE(PG8_SB(0, 0), b2, voffB);
            PG8_BAR; PG8_WAIT_L(0); PG8_MMA(0, 1, At, B1); PG8_BAR;
            PG8_LDA(At, 0, 1); PG8_STAGE(PG8_SA(0, 0), a2, voffA);
            PG8_BAR; PG8_WAIT_L(0); PG8_MMA(1, 0, At, B0); PG8_BAR; PG8_SCHED;
            PG8_STAGE(PG8_SB(0, 1), b2 + hstepB, voffB);
            PG8_WAIT_V(6); PG8_BAR; PG8_MMA(1, 1, At, B1); PG8_BAR;
            PG8_LDB(B0, 1, 0); PG8_SCHED; PG8_LDA(At, 1, 0); PG8_STAGE(PG8_SA(0, 1), a2 + hstepA, voffA);
            PG8_WAIT_L(8); PG8_BAR; PG8_WAIT_L(0); PG8_MMA(0, 0, At, B0); PG8_BAR; PG8_SCHED;
            PG8_LDB(B1, 1, 1); PG8_STAGE(PG8_SB(1, 0), b3, voffB);
            PG8_BAR; PG8_WAIT_L(0); PG8_MMA(0, 1, At, B1); PG8_BAR;
            PG8_LDA(At, 1, 1); PG8_STAGE(PG8_SA(1, 0), a3, voffA);
            PG8_BAR; PG8_WAIT_L(0); PG8_MMA(1, 0, At, B0); PG8_BAR; PG8_SCHED;
            PG8_STAGE(PG8_SB(1, 1), b3 + hstepB, voffB);
            PG8_WAIT_V(6); PG8_BAR; PG8_MMA(1, 1, At, B1); PG8_BAR;
            }
        }
        if constexpr (ALIGN_EPI) { if (wr == 0) PG8_BAR; }
        if constexpr (!Epi::AFTER_DRAIN) { E(acc, cur, wr, wc, fr, fq); S.done(cur); }
        if (!has_next) break;
#pragma unroll
        for (int a = 0; a < 2; ++a)
#pragma unroll
            for (int b = 0; b < 2; ++b)
#pragma unroll
                for (int m = 0; m < 4; ++m)
#pragma unroll
                    for (int n = 0; n < 2; ++n) acc[a][b][m][n] = (f32x4){0.f, 0.f, 0.f, 0.f};
        cur = nxt; cA = nA; cB = nB; ++ui;
        if constexpr (ALIGN_EPI) { if (wr == 1) PG8_BAR; }
    }
    PG8_WAIT_V(0);
    if constexpr (!ALIGN_EPI) { if (wr == 0) PG8_BAR; }
    PG8_BAR;
    if constexpr (Epi::AFTER_DRAIN) { E.fused(acc, cur, wr, wc, fr, fq, lds, wid, lane); S.done(cur); }
#undef PG8_SA
#undef PG8_SB
#undef PG8_STAGE
#undef PG8_LDA
#undef PG8_LDB
#undef PG8_MMA
#undef PG8_WAIT_V
#undef PG8_WAIT_L
#undef PG8_BAR
#undef PG8_SCHED
}
}
#define GAS __attribute__((address_space(1)))
#define LAS __attribute__((address_space(3)))
typedef unsigned short bf16;
typedef unsigned v4u __attribute__((ext_vector_type(4)));
typedef float f32x4 __attribute__((ext_vector_type(4)));
typedef short bf16x8 __attribute__((ext_vector_type(8)));
typedef GAS unsigned gu32;
typedef GAS unsigned long long gu64;
#define RLX_AGENT __ATOMIC_RELAXED, __HIP_MEMORY_SCOPE_AGENT
#define LDS_WAIT() asm volatile("s_waitcnt lgkmcnt(0)" ::: "memory")
#define VM_WAIT() asm volatile("s_waitcnt vmcnt(0)" ::: "memory")
__device__ __forceinline__ unsigned long long rt() { return __builtin_amdgcn_s_memrealtime(); }
__device__ __forceinline__ unsigned f2bf(float f) { unsigned u = __builtin_bit_cast(unsigned, f); return (u + 0x7fffu + ((u >> 16) & 1u)) >> 16; }
__device__ __forceinline__ unsigned pk2(float lo, float hi) { return f2bf(lo) | (f2bf(hi) << 16); }

#define XB_TMO      128
#define XB_XCNT(j)  (256  + 64 * (j))
#define XB_XSUB(j)  (1280 + 64 * (j))
#define XB_XGEN(j)  (2304 + 64 * (j))
#define XB_TOP      3328
#define XB_TOPGEN   3392
#define XCD_BAR_WORDS 3456
#define XB_SPIN_CAP (1u << 18)

__device__ __forceinline__ unsigned xb_ld(unsigned* p)              { return __hip_atomic_load(p, __ATOMIC_RELAXED, __HIP_MEMORY_SCOPE_AGENT); }
__device__ __forceinline__ unsigned xb_add(unsigned* p, unsigned v) { return __hip_atomic_fetch_add(p, v, __ATOMIC_RELAXED, __HIP_MEMORY_SCOPE_AGENT); }
__device__ __forceinline__ unsigned xb_xcc_id() { return (unsigned)__builtin_amdgcn_s_getreg((3 << 11) | 20) & 0xFu; }
#define XB_SPIN(cond, bar) do { unsigned _sp = 0; while (cond) { __builtin_amdgcn_s_sleep(1); \
    if ((++_sp & 255u) == 0u) { if (xb_ld(&(bar)[XB_TMO])) break; if (_sp > XB_SPIN_CAP) { atomicAdd(&(bar)[XB_TMO], 1u); break; } } } } while (0)

struct XcdBarrier {
    unsigned* bar; unsigned x;
    volatile LAS unsigned* st;
};

__device__ __forceinline__ XcdBarrier xcd_barrier_post(unsigned* bar, volatile LAS unsigned* st) {
    XcdBarrier b; b.bar = bar; b.x = xb_xcc_id(); b.st = st;
    if (threadIdx.x == 0) (void)xb_add(&bar[XB_XCNT(b.x)], 1u);
    return b;
}
__device__ __forceinline__ void xcd_barrier_complete(unsigned* bar, unsigned x, unsigned& nloc, unsigned& nx) {
    const unsigned G = gridDim.x * gridDim.y * gridDim.z;
    unsigned sum, cnt, mine, sp = 0u;
    for (;;) {
        sum = 0u; cnt = 0u; mine = 0u;
#pragma unroll
        for (unsigned j = 0; j < 16; ++j) { const unsigned c = xb_ld(&bar[XB_XCNT(j)]); sum += c; cnt += (c > 0u) ? 1u : 0u; mine = (j == x) ? c : mine; }
        if (sum == G) break;
        __builtin_amdgcn_s_sleep(1);
        if ((++sp & 255u) == 0u) { if (xb_ld(&bar[XB_TMO])) break; if (sp > XB_SPIN_CAP) { atomicAdd(&bar[XB_TMO], 1u); break; } }
    }
    nloc = mine > 0u ? mine : 1u; nx = cnt > 0u ? cnt : 1u;
}

__device__ __forceinline__ void xcd_barrier(const XcdBarrier& b) {
    asm volatile("s_waitcnt vmcnt(0)" ::: "memory");
    __syncthreads();
    if (threadIdx.x == 0) {
        unsigned* bar = b.bar;
        __builtin_amdgcn_s_waitcnt(0);
        unsigned nloc = b.st[0], nx = b.st[1];
        if (nloc == 0u) { xcd_barrier_complete(bar, b.x, nloc, nx); b.st[0] = nloc; b.st[1] = nx; }
        const unsigned old = xb_add(&bar[XB_XSUB(b.x)], 1u);
        const unsigned gen = old / nloc;
        if (old + 1u == (gen + 1u) * nloc) {
            __builtin_amdgcn_fence(__ATOMIC_RELEASE, "agent");
            asm volatile("s_waitcnt vmcnt(0)" ::: "memory");
            const unsigned og = xb_add(&bar[XB_TOP], 1u);
            const unsigned tg = og / nx;
            if (og + 1u == (tg + 1u) * nx) xb_add(&bar[XB_TOPGEN], 1u);
            else XB_SPIN(xb_ld(&bar[XB_TOPGEN]) == tg, bar);
            __builtin_amdgcn_fence(__ATOMIC_ACQUIRE, "agent");
            xb_add(&bar[XB_XGEN(b.x)], 1u);
            asm volatile("s_waitcnt vmcnt(0)" ::: "memory");
        } else {
            XB_SPIN(xb_ld(&bar[XB_XGEN(b.x)]) == gen, bar);
            __builtin_amdgcn_fence(__ATOMIC_ACQUIRE, "agent");
            asm volatile("s_waitcnt vmcnt(0)" ::: "memory");
        }
    }
    __syncthreads();
}

typedef float f32x2 __attribute__((ext_vector_type(2)));
typedef unsigned v2u __attribute__((ext_vector_type(2)));
__device__ __forceinline__ unsigned pkc(float lo, float hi) { return pg8::pk2c(lo, hi); }
__device__ __forceinline__ float bf_lo(unsigned w) { return __uint_as_float(w << 16); }
__device__ __forceinline__ float bf_hi(unsigned w) { return __uint_as_float(w & 0xffff0000u); }
__device__ __forceinline__ float wave_sum(float v) {
#pragma unroll
    for (int o = 1; o < 64; o <<= 1) v += __shfl_xor(v, o);
    return v;
}
__device__ __forceinline__ f32x4 mfma16(bf16x8 a, bf16x8 b, f32x4 c) { return __builtin_amdgcn_mfma_f32_16x16x32_bf16(a, b, c, 0, 0, 0); }
__device__ __forceinline__ float ex2(float x) { return __builtin_amdgcn_exp2f(x); }
__device__ __forceinline__ bf16x8 pack8(const f32x4& a, const f32x4& b) { v4u w; w.x = pkc(a[0], a[1]); w.y = pkc(a[2], a[3]); w.z = pkc(b[0], b[1]); w.w = pkc(b[2], b[3]); return __builtin_bit_cast(bf16x8, w); }

__device__ __forceinline__ void tr_item(const float* W, int ldw, int col0, int nvalid, const float* gain, bf16* WT, int ldt, int drow0, LAS float* scr, int kb, int n0, int lane) {
    const int k0 = 64 * kb;
#pragma unroll 8
    for (int i = 0; i < 32; ++i) { const int kk = 2 * i + (lane >> 5), n = n0 + (lane & 31);
        float v = (n < nvalid) ? W[(size_t)(k0 + kk) * ldw + col0 + n] : 0.f; if (gain) v *= gain[k0 + kk];
        scr[kk * 33 + (lane & 31)] = v; }
    LDS_WAIT(); asm volatile("" ::: "memory");
    const int c = lane & 7;
#pragma unroll
    for (int j = 0; j < 4; ++j) { const int n = (lane >> 3) + 8 * j; const LAS float* s = scr + (8 * c) * 33 + n;
        v4u o; o.x = pkc(s[0 * 33], s[1 * 33]); o.y = pkc(s[2 * 33], s[3 * 33]); o.z = pkc(s[4 * 33], s[5 * 33]); o.w = pkc(s[6 * 33], s[7 * 33]);
        *(GAS v4u*)(WT + (size_t)(drow0 + n) * ldt + k0 + 8 * c) = o; }
    LDS_WAIT(); asm volatile("" ::: "memory");
}

struct In {
    const float *x; const int* pos;
    const float *f1_pre, *f1_wg, *f1_wu, *f1_wd, *f1_post, *mix_pre, *w_in, *pe_k, *w1_k, *w2_k, *pe_v, *w1_v, *w2_v, *conv_w, *aon, *con, *w_out, *mix_post, *f2_pre, *f2_wg, *f2_wu, *f2_wd, *f2_post;
};

__device__ __forceinline__ void pro_weights(const In& I, unsigned char* ws, LAS float* scr, int gw, int NGW, int lane) {
    constexpr int I_GU = 16 * 88, I_D = 44 * 32, I_INM = 16 * 40, I_ING = 16, I_INC = 16 * 16, I_O = 16 * 32, I_W1 = 32 * 8;
    constexpr int PER_LAYER = 4 * I_GU + 2 * I_D + I_INM + I_ING + 3 * I_INC + I_O + 2 * I_W1;
    for (int it = gw; it < NLAYER * PER_LAYER; it += NGW) {
        const int l = it / PER_LAYER; int r = it % PER_LAYER;
        unsigned char* wl = ws + WS_W + (size_t)l * W_LAYER;
        if (r < I_GU) { const int kb = r / 88, n0 = 32 * (r % 88); tr_item(I.f1_wg + (size_t)l * DM * DFF, DFF, 0, DFF, I.f1_pre + (size_t)l * DM, (bf16*)(wl + WO_GU1), DM, (n0 >> 7) * 256 + (n0 & 127), scr, kb, n0, lane); continue; } r -= I_GU;
        if (r < I_GU) { const int kb = r / 88, n0 = 32 * (r % 88); tr_item(I.f1_wu + (size_t)l * DM * DFF, DFF, 0, DFF, I.f1_pre + (size_t)l * DM, (bf16*)(wl + WO_GU1), DM, (n0 >> 7) * 256 + (n0 & 127) + 128, scr, kb, n0, lane); continue; } r -= I_GU;
        if (r < I_D) { const int kb = r / 32, n0 = 32 * (r % 32); tr_item(I.f1_wd + (size_t)l * DFF * DM, DM, 0, DM, nullptr, (bf16*)(wl + WO_D1), DFF, n0, scr, kb, n0, lane); continue; } r -= I_D;
        if (r < I_GU) { const int kb = r / 88, n0 = 32 * (r % 88); tr_item(I.f2_wg + (size_t)l * DM * DFF, DFF, 0, DFF, I.f2_pre + (size_t)l * DM, (bf16*)(wl + WO_GU2), DM, (n0 >> 7) * 256 + (n0 & 127), scr, kb, n0, lane); continue; } r -= I_GU;
        if (r < I_GU) { const int kb = r / 88, n0 = 32 * (r % 88); tr_item(I.f2_wu + (size_t)l * DM * DFF, DFF, 0, DFF, I.f2_pre + (size_t)l * DM, (bf16*)(wl + WO_GU2), DM, (n0 >> 7) * 256 + (n0 & 127) + 128, scr, kb, n0, lane); continue; } r -= I_GU;
        if (r < I_D) { const int kb = r / 32, n0 = 32 * (r % 32); tr_item(I.f2_wd + (size_t)l * DFF * DM, DM, 0, DM, nullptr, (bf16*)(wl + WO_D2), DFF, n0, scr, kb, n0, lane); continue; } r -= I_D;
        const float* Win = I.w_in + (size_t)l * DM * 2840; const float* mpre = I.mix_pre + (size_t)l * DM; bf16* WI = (bf16*)(wl + WO_IN);
        if (r < I_INM) { const int kb = r / 40, n0 = 32 * (r % 40); tr_item(Win, 2840, 0, 1280, mpre, WI, DM, n0, scr, kb, n0, lane); continue; } r -= I_INM;
        if (r < I_ING) { tr_item(Win, 2840, 1280, 24, mpre, WI, DM, 2816, scr, r, 0, lane); continue; } r -= I_ING;
        if (r < I_INC) { const int kb = r / 16, n0 = 32 * (r % 16); tr_item(Win, 2840, 1304, 512, mpre, WI, DM, 1280 + n0, scr, kb, n0, lane); continue; } r -= I_INC;
        if (r < I_INC) { const int kb = r / 16, n0 = 32 * (r % 16); tr_item(Win, 2840, 1816, 512, mpre, WI, DM, 1792 + n0, scr, kb, n0, lane); continue; } r -= I_INC;
        if (r < I_INC) { const int kb = r / 16, n0 = 32 * (r % 16); tr_item(Win, 2840, 2328, 512, mpre, WI, DM, 2304 + n0, scr, kb, n0, lane); continue; } r -= I_INC;
        if (r < I_O) { const int kb = r / 32, n0 = 32 * (r % 32);
            const float* gn = (kb < 8) ? (I.aon + (size_t)l * 512) : (I.con + (size_t)l * 512 - 512);
            tr_item(I.w_out + (size_t)l * DM * DM, DM, 0, DM, gn, (bf16*)(wl + WO_O), DM, n0, scr, kb, n0, lane); continue; } r -= I_O;
        if (r < I_W1) { const int kb = r / 8, n0 = 32 * (r % 8); tr_item(I.w1_k + (size_t)l * 2048 * 256, 256, 0, 256, nullptr, (bf16*)(wl + WO_W1), 2048, n0, scr, kb, n0, lane); continue; } r -= I_W1;
        { const int kb = r / 8, n0 = 32 * (r % 8); tr_item(I.w1_v + (size_t)l * 2048 * 256, 256, 0, 256, nullptr, (bf16*)(wl + WO_W1), 2048, 256 + n0, scr, kb, n0, lane); }
    }
    for (int i = gw * 64 + lane; i < NLAYER * 28672; i += NGW * 64) { const int l = i / 28672, q = i % 28672;
        *(GAS v4u*)(ws + WS_W + (size_t)l * W_LAYER + WO_IN + (size_t)2848 * DM * 2 + (size_t)q * 16) = (v4u){0u, 0u, 0u, 0u}; }
    for (int j = gw; j < NLAYER * 2 * 4; j += NGW) { const int l = j >> 3, kv = (j >> 2) & 1, c = (j & 3) * 64 + lane;
        const float* pe = (kv == 0 ? I.pe_k : I.pe_v) + (size_t)l * 2048; const float* w1 = (kv == 0 ? I.w1_k : I.w1_v) + (size_t)l * 2048 * 256;
        float s = 0.f;
        for (int k = 0; k < 2048; ++k) s += pe[k] * w1[(size_t)k * 256 + c];
        ((float*)(ws + WS_BIAS))[(l * 2 + kv) * 256 + c] = s; }
}

__device__ __forceinline__ void pro_rope(const int* pos, float* rope, int gtid, int nthreads) {
    const double invf[8] = {1.0, 0.19392274474868576, 0.03760603093086393, 0.007292664737217109, 0.001414213562373095, 0.0002742481756762073, 5.318295896944988e-05, 1.031338537721246e-05};
    for (int e = gtid; e < M * 8; e += nthreads) { const int row = e >> 3, i = e & 7;
        double f = 1.0;
#pragma unroll
        for (int q = 0; q < 8; ++q) f = (i == q) ? invf[q] : f;
        const double ang = (double)pos[row] * f;
        const double k = __builtin_rint(ang * 0.15915494309189535);
        const double red = __builtin_fma(-k, 1.2246467991473532e-16 * 2.0, __builtin_fma(-k, 6.283185307179586, ang));
        const float rf = (float)red;
        rope[(size_t)row * 16 + i] = cosf(rf); rope[(size_t)row * 16 + 8 + i] = sinf(rf); }
}

__device__ __forceinline__ void pro_xrow(const float* xrow, bf16* xbrow, float* rstd_out, int lane) {
    const GAS f32x4* xr = (const GAS f32x4*)xrow + lane;
    f32x4 v[4]; float s = 0.f;
#pragma unroll
    for (int j = 0; j < 4; ++j) { v[j] = xr[64 * j]; s += (v[j].x * v[j].x + v[j].y * v[j].y) + (v[j].z * v[j].z + v[j].w * v[j].w); }
    s = wave_sum(s);
    GAS v2u* o8 = (GAS v2u*)xbrow + lane;
#pragma unroll
    for (int j = 0; j < 4; ++j) o8[64 * j] = (v2u){pkc(v[j].x, v[j].y), pkc(v[j].z, v[j].w)};
    if (lane == 0) *rstd_out = 1.0f / sqrtf(s * (1.0f / DM) + EPS);
}

__device__ __forceinline__ void rowpass(const float* xin, float* xout, const bf16* h, const float* gpost, float scale, bf16* xb, float* rstd, int gw, int NGW, int lane) {
    f32x4 gv[4];
#pragma unroll
    for (int j = 0; j < 4; ++j) gv[j] = *((const GAS f32x4*)gpost + lane + 64 * j);
    for (int row = gw; row < M; row += NGW) {
        const GAS v2u* hr = (const GAS v2u*)(h + (size_t)row * DM) + lane;
        const GAS f32x4* xr = (const GAS f32x4*)(xin + (size_t)row * DM) + lane;
        f32x4 hv[4], xv[4]; float s = 0.f;
#pragma unroll
        for (int j = 0; j < 4; ++j) { const v2u w = hr[64 * j]; hv[j] = (f32x4){bf_lo(w.x), bf_hi(w.x), bf_lo(w.y), bf_hi(w.y)}; xv[j] = xr[64 * j];
            s += (hv[j].x * hv[j].x + hv[j].y * hv[j].y) + (hv[j].z * hv[j].z + hv[j].w * hv[j].w); }
        s = wave_sum(s);
        const float rh = scale / sqrtf(s * (1.0f / DM) + EPS);
        float s2 = 0.f;
#pragma unroll
        for (int j = 0; j < 4; ++j) { xv[j] = xv[j] + hv[j] * gv[j] * rh; s2 += (xv[j].x * xv[j].x + xv[j].y * xv[j].y) + (xv[j].z * xv[j].z + xv[j].w * xv[j].w); }
        s2 = wave_sum(s2);
        GAS f32x4* xo = (GAS f32x4*)(xout + (size_t)row * DM) + lane;
        GAS v2u* o8 = (GAS v2u*)(xb + (size_t)row * DM) + lane;
#pragma unroll
        for (int j = 0; j < 4; ++j) { xo[64 * j] = xv[j]; o8[64 * j] = (v2u){pkc(xv[j].x, xv[j].y), pkc(xv[j].z, xv[j].w)}; }
        if (lane == 0) rstd[row] = 1.0f / sqrtf(s2 * (1.0f / DM) + EPS);
    }
}

__device__ __forceinline__ float gelu_tanh(float x) {
    const float u = 0.7978845608028654f * (x + 0.044715f * x * x * x);
    const float e = ex2(2.0f * 1.4426950408889634f * u);
    const float th = 1.0f - 2.0f * __builtin_amdgcn_rcpf(e + 1.0f);
    return 0.5f * x * (1.0f + th);
}
__device__ __forceinline__ int kt_off(int key, int d) { return (((key >> 4) * 2 + (d >> 5)) * 64 + ((d & 31) >> 3) * 16 + (key & 15)) * 8 + (d & 7); }
__device__ __forceinline__ int vt_off(int key, int d) { return ((((key >> 5) * 4 + (d >> 4)) * 64) + ((key & 15) >> 2) * 16 + (d & 15)) * 8 + (key & 3) + 4 * ((key >> 4) & 1); }

__device__ __forceinline__ void cmp2_phase(const float* hid, const float* bias, const float* w2k, const float* w2v, bf16* kc_t, bf16* vc_t, int gw, int NGW, int lane) {
    for (int m = gw; m < 8192; m += NGW) {
        const int kv = m >> 12, bg = (m >> 10) & 3, n = m & 1023;
        const float* hr = hid + (size_t)m * 256; const float* bs = bias + kv * 256; const float* w2 = kv == 0 ? w2k : w2v;
        float a[4];
#pragma unroll
        for (int i = 0; i < 4; ++i) a[i] = gelu_tanh(hr[lane + 64 * i] + bs[lane + 64 * i]);
        float o = 0.f;
#pragma unroll
        for (int i = 0; i < 4; ++i)
#pragma unroll 16
            for (int c = 0; c < 64; ++c) o += __shfl(a[i], c) * w2[(size_t)(64 * i + c) * 64 + lane];
        if (n == 1023) o = 0.f;
        const unsigned short ob = (unsigned short)(pkc(o, 0.f) & 0xffffu);
        if (kv == 0) kc_t[(size_t)bg * 65536 + kt_off(n, lane)] = ob; else vc_t[(size_t)bg * 65536 + vt_off(n, lane)] = ob;
    }
}
__device__ __forceinline__ void vretile(const bf16* vrm, bf16* vt, int gw, int NGW, int lane) {
    for (int it = gw; it < 4 * (SEQ / 32); it += NGW) {
        const int bg = it / (SEQ / 32), kg = it % (SEQ / 32);
        const bf16* src = vrm + ((size_t)bg * SEQ + kg * 32) * 64; bf16* dst = vt + (size_t)bg * SEQ * 64;
#pragma unroll
        for (int g4 = 0; g4 < 4; ++g4) { unsigned short e[8];
#pragma unroll
            for (int j = 0; j < 8; ++j) { const int key = 4 * g4 + (j & 3) + 16 * (j >> 2); e[j] = src[key * 64 + lane]; }
            v4u w; w.x = e[0] | ((unsigned)e[1] << 16); w.y = e[2] | ((unsigned)e[3] << 16); w.z = e[4] | ((unsigned)e[5] << 16); w.w = e[6] | ((unsigned)e[7] << 16);
            *(GAS v4u*)(dst + (size_t)((kg * 4 + (lane >> 4)) * 64 + g4 * 16 + (lane & 15)) * 8) = w; }
    }
}

__device__ __forceinline__ void acmp_item(const bf16* qraw_ocmp, bf16* ocmp, const bf16* kc_t, const bf16* vc_t, float* scores, int bg, int qt, int lane) {
    const int col = lane & 15, g4 = lane >> 4, b = bg >> 1, g = bg & 1;
    const int t = 16 * qt + col; const size_t row = (size_t)b * SEQ + t;
    const int nmax = (t - 31) >> 4;
    const int ntiles = (qt + 15) >> 4;
    bf16x8 qf[4][2];
#pragma unroll
    for (int hh = 0; hh < 4; ++hh)
#pragma unroll
        for (int s = 0; s < 2; ++s) qf[hh][s] = *(const bf16x8*)(qraw_ocmp + row * 512 + (4 * g + hh) * 64 + 32 * s + 8 * g4);
    const bf16* kb = kc_t + (size_t)bg * 65536 + lane * 8; const bf16* vb = vc_t + (size_t)bg * 65536 + lane * 8;
    float mx[4], ls[4];
#pragma unroll
    for (int hh = 0; hh < 4; ++hh) { mx[hh] = -1e30f; ls[hh] = 0.f; }
    const f32x4 zero = {0.f, 0.f, 0.f, 0.f};
    for (int T = 0; T < ntiles; ++T) {
        const bf16x8 k0 = *(const bf16x8*)(kb + (T * 2 + 0) * 512), k1 = *(const bf16x8*)(kb + (T * 2 + 1) * 512);
#pragma unroll
        for (int hh = 0; hh < 4; ++hh) {
            f32x4 s = mfma16(k0, qf[hh][0], zero); s = mfma16(k1, qf[hh][1], s);
            float e[4]; float mt = mx[hh];
#pragma unroll
            for (int r = 0; r < 4; ++r) { const bool valid = (16 * T + 4 * g4 + r) <= nmax; e[r] = valid ? s[r] * C2 : -1e30f; mt = fmaxf(mt, e[r]); }
            float add = 0.f;
#pragma unroll
            for (int r = 0; r < 4; ++r) { const bool valid = (16 * T + 4 * g4 + r) <= nmax; add += valid ? ex2(e[r] - mt) : 0.f; }
            ls[hh] = ls[hh] * ex2(mx[hh] - mt) + add; mx[hh] = mt;
        }
    }
#pragma unroll
    for (int hh = 0; hh < 4; ++hh) {
        float Mx = fmaxf(mx[hh], __shfl_xor(mx[hh], 16)); Mx = fmaxf(Mx, __shfl_xor(Mx, 32));
        float l = ls[hh] * ex2(mx[hh] - Mx); l += __shfl_xor(l, 16); l += __shfl_xor(l, 32);
        mx[hh] = Mx; ls[hh] = l > 0.f ? 1.0f / l : 0.f;
    }
    f32x4 O[4][4];
#pragma unroll
    for (int hh = 0; hh < 4; ++hh)
#pragma unroll
        for (int dt = 0; dt < 4; ++dt) O[hh][dt] = zero;
    float carry = 0.f;
    const int npairs = (ntiles + 1) >> 1;
    float* srow = scores + (row * 2 + g) * 256;
    for (int kg = 0; kg < npairs; ++kg) {
        bf16x8 vf[4];
#pragma unroll
        for (int dt = 0; dt < 4; ++dt) vf[dt] = *(const bf16x8*)(vb + (kg * 4 + dt) * 512);
        f32x4 p[2][4]; float aa[2], bb[2];
#pragma unroll
        for (int tt = 0; tt < 2; ++tt) {
            const int T = 2 * kg + tt;
            const bf16x8 k0 = *(const bf16x8*)(kb + (T * 2 + 0) * 512), k1 = *(const bf16x8*)(kb + (T * 2 + 1) * 512);
            aa[tt] = 0.f; bb[tt] = 0.f;
#pragma unroll
            for (int hh = 0; hh < 4; ++hh) {
                f32x4 s = mfma16(k0, qf[hh][0], zero); s = mfma16(k1, qf[hh][1], s);
#pragma unroll
                for (int r = 0; r < 4; ++r) { const bool valid = (16 * T + 4 * g4 + r) <= nmax; p[tt][hh][r] = valid ? ex2(s[r] * C2 - mx[hh]) * ls[hh] : 0.f; }
                aa[tt] += 2.0f * (p[tt][hh][0] + p[tt][hh][1] + p[tt][hh][2]) + p[tt][hh][3]; bb[tt] += p[tt][hh][3];
            }
        }
#pragma unroll
        for (int hh = 0; hh < 4; ++hh) { const bf16x8 pf = pack8(p[0][hh], p[1][hh]);
#pragma unroll
            for (int dt = 0; dt < 4; ++dt) O[hh][dt] = mfma16(vf[dt], pf, O[hh][dt]); }
#pragma unroll
        for (int tt = 0; tt < 2; ++tt) {
            const int T = 2 * kg + tt;
            const float bsh = __shfl(bb[tt], (lane + 48) & 63);
            const float val = aa[tt] + (g4 == 0 ? carry : bsh);
            carry = bsh;
            srow[4 * T + g4] = val;
        }
    }
    for (int j = 8 * npairs + g4; j < NSELB; j += 4) srow[j] = (j == 8 * npairs) ? carry : 0.f;
#pragma unroll
    for (int hh = 0; hh < 4; ++hh)
#pragma unroll
        for (int dt = 0; dt < 4; ++dt) { const f32x4 o = O[hh][dt];
            *(GAS v2u*)(ocmp + row * 512 + (4 * g + hh) * 64 + 16 * dt + 4 * g4) = (v2u){pkc(o[0], o[1]), pkc(o[2], o[3])}; }
}

__device__ __forceinline__ void sel_phase(const float* scores, int* idx, int gw, int NGW, int lane) {
    for (int it = gw; it < M * 2; it += NGW) {
        const int row = it >> 1; const int t = row & (SEQ - 1), cur = t >> 6;
        const f32x4 sv = *((const GAS f32x4*)(scores + (size_t)it * 256) + lane);
        float v0, v1, v2, v3;
        { const int j = 4 * lane;
          v0 = (j + 0 <= cur) ? ((j + 0 == 0 || j + 0 == cur || j + 0 == cur - 1) ? 1e9f : sv[0]) : -1e30f;
          v1 = (j + 1 <= cur) ? ((j + 1 == cur || j + 1 == cur - 1) ? 1e9f : sv[1]) : -1e30f;
          v2 = (j + 2 <= cur) ? ((j + 2 == cur || j + 2 == cur - 1) ? 1e9f : sv[2]) : -1e30f;
          v3 = (j + 3 <= cur) ? ((j + 3 == cur || j + 3 == cur - 1) ? 1e9f : sv[3]) : -1e30f; }
        int mine = -1;
#pragma unroll 1
        for (int k = 0; k < KTOP; ++k) {
            float bv = v0; int bi = 4 * lane;
            if (v1 > bv) { bv = v1; bi = 4 * lane + 1; }
            if (v2 > bv) { bv = v2; bi = 4 * lane + 2; }
            if (v3 > bv) { bv = v3; bi = 4 * lane + 3; }
#pragma unroll
            for (int o = 1; o < 64; o <<= 1) { const float ov = __shfl_xor(bv, o); const int oi = __shfl_xor(bi, o); if (ov > bv || (ov == bv && oi < bi)) { bv = ov; bi = oi; } }
            if (lane == k) mine = (bv > -1e29f) ? bi : -1;
            if ((bi >> 2) == lane) { const int sl = bi & 3; if (sl == 0) v0 = -3e38f; else if (sl == 1) v1 = -3e38f; else if (sl == 2) v2 = -3e38f; else v3 = -3e38f; }
        }
        if (lane < KTOP) idx[(size_t)it * KTOP + lane] = mine;
    }
}

__device__ __forceinline__ void aslc_item(const bf16* qrot, const bf16* ks_t, const bf16* vs_t, const int* idx, bf16* oslc, int row, int g, int lane) {
    const int col = lane & 15, g4 = lane >> 4, b = row >> 14, t = row & (SEQ - 1), bg = b * 2 + g, cur = t >> 6;
    const int myidx = (lane < KTOP) ? idx[((size_t)row * 2 + g) * KTOP + lane] : -1;
    const int nsel = __builtin_popcountll(__ballot(myidx >= 0));
    bf16x8 qf[2];
#pragma unroll
    for (int s = 0; s < 2; ++s) { if (col < 4) qf[s] = *(const bf16x8*)(qrot + (size_t)row * 512 + (4 * g + col) * 64 + 32 * s + 8 * g4); else qf[s] = (bf16x8){0, 0, 0, 0, 0, 0, 0, 0}; }
    const bf16* kb = ks_t + (size_t)bg * SEQ * 64 + lane * 8; const bf16* vb = vs_t + (size_t)bg * SEQ * 64 + lane * 8;
    const f32x4 zero = {0.f, 0.f, 0.f, 0.f};
    f32x4 O[4] = {zero, zero, zero, zero}; float Mx = -1e30f, l = 0.f;
    for (int k = 0; k < nsel; ++k) {
        const int blk = __builtin_amdgcn_readlane(myidx, k);
        bf16x8 kf[4][2], vf[2][4];
#pragma unroll
        for (int T = 0; T < 4; ++T)
#pragma unroll
            for (int s = 0; s < 2; ++s) kf[T][s] = *(const bf16x8*)(kb + (size_t)((blk * 4 + T) * 2 + s) * 512);
#pragma unroll
        for (int ks = 0; ks < 2; ++ks)
#pragma unroll
            for (int dt = 0; dt < 4; ++dt) vf[ks][dt] = *(const bf16x8*)(vb + (size_t)((blk * 2 + ks) * 4 + dt) * 512);
        f32x4 e[4]; float mt = -1e30f;
        const bool diag = (blk == cur);
#pragma unroll
        for (int T = 0; T < 4; ++T) { f32x4 s = mfma16(kf[T][0], qf[0], zero); s = mfma16(kf[T][1], qf[1], s);
#pragma unroll
            for (int r = 0; r < 4; ++r) { const bool valid = !diag || (64 * blk + 16 * T + 4 * g4 + r) <= t; e[T][r] = valid ? s[r] * C2 : -1e30f; mt = fmaxf(mt, e[T][r]); } }
        mt = fmaxf(mt, __shfl_xor(mt, 16)); mt = fmaxf(mt, __shfl_xor(mt, 32));
        const float Mn = fmaxf(Mx, mt), alpha = ex2(Mx - Mn); Mx = Mn;
        float add = 0.f;
#pragma unroll
        for (int T = 0; T < 4; ++T)
#pragma unroll
            for (int r = 0; r < 4; ++r) { const float pv = (e[T][r] > -1e29f) ? ex2(e[T][r] - Mn) : 0.f; e[T][r] = pv; add += pv; }
        l = l * alpha + add;
#pragma unroll
        for (int dt = 0; dt < 4; ++dt) O[dt] = O[dt] * alpha;
#pragma unroll
        for (int ks = 0; ks < 2; ++ks) { const bf16x8 pf = pack8(e[2 * ks], e[2 * ks + 1]);
#pragma unroll
            for (int dt = 0; dt < 4; ++dt) O[dt] = mfma16(vf[ks][dt], pf, O[dt]); }
    }
    l += __shfl_xor(l, 16); l += __shfl_xor(l, 32);
    const float inv = l > 0.f ? 1.0f / l : 0.f;
    if (col < 4) {
#pragma unroll
        for (int dt = 0; dt < 4; ++dt) { const f32x4 o = O[dt] * inv;
            *(GAS v2u*)(oslc + (size_t)row * 512 + (4 * g + col) * 64 + 16 * dt + 4 * g4) = (v2u){pkc(o[0], o[1]), pkc(o[2], o[3])}; }
    }
}

__device__ __forceinline__ void awin_item(const bf16* qrot, bf16* owin, const bf16* kw_t, const bf16* vw_t, int b, int h, int qt, int lane) {
    const int col = lane & 15, g4 = lane >> 4, g = h >> 2, bg = b * 2 + g;
    const int t = 16 * qt + col; const size_t row = (size_t)b * SEQ + t;
    bf16x8 qf[2];
#pragma unroll
    for (int s = 0; s < 2; ++s) qf[s] = *(const bf16x8*)(qrot + row * 512 + h * 64 + 32 * s + 8 * g4);
    const bf16* kb = kw_t + (size_t)bg * SEQ * 64 + lane * 8; const bf16* vb = vw_t + (size_t)bg * SEQ * 64 + lane * 8;
    const f32x4 zero = {0.f, 0.f, 0.f, 0.f};
    f32x4 O[4] = {zero, zero, zero, zero}; float Mx = -1e30f, l = 0.f;
    const int tlo = qt - 32 > 0 ? qt - 32 : 0, kg0 = tlo >> 1, kg1 = qt >> 1;
    for (int kg = kg0; kg <= kg1; ++kg) {
        bf16x8 kf[2][2], vf[4];
#pragma unroll
        for (int tt = 0; tt < 2; ++tt)
#pragma unroll
            for (int s = 0; s < 2; ++s) kf[tt][s] = *(const bf16x8*)(kb + (size_t)((2 * kg + tt) * 2 + s) * 512);
#pragma unroll
        for (int dt = 0; dt < 4; ++dt) vf[dt] = *(const bf16x8*)(vb + (size_t)(kg * 4 + dt) * 512);
        f32x4 e[2]; float mt = -1e30f;
#pragma unroll
        for (int tt = 0; tt < 2; ++tt) { f32x4 s = mfma16(kf[tt][0], qf[0], zero); s = mfma16(kf[tt][1], qf[1], s);
#pragma unroll
            for (int r = 0; r < 4; ++r) { const int df = t - (32 * kg + 16 * tt + 4 * g4 + r); const bool valid = df >= 0 && df < 512; e[tt][r] = valid ? s[r] * C2 : -1e30f; mt = fmaxf(mt, e[tt][r]); } }
        mt = fmaxf(mt, __shfl_xor(mt, 16)); mt = fmaxf(mt, __shfl_xor(mt, 32));
        const float Mn = fmaxf(Mx, mt), alpha = ex2(Mx - Mn); Mx = Mn;
        float add = 0.f;
#pragma unroll
        for (int tt = 0; tt < 2; ++tt)
#pragma unroll
            for (int r = 0; r < 4; ++r) { const float pv = (e[tt][r] > -1e29f) ? ex2(e[tt][r] - Mn) : 0.f; e[tt][r] = pv; add += pv; }
        l = l * alpha + add;
        const bf16x8 pf = pack8(e[0], e[1]);
#pragma unroll
        for (int dt = 0; dt < 4; ++dt) O[dt] = mfma16(vf[dt], pf, O[dt] * alpha);
    }
    l += __shfl_xor(l, 16); l += __shfl_xor(l, 32);
    const float inv = l > 0.f ? 1.0f / l : 0.f;
#pragma unroll
    for (int dt = 0; dt < 4; ++dt) { const f32x4 o = O[dt] * inv;
        *(GAS v2u*)(owin + row * 512 + h * 64 + 16 * dt + 4 * g4) = (v2u){pkc(o[0], o[1]), pkc(o[2], o[3])}; }
}

__device__ __forceinline__ void unpack8(const v4u w, float (&f)[8]) { f[0] = bf_lo(w.x); f[1] = bf_hi(w.x); f[2] = bf_lo(w.y); f[3] = bf_hi(w.y); f[4] = bf_lo(w.z); f[5] = bf_hi(w.z); f[6] = bf_lo(w.w); f[7] = bf_hi(w.w); }
__device__ __forceinline__ void mrg_phase(const bf16* ocmp, const bf16* oslc, const bf16* owin, const float* gates, const bf16* bgp, const bf16* cgp, const bf16* xcp, const float* convw, bf16* merged, int gw, int NGW, int lane) {
    float w0[8], w1[8], w2[8];
#pragma unroll
    for (int j = 0; j < 8; ++j) { w0[j] = convw[8 * lane + j]; w1[j] = convw[512 + 8 * lane + j]; w2[j] = convw[1024 + 8 * lane + j]; }
    for (int row = gw; row < M; row += NGW) {
        const int t = row & (SEQ - 1); const size_t o = (size_t)row * 512 + 8 * lane;
        float a[8], c[8], d[8], att[8];
        unpack8(*(const GAS v4u*)(ocmp + o), a); unpack8(*(const GAS v4u*)(oslc + o), c); unpack8(*(const GAS v4u*)(owin + o), d);
        const float* gr = gates + (size_t)row * NGATE + (lane >> 3) * 3; const float g0 = gr[0], g1 = gr[1], g2 = gr[2];
        float sa = 0.f;
#pragma unroll
        for (int j = 0; j < 8; ++j) { att[j] = g0 * a[j] + g1 * c[j] + g2 * d[j]; sa += att[j] * att[j]; }
        float bgv[8], u0[8], u1[8], u2[8], tmp[8];
        unpack8(*(const GAS v4u*)(bgp + o), bgv);
        unpack8(*(const GAS v4u*)(cgp + o), u2); unpack8(*(const GAS v4u*)(xcp + o), tmp);
#pragma unroll
        for (int j = 0; j < 8; ++j) u2[j] *= tmp[j];
        if (t >= 1) { unpack8(*(const GAS v4u*)(cgp + o - 512), u1); unpack8(*(const GAS v4u*)(xcp + o - 512), tmp);
#pragma unroll
            for (int j = 0; j < 8; ++j) u1[j] *= tmp[j]; }
        else {
#pragma unroll
            for (int j = 0; j < 8; ++j) u1[j] = 0.f; }
        if (t >= 2) { unpack8(*(const GAS v4u*)(cgp + o - 1024), u0); unpack8(*(const GAS v4u*)(xcp + o - 1024), tmp);
#pragma unroll
            for (int j = 0; j < 8; ++j) u0[j] *= tmp[j]; }
        else {
#pragma unroll
            for (int j = 0; j < 8; ++j) u0[j] = 0.f; }
        float y[8]; float sc = 0.f;
#pragma unroll
        for (int j = 0; j < 8; ++j) { y[j] = bgv[j] * (w0[j] * u0[j] + w1[j] * u1[j] + w2[j] * u2[j]); sc += y[j] * y[j]; }
        sa = wave_sum(sa); sc = wave_sum(sc);
        const float ra = 1.0f / sqrtf(sa * (1.0f / 512.0f) + EPS), rc = 1.0f / sqrtf(sc * (1.0f / 512.0f) + EPS);
        v4u wa, wc;
        wa.x = pkc(att[0] * ra, att[1] * ra); wa.y = pkc(att[2] * ra, att[3] * ra); wa.z = pkc(att[4] * ra, att[5] * ra); wa.w = pkc(att[6] * ra, att[7] * ra);
        wc.x = pkc(y[0] * rc, y[1] * rc); wc.y = pkc(y[2] * rc, y[3] * rc); wc.z = pkc(y[4] * rc, y[5] * rc); wc.w = pkc(y[6] * rc, y[7] * rc);
        *(GAS v4u*)(merged + (size_t)row * DM + 8 * lane) = wa; *(GAS v4u*)(merged + (size_t)row * DM + 512 + 8 * lane) = wc;
    }
}

struct Args { const void* in[25]; float* out; unsigned char* ws; int ph_lo, ph_hi; };
__device__ __forceinline__ unsigned char* opaque_ptr(unsigned char* p) { GAS unsigned char* g = (GAS unsigned char*)p; asm volatile("" : "+s"(g)); return (unsigned char*)g; }
__device__ __forceinline__ int opaque_v(int v) { asm volatile("" : "+v"(v)); return v; }
#define PH_LOCALS \
    unsigned char* ws = opaque_ptr(args.ws); \
    const int tid = opaque_v((int)threadIdx.x), lane = tid & 63, wave = __builtin_amdgcn_readfirstlane(tid >> 6); \
    const int G = gridDim.x, bx = blockIdx.x, vcu = (G % 8 == 0) ? (bx % 8) * (G / 8) + bx / 8 : bx, gw = vcu * NWAVES + wave, NGW = G * NWAVES; \
    (void)lane; (void)gw; (void)NGW; (void)ws; (void)bx;
#define INF(k) ((const float*)args.in[k])
#define WSP(T, off) ((T*)(ws + (off)))

__global__ void __launch_bounds__(NWAVES * 64, 2) mk_fwd(Args args) {
    extern __shared__ __attribute__((aligned(16))) unsigned char lds_raw[];
    LAS unsigned char* lds = (LAS unsigned char*)lds_raw;
    const int lo = args.ph_lo, hi = args.ph_hi;
    XcdBarrier bar; bar.bar = (unsigned*)(args.ws + WS_CTL) + CW_BAR; bar.x = 0; bar.st = nullptr;
    {
        const int tid0 = threadIdx.x;
        for (int u = tid0; u < (LDS_BYTES - RING_BYTES) / 4; u += NWAVES * 64) ((LAS unsigned*)(lds + RING_BYTES))[u] = 0u;
        __syncthreads();
        if (hi - lo > 1) bar = xcd_barrier_post((unsigned*)(args.ws + WS_CTL) + CW_BAR, (volatile LAS unsigned*)(lds + MISC_OFF) + 8);
    }
#define IN(k) (lo <= (k) && (k) < hi)
#define SEAM(k) do { if (IN(k) && IN((k) + 1)) xcd_barrier(bar); } while (0)

    if (EN(0) && IN(0)) {
        PH_LOCALS
        In I;
        I.x = INF(0); I.pos = (const int*)args.in[1]; I.f1_pre = INF(2); I.f1_wg = INF(3); I.f1_wu = INF(4); I.f1_wd = INF(5);
        I.f1_post = INF(6); I.mix_pre = INF(7); I.w_in = INF(8); I.pe_k = INF(9); I.w1_k = INF(10); I.w2_k = INF(11);
        I.pe_v = INF(12); I.w1_v = INF(13); I.w2_v = INF(14); I.conv_w = INF(15); I.aon = INF(16); I.con = INF(17);
        I.w_out = INF(18); I.mix_post = INF(19); I.f2_pre = INF(20); I.f2_wg = INF(21); I.f2_wu = INF(22); I.f2_wd = INF(23); I.f2_post = INF(24);
        pro_weights(I, ws, (LAS float*)(lds + wave * 16384), gw, NGW, lane);
        pro_rope(I.pos, WSP(float, WS_ROPE), vcu * NWAVES * 64 + tid, G * NWAVES * 64);
        for (int m = gw; m < M; m += NGW) pro_xrow(I.x + (size_t)m * DM, WSP(bf16, WS_XB) + (size_t)m * DM, WSP(float, WS_RSTD) + m, lane);
    }
    SEAM(0);

    for (int l = 0; l < NLAYER; ++l) {
        const int P = 1 + l * PH_PER_LAYER;
        if (hi <= P || lo >= P + PH_PER_LAYER) continue;
        if (EN(1) && IN(P + 0)) {
            PH_LOCALS
            pg8::Gemm g{WSP(bf16, WS_XB), WSP(const bf16, WS_W + (size_t)l * W_LAYER + WO_GU1), M, 2 * DFF, DM, DM, DM}; pg8::StaticOrder S; S.init(M, 2 * DFF, G, bx);
            pg8::EpiSwiGLU E{WSP(bf16, WS_BIG), DFF, WSP(float, WS_RSTD)};
            pg8::gemm_phase<pg8::EpiSwiGLU, pg8::StaticOrder, true, true>(lds, g, S, E);
        }
        SEAM(P + 0);
        if (EN(2) && IN(P + 1)) {
            PH_LOCALS
            pg8::Gemm g{WSP(bf16, WS_BIG), WSP(const bf16, WS_W + (size_t)l * W_LAYER + WO_D1), M, DM, DFF, DFF, DFF}; pg8::StaticOrder S; S.init(M, DM, G, bx);
            pg8::EpiBf16<0> E{WSP(bf16, WS_H), DM, nullptr, 0, 0, 1.f};
            pg8::gemm_phase<pg8::EpiBf16<0>, pg8::StaticOrder, true, true>(lds, g, S, E);
        }
        SEAM(P + 1);
        if (EN(3) && IN(P + 2)) { PH_LOCALS rowpass(l == 0 ? INF(0) : args.out, args.out, WSP(bf16, WS_H), INF(6) + (size_t)l * DM, 0.5f, WSP(bf16, WS_XB), WSP(float, WS_RSTD), gw, NGW, lane); }
        SEAM(P + 2);
        if (EN(4) && IN(P + 3)) {
            PH_LOCALS
            pg8::Gemm g{WSP(bf16, WS_XB), WSP(const bf16, WS_W + (size_t)l * W_LAYER + WO_IN), M, NIN, DM, DM, DM}; pg8::StaticOrder S; S.init(M, NIN, G, bx);
            pg8::EpiInProj E{ws};
            pg8::gemm_phase<pg8::EpiInProj, pg8::StaticOrder, true, true>(lds, g, S, E);
        }
        SEAM(P + 3);
        if (EN(5) && IN(P + 4)) {
            PH_LOCALS
            vretile(WSP(bf16, WS_VS_RM), WSP(bf16, WS_VS_T), gw, NGW, lane); vretile(WSP(bf16, WS_VW_RM), WSP(bf16, WS_VW_T), gw, NGW, lane);
            pg8::Gemm g{WSP(bf16, WS_KRAW), WSP(const bf16, WS_W + (size_t)l * W_LAYER + WO_W1), 8192, 512, 2048, 1024, 2048}; pg8::CmpOrder S{G, bx};
            pg8::EpiHid E{WSP(float, WS_HID)};
            pg8::gemm_phase<pg8::EpiHid, pg8::CmpOrder, true, true>(lds, g, S, E);
        }
        SEAM(P + 4);
        if (EN(6) && IN(P + 5)) { PH_LOCALS cmp2_phase(WSP(float, WS_HID), WSP(float, WS_BIAS) + l * 512, INF(11) + (size_t)l * 256 * 64, INF(14) + (size_t)l * 256 * 64, WSP(bf16, WS_KC_T), WSP(bf16, WS_VC_T), gw, NGW, lane); }
        SEAM(P + 5);
        if (EN(7) && IN(P + 6)) {
            PH_LOCALS
            for (int p = gw; p < 2048; p += NGW) { const int bg = p >> 9, i = p & 511;
                acmp_item(WSP(bf16, WS_QRAW), WSP(bf16, WS_QRAW), WSP(bf16, WS_KC_T), WSP(bf16, WS_VC_T), WSP(float, WS_SCORES), bg, i, lane);
                acmp_item(WSP(bf16, WS_QRAW), WSP(bf16, WS_QRAW), WSP(bf16, WS_KC_T), WSP(bf16, WS_VC_T), WSP(float, WS_SCORES), bg, 1023 - i, lane); }
        }
        SEAM(P + 6);
        if (EN(8) && IN(P + 7)) { PH_LOCALS sel_phase(WSP(float, WS_SCORES), WSP(int, WS_IDX), gw, NGW, lane); }
        SEAM(P + 7);
        if (EN(9) && IN(P + 8)) { PH_LOCALS for (int it = gw; it < M * 2; it += NGW) aslc_item(WSP(bf16, WS_QROT), WSP(bf16, WS_KS_T), WSP(bf16, WS_VS_T), WSP(int, WS_IDX), WSP(bf16, WS_OSLC), it >> 1, it & 1, lane); }
        SEAM(P + 8);
        if (EN(10) && IN(P + 9)) { PH_LOCALS for (int it = gw; it < BATCH * 8 * (SEQ / 16); it += NGW) { const int qt = it & 1023, h = (it >> 10) & 7, b = it >> 13; awin_item(WSP(bf16, WS_QROT), WSP(bf16, WS_QROT), WSP(bf16, WS_KW_T), WSP(bf16, WS_VW_T), b, h, qt, lane); } }
        SEAM(P + 9);
        if (EN(11) && IN(P + 10)) { PH_LOCALS mrg_phase(WSP(bf16, WS_QRAW), WSP(bf16, WS_OSLC), WSP(bf16, WS_QROT), WSP(float, WS_GATES), WSP(bf16, WS_BG), WSP(bf16, WS_CG), WSP(bf16, WS_XC), INF(15) + (size_t)l * 3 * 512, WSP(bf16, WS_MERGED), gw, NGW, lane); }
        SEAM(P + 10);
        if (EN(12) && IN(P + 11)) {
            PH_LOCALS
            pg8::Gemm g{WSP(bf16, WS_MERGED), WSP(const bf16, WS_W + (size_t)l * W_LAYER + WO_O), M, DM, DM, DM, DM}; pg8::StaticOrder S; S.init(M, DM, G, bx);
            pg8::EpiBf16<0> E{WSP(bf16, WS_H), DM, nullptr, 0, 0, 1.f};
            pg8::gemm_phase<pg8::EpiBf16<0>, pg8::StaticOrder, true, true>(lds, g, S, E);
        }
        SEAM(P + 11);
        if (EN(13) && IN(P + 12)) { PH_LOCALS rowpass(args.out, args.out, WSP(bf16, WS_H), INF(19) + (size_t)l * DM, 1.0f, WSP(bf16, WS_XB), WSP(float, WS_RSTD), gw, NGW, lane); }
        SEAM(P + 12);
        if (EN(14) && IN(P + 13)) {
            PH_LOCALS
            pg8::Gemm g{WSP(bf16, WS_XB), WSP(const bf16, WS_W + (size_t)l * W_LAYER + WO_GU2), M, 2 * DFF, DM, DM, DM}; pg8::StaticOrder S; S.init(M, 2 * DFF, G, bx);
            pg8::EpiSwiGLU E{WSP(bf16, WS_BIG), DFF, WSP(float, WS_RSTD)};
            pg8::gemm_phase<pg8::EpiSwiGLU, pg8::StaticOrder, true, true>(lds, g, S, E);
        }
        SEAM(P + 13);
        if (EN(15) && IN(P + 14)) {
            PH_LOCALS
            pg8::Gemm g{WSP(bf16, WS_BIG), WSP(const bf16, WS_W + (size_t)l * W_LAYER + WO_D2), M, DM, DFF, DFF, DFF}; pg8::StaticOrder S; S.init(M, DM, G, bx);
            pg8::EpiBf16<0> E{WSP(bf16, WS_H), DM, nullptr, 0, 0, 1.f};
            pg8::gemm_phase<pg8::EpiBf16<0>, pg8::StaticOrder, true, true>(lds, g, S, E);
        }
        SEAM(P + 14);
        if (EN(16) && IN(P + 15)) { PH_LOCALS rowpass(args.out, args.out, WSP(bf16, WS_H), INF(24) + (size_t)l * DM, 0.5f, WSP(bf16, WS_XB), WSP(float, WS_RSTD), gw, NGW, lane); }
        if (l != NLAYER - 1) SEAM(P + 15);
    }
#undef IN
#undef SEAM
}

extern "C" void kernel_launch(void* const* d_in, const int* in_sizes, int n_in, void* d_out, int out_size, void* d_ws, size_t ws_size, hipStream_t stream) {
    static int grid = 0;
    if (grid == 0) {
        if (n_in != 25 || out_size != M * DM || ws_size < WS_END) { fprintf(stderr, "kernel_launch: unexpected shapes (n_in %d out %d ws %zu)\n", n_in, out_size, ws_size); grid = -1; return; }
        int dev = 0, cus = 0, per_cu = 0;
        if (hipGetDevice(&dev) != hipSuccess || hipDeviceGetAttribute(&cus, hipDeviceAttributeMultiprocessorCount, dev) != hipSuccess) { grid = -1; return; }
        if (hipFuncSetAttribute((const void*)mk_fwd, hipFuncAttributeMaxDynamicSharedMemorySize, LDS_BYTES) != hipSuccess) { fprintf(stderr, "kernel_launch: hipFuncSetAttribute failed\n"); grid = -1; return; }
        if (hipOccupancyMaxActiveBlocksPerMultiprocessor(&per_cu, (const void*)mk_fwd, NWAVES * 64, LDS_BYTES) != hipSuccess || per_cu < 1) fprintf(stderr, "kernel_launch: occupancy query reports %d\n", per_cu);
        (void)hipGetLastError();
        grid = cus;
    }
    if (grid < 0) return;
    if (hipMemsetAsync((char*)d_ws + WS_CTL, 0, CTL_ZERO_BYTES, stream) != hipSuccess) return;
    Args a{};
    for (int i = 0; i < 25; ++i) a.in[i] = d_in[i];
    a.out = (float*)d_out; a.ws = (unsigned char*)d_ws;
#if MK_ONE_LAUNCH
    a.ph_lo = 0; a.ph_hi = N_PHASES;
    hipLaunchKernelGGL(mk_fwd, dim3(grid), dim3(NWAVES * 64), LDS_BYTES, stream, a);
#else
    for (int p = 0; p < N_PHASES; ++p) { a.ph_lo = p; a.ph_hi = p + 1; hipLaunchKernelGGL(mk_fwd, dim3(grid), dim3(NWAVES * 64), LDS_BYTES, stream, a); }
#endif
}
```

```cpp
#include <hip/hip_runtime.h>
#include <cstdio>
#include <cstdint>
constexpr int NWAVES = 8;
constexpr int BATCH = 2, SEQ = 16384, DM = 1024, M = BATCH * SEQ, DFF = 2816, NIN = 3072, NLAYER = 2;
constexpr int DATT = 512, NGATE = 24, NSELB = 256, KTOP = 16;
constexpr float EPS = 1e-6f;
constexpr float C2 = 0.125f * 1.4426950408889634f;
constexpr size_t MiB = 1u << 20;
constexpr size_t WS_CTL = 0, CTL_ZERO_BYTES = 1 * MiB;
constexpr size_t WS_W = 2 * MiB, W_LAYER = 43 * MiB;
constexpr size_t WO_GU1 = 0, WO_D1 = 11 * MiB, WO_IN = 11 * MiB + 5632 * 1024, WO_O = WO_IN + 6 * MiB, WO_GU2 = WO_O + 2 * MiB, WO_D2 = WO_GU2 + 11 * MiB, WO_W1 = WO_D2 + 5632 * 1024;
static_assert(WO_W1 + 2 * MiB == W_LAYER, "weight map");
constexpr size_t WS_XB = 88 * MiB;
constexpr size_t WS_H = 152 * MiB;
constexpr size_t WS_BIG = 216 * MiB;
constexpr size_t WS_QRAW = WS_BIG, WS_QROT = WS_BIG + 32 * MiB, WS_OSLC = WS_BIG + 64 * MiB, WS_BG = WS_BIG + 96 * MiB, WS_CG = WS_BIG + 128 * MiB, WS_KRAW = WS_BIG + 160 * MiB, WS_VRAW = WS_KRAW + 8 * MiB;
constexpr size_t WS_XC = 392 * MiB, WS_KS_T = 424 * MiB, WS_KW_T = 432 * MiB, WS_VS_T = 440 * MiB, WS_VW_T = 448 * MiB, WS_GATES = 456 * MiB, WS_IDX = 460 * MiB, WS_HID = 464 * MiB;
constexpr size_t WS_KC_T = 472 * MiB, WS_VC_T = WS_KC_T + 512 * 1024, WS_ROPE = 473 * MiB, WS_RSTD = 475 * MiB, WS_BIAS = 476 * MiB, WS_END = 477 * MiB;
constexpr size_t WS_VS_RM = WS_H, WS_VW_RM = WS_H + 8 * MiB, WS_SCORES = WS_H, WS_MERGED = WS_XB;
constexpr int CW_BAR = 4096;

constexpr int RING_BYTES = 131072, MISC_OFF = RING_BYTES + 320, LDS_BYTES = 147456;

constexpr int PH_PER_LAYER = 16, N_PHASES = 1 + NLAYER * PH_PER_LAYER;
#ifndef PH_MASK
#define PH_MASK 0x1ffff
#endif
#define EN(k) (((PH_MASK) >> (k)) & 1)
#ifndef MK_ONE_LAUNCH
#define MK_ONE_LAUNCH 1
#endif

namespace pg8 {
#define PG8_LAS __attribute__((address_space(3)))
typedef unsigned short bf16_t;
typedef short bf16x8 __attribute__((ext_vector_type(8)));
typedef float f32x4 __attribute__((ext_vector_type(4)));
typedef unsigned u32x4 __attribute__((ext_vector_type(4)));
constexpr int BM = 256, BK = 64, HALF = 128, HTB = HALF * BK * 2  , STAGE_BYTES = 8 * HTB, NXCD = 8, WGM = 8;

__host__ __device__ __forceinline__ int lds_byte(int r, int c) { const int st = (r >> 4) * 2 + (c >> 5), rr = r & 15, cc = c & 31, ob = rr * 64 + cc * 2; return st * 1024 + (ob ^ (((ob >> 9) & 1) << 5)); }
__host__ __device__ __forceinline__ void stage_rc(int b, int& R, int& C) { const int st = b / 1024, sb = b % 1024, swz = sb ^ (((sb >> 9) & 1) << 5); R = (st >> 1) * 16 + swz / 64; C = (st & 1) * 32 + (swz % 64) / 2; }
__host__ __device__ __forceinline__ int perm32(int rho) { const int n = rho >> 4, i = rho & 15; return 8 * (i >> 2) + 4 * n + (i & 3); }

struct Unit { int pm, pn; };
struct Gemm { const bf16_t* A; const bf16_t* Bt; int M, N, K, lda, ldb; };

struct StaticOrder {
    int nM, nN, nwg, G, c;
    __host__ __device__ void init(int M, int N, int G_, int c_) { nM = M / BM; nN = N / BM; nwg = nM * nN; G = G_; c = c_; }
    __host__ __device__ bool next(int i, Unit& u) const {
        const long L = (long)i * G + c; if (L >= nwg) return false;
        int wgid = (int)L; { const int q = nwg / NXCD, r = nwg % NXCD, xcd = wgid % NXCD, off = wgid / NXCD; wgid = (xcd < r ? xcd * (q + 1) : r * (q + 1) + (xcd - r) * q) + off; }
        const int nig = WGM * nN, gid = wgid / nig, fm = gid * WGM, gsz = (nM - fm) < WGM ? (nM - fm) : WGM;
        u.pm = fm + ((wgid % nig) % gsz); u.pn = (wgid % nig) / gsz; return true;
    }
    __device__ __forceinline__ void a_ready(const Unit&) const {}
    __device__ __forceinline__ void done(const Unit&) const {}
};

__device__ __forceinline__ unsigned cvt_pk_bf16(float lo, float hi) { unsigned r; asm volatile("v_cvt_pk_bf16_f32 %0, %1, %2" : "=v"(r) : "v"(lo), "v"(hi)); return r; }
typedef float f32x2 __attribute__((ext_vector_type(2)));
__device__ __forceinline__ f32x2 gelu_pk(f32x2 v) {
    const f32x2 av = __builtin_elementwise_abs(v), d = av * 0.2316418882f + 1.0f;
    f32x2 t; t.x = __builtin_amdgcn_rcpf(d.x); t.y = __builtin_amdgcn_rcpf(d.y);
    f32x2 q = t * 0.5307027145f + (-0.7265760135f); q = q * t + 0.7107068705f; q = q * t + (-0.142248368f); q = q * t + 0.127414796f; q = q * t;
    const f32x2 s = (v * v) * (-0.72134752044f);
    f32x2 e; e.x = __builtin_amdgcn_exp2f(s.x); e.y = __builtin_amdgcn_exp2f(s.y);
    const f32x2 m = v * (q * e), r = v - m;
    f32x2 o; o.x = v.x < 0.f ? m.x : r.x; o.y = v.y < 0.f ? m.y : r.y; return o;
}

template <int ACT  > struct EpiBf16 {
    static constexpr bool PERM = true, AFTER_DRAIN = false; static_assert(ACT == 0 || ACT == 1, "EpiBf16: ACT is 0 (none) or 1 (gelu_pk)");
    bf16_t* O; int ldc; const float* bias; int split_cols; size_t split_stride; float scale0;
    __device__ __forceinline__ void operator()(const f32x4 (&acc)[2][2][4][2], const Unit& u, int wr, int wc, int fr, int fq) const {
        const int row0 = u.pm * BM + wr * 64 + fr; int colt = u.pn * BM; bf16_t* base = O;
        float sc = 1.f; if (split_cols) { const int t = colt / split_cols; base += (size_t)t * split_stride; colt -= t * split_cols; if (t == 0) sc = scale0; }
        const int col0 = colt + wc * 32 + 8 * fq, bcol0 = u.pn * BM + wc * 32 + 8 * fq;
        f32x4 bv[2][2];
#pragma unroll
        for (int bj = 0; bj < 2; ++bj)
#pragma unroll
            for (int n = 0; n < 2; ++n) bv[bj][n] = bias ? *(const f32x4*)(bias + bcol0 + bj * HALF + 4 * n) : (f32x4){0.f, 0.f, 0.f, 0.f};
#pragma unroll
        for (int ai = 0; ai < 2; ++ai)
#pragma unroll
            for (int m = 0; m < 4; ++m) { bf16_t* rowp = base + (size_t)(row0 + ai * HALF + m * 16) * ldc + col0;
#pragma unroll
                for (int bj = 0; bj < 2; ++bj) { f32x4 v0 = acc[ai][bj][m][0] + bv[bj][0], v1 = acc[ai][bj][m][1] + bv[bj][1];
                    if (ACT == 1) { f32x2 a = gelu_pk((f32x2){v0[0], v0[1]}), b = gelu_pk((f32x2){v0[2], v0[3]}), c = gelu_pk((f32x2){v1[0], v1[1]}), d = gelu_pk((f32x2){v1[2], v1[3]});
                        v0 = (f32x4){a.x, a.y, b.x, b.y}; v1 = (f32x4){c.x, c.y, d.x, d.y}; }
                    v0 = v0 * sc; v1 = v1 * sc; u32x4 w; w.x = cvt_pk_bf16(v0[0], v0[1]); w.y = cvt_pk_bf16(v0[2], v0[3]); w.z = cvt_pk_bf16(v1[0], v1[1]); w.w = cvt_pk_bf16(v1[2], v1[3]);
                    *(u32x4*)(rowp + bj * HALF) = w; } }
    }
};

constexpr int SEQ_ = SEQ;
__device__ __forceinline__ unsigned pk2c(float lo, float hi) { typedef float f2_t __attribute__((ext_vector_type(2))); typedef __bf16 b2_t __attribute__((ext_vector_type(2))); f2_t v = {lo, hi}; b2_t b = __builtin_convertvector(v, b2_t); return __builtin_bit_cast(unsigned, b); }
__device__ __forceinline__ void store8(bf16_t* dst, const f32x4& v0, const f32x4& v1) { u32x4 w; w.x = pk2c(v0[0], v0[1]); w.y = pk2c(v0[2], v0[3]); w.z = pk2c(v1[0], v1[1]); w.w = pk2c(v1[2], v1[3]); *(u32x4*)dst = w; }
__device__ __forceinline__ float silu_f(float x) { return x * __builtin_amdgcn_rcpf(1.0f + __builtin_amdgcn_exp2f(-1.4426950408889634f * x)); }
__device__ __forceinline__ float sigmoid_f(float x) { return __builtin_amdgcn_rcpf(1.0f + __builtin_amdgcn_exp2f(-1.4426950408889634f * x)); }

struct EpiSwiGLU {
    static constexpr bool PERM = true, AFTER_DRAIN = false;
    bf16_t* O; int ldc; const float* rstd;
    __device__ __forceinline__ void operator()(const f32x4 (&acc)[2][2][4][2], const Unit& u, int wr, int wc, int fr, int fq) const {
        const int row0 = u.pm * BM + wr * 64 + fr, col0 = u.pn * 128 + wc * 32 + 8 * fq;
#pragma unroll
        for (int ai = 0; ai < 2; ++ai)
#pragma unroll
            for (int m = 0; m < 4; ++m) { const int r = row0 + ai * HALF + m * 16; const float rs = rstd[r];
                const f32x4 g0 = acc[ai][0][m][0] * rs, g1 = acc[ai][0][m][1] * rs, u0 = acc[ai][1][m][0] * rs, u1 = acc[ai][1][m][1] * rs;
                f32x4 o0, o1;
#pragma unroll
                for (int j = 0; j < 4; ++j) { o0[j] = silu_f(g0[j]) * u0[j]; o1[j] = silu_f(g1[j]) * u1[j]; }
                store8(O + (size_t)r * ldc + col0, o0, o1); }
    }
};

struct EpiHid {
    static constexpr bool PERM = false, AFTER_DRAIN = false;
    float* C;
    __device__ __forceinline__ void operator()(const f32x4 (&acc)[2][2][4][2], const Unit& u, int wr, int wc, int fr, int fq) const {
        const int row0 = u.pm * BM + wr * 64 + fr, col0 = wc * 32 + 4 * fq;
#pragma unroll
        for (int ai = 0; ai < 2; ++ai)
#pragma unroll
            for (int m = 0; m < 4; ++m) { float* rowp = C + (size_t)(row0 + ai * HALF + m * 16) * 256 + col0;
#pragma unroll
                for (int bj = 0; bj < 2; ++bj)
#pragma unroll
                    for (int n = 0; n < 2; ++n) *(f32x4*)(rowp + bj * HALF + n * 16) = acc[ai][bj][m][n]; }
    }
};

__device__ __forceinline__ void rope8(f32x4& v0, f32x4& v1, const float* rope_row, int wc, int fq) {
    if ((wc & 1) == 0) {
        f32x4 o0, o1;
#pragma unroll
        for (int j = 0; j < 4; ++j) { o0[j] = __shfl_xor(v0[j], 16); o1[j] = __shfl_xor(v1[j], 16); }
        if (fq < 2) {
            const f32x4 c0 = *(const f32x4*)(rope_row), c1 = *(const f32x4*)(rope_row + 4), s0 = *(const f32x4*)(rope_row + 8), s1 = *(const f32x4*)(rope_row + 12);
            if (fq == 0) { v0 = v0 * c0 - o0 * s0; v1 = v1 * c1 - o1 * s1; }
            else         { v0 = v0 * c0 + o0 * s0; v1 = v1 * c1 + o1 * s1; }
        }
    }
}

struct EpiInProj {
    static constexpr bool PERM = true, AFTER_DRAIN = false;
    unsigned char* ws;
    __device__ __forceinline__ void operator()(const f32x4 (&acc)[2][2][4][2], const Unit& u, int wr, int wc, int fr, int fq) const {
        const float* rstd = (const float*)(ws + WS_RSTD); const float* rope = (const float*)(ws + WS_ROPE);
        bf16_t* qraw = (bf16_t*)(ws + WS_QRAW); bf16_t* qrot = (bf16_t*)(ws + WS_QROT); bf16_t* kraw = (bf16_t*)(ws + WS_KRAW); bf16_t* vraw = (bf16_t*)(ws + WS_VRAW);
        bf16_t* ks_t = (bf16_t*)(ws + WS_KS_T); bf16_t* vs_rm = (bf16_t*)(ws + WS_VS_RM); bf16_t* kw_t = (bf16_t*)(ws + WS_KW_T); bf16_t* vw_rm = (bf16_t*)(ws + WS_VW_RM);
        bf16_t* bg = (bf16_t*)(ws + WS_BG); bf16_t* cg = (bf16_t*)(ws + WS_CG); bf16_t* xc = (bf16_t*)(ws + WS_XC); float* gates = (float*)(ws + WS_GATES);
        const int pn = u.pn, row0 = u.pm * BM + wr * 64 + fr;
#pragma unroll
        for (int ai = 0; ai < 2; ++ai)
#pragma unroll
            for (int m = 0; m < 4; ++m) {
                const int r = row0 + ai * HALF + m * 16; const float rs = rstd[r];
                const int b = r >> 14, s = r & (SEQ_ - 1);
                const float* rrow = rope + (size_t)r * 16;
#pragma unroll
                for (int bj = 0; bj < 2; ++bj) {
                    f32x4 v0 = acc[ai][bj][m][0] * rs, v1 = acc[ai][bj][m][1] * rs;
                    const int ct = bj * HALF + wc * 32 + 8 * fq;
                    const int c = wc * 32 + 8 * fq, g = c >> 6, d0 = c & 63;
                    if (pn <= 1) {
                        const size_t o = (size_t)r * 512 + pn * 256 + ct;
                        store8(qraw + o, v0, v1);
                        rope8(v0, v1, rrow, wc, fq);
                        store8(qrot + o, v0, v1);
                    } else if (pn == 2) {
                        bf16_t* dst = (bj == 0 ? kraw : vraw) + ((size_t)((b * 2 + g) * SEQ_ + s)) * 64 + d0;
                        store8(dst, v0, v1);
                    } else if (pn <= 4) {
                        if (bj == 0) {
                            rope8(v0, v1, rrow, wc, fq);
                            bf16_t* base = (pn == 3 ? ks_t : kw_t) + (size_t)(b * 2 + g) * SEQ_ * 64;
                            const int off = (((s >> 4) * 2 + (d0 >> 5)) * 64 + ((d0 & 31) >> 3) * 16 + (s & 15)) * 8;
                            store8(base + off, v0, v1);
                        } else {
                            bf16_t* dst = (pn == 3 ? vs_rm : vw_rm) + ((size_t)((b * 2 + g) * SEQ_ + s)) * 64 + d0;
                            store8(dst, v0, v1);
                        }
                    } else if (pn <= 10) {
                        bf16_t* base = pn <= 6 ? bg : (pn <= 8 ? cg : xc);
                        store8(base + (size_t)r * 512 + ((pn - 5) & 1) * 256 + ct, v0, v1);
                    } else {
                        if (bj == 0 && wc == 0 && fq < 3) {
                            f32x4 a, bb;
#pragma unroll
                            for (int j = 0; j < 4; ++j) { a[j] = sigmoid_f(v0[j]); bb[j] = sigmoid_f(v1[j]); }
                            float* dst = gates + (size_t)r * 24 + 8 * fq;
                            *(f32x4*)dst = a; *(f32x4*)(dst + 4) = bb;
                        }
                    }
                }
            }
    }
};

struct CmpOrder {
    int G, c;
    __device__ __forceinline__ bool next(int i, Unit& u) const { const int L = i * G + c; if (L >= 32) return false; u.pm = L; u.pn = L >> 4; return true; }
    __device__ __forceinline__ void a_ready(const Unit&) const {}
    __device__ __forceinline__ void done(const Unit&) const {}
};
template <class Epi, class Sched, bool ALIGN_EPI = false, bool SP2 = false>
__device__ __forceinline__ void gemm_phase(PG8_LAS unsigned char* lds, const Gemm g, const Sched& S, const Epi& E) {
    int tid_ = threadIdx.x; asm volatile("" : "+v"(tid_));
    const int tid = tid_, wid = __builtin_amdgcn_readfirstlane(tid >> 6), lane = tid & 63, wr = wid >> 2, wc = wid & 3, fr = lane & 15, fq = lane >> 4;
    const int K = g.K, nt = K / BK;
    unsigned voffA[2], voffB[2];
#pragma unroll
    for (int i = 0; i < 2; ++i) { int R, C; stage_rc(tid * 16 + i * 8192, R, C); const int Rb = Epi::PERM ? ((R & ~31) + perm32(R & 31)) : R;
        voffA[i] = (unsigned)(R * g.lda + C) * 2u; voffB[i] = (unsigned)(Rb * g.ldb + C) * 2u; }
    const size_t kstep = (size_t)(BK * 2);
    const size_t hstepA = (size_t)HALF * g.lda * 2, hstepB = (size_t)HALF * g.ldb * 2;
    const size_t tstepA = 2 * hstepA, tstepB = 2 * hstepB;
    const unsigned ldsw = (unsigned)wid * 1024u;
    const int aoff = lds_byte(wr * 64 + fr, fq * 8), boff = lds_byte(wc * 32 + fr, fq * 8);
#define PG8_SA(b, h) (((b) * 2 + (h)) * HTB)
#define PG8_SB(b, h) ((4 + (b) * 2 + (h)) * HTB)
#define PG8_STAGE(bufoff, gbase, voff) do { _Pragma("unroll") for (int _i = 0; _i < 2; ++_i) \
        __builtin_amdgcn_global_load_lds((const unsigned*)((const char*)(gbase) + (voff)[_i]), (PG8_LAS unsigned*)(lds + (bufoff) + ldsw + _i * 8192), 16, 0, 0); } while (0)
#define PG8_LDA(dst, b, h) do { _Pragma("unroll") for (int m = 0; m < 4; ++m) _Pragma("unroll") for (int k = 0; k < 2; ++k) dst[m][k] = *(const PG8_LAS bf16x8*)(lds + PG8_SA(b, h) + aoff + m * 2048 + k * 1024); } while (0)
#define PG8_LDB(dst, b, h) do { _Pragma("unroll") for (int n = 0; n < 2; ++n) _Pragma("unroll") for (int k = 0; k < 2; ++k) dst[n][k] = *(const PG8_LAS bf16x8*)(lds + PG8_SB(b, h) + boff + n * 2048 + k * 1024); } while (0)
#define PG8_MMA(ai, bj, At, Bt) do { __builtin_amdgcn_s_setprio(1); _Pragma("unroll") for (int m = 0; m < 4; ++m) _Pragma("unroll") for (int n = 0; n < 2; ++n) _Pragma("unroll") for (int k = 0; k < 2; ++k) \
        acc[ai][bj][m][n] = __builtin_amdgcn_mfma_f32_16x16x32_bf16(Bt[n][k], At[m][k], acc[ai][bj][m][n], 0, 0, 0); __builtin_amdgcn_s_setprio(0); } while (0)
#define PG8_WAIT_V(n) asm volatile("s_waitcnt vmcnt(" #n ")" ::: "memory")
#define PG8_WAIT_L(n) asm volatile("s_waitcnt lgkmcnt(" #n ")" ::: "memory")
#define PG8_BAR __builtin_amdgcn_s_barrier()
#define PG8_SCHED __builtin_amdgcn_sched_barrier(0)
    Unit cur, nxt; int ui = 0;
    if (!S.next(0, cur)) return;
    f32x4 acc[2][2][4][2];
#pragma unroll
    for (int a = 0; a < 2; ++a)
#pragma unroll
        for (int b = 0; b < 2; ++b)
#pragma unroll
            for (int m = 0; m < 4; ++m)
#pragma unroll
                for (int n = 0; n < 2; ++n) acc[a][b][m][n] = (f32x4){0.f, 0.f, 0.f, 0.f};
    bf16x8 At[4][2], B0[2][2], B1[2][2];
    const char* cA = (const char*)g.A + (size_t)cur.pm * tstepA; const char* cB = (const char*)g.Bt + (size_t)cur.pn * tstepB;
    S.a_ready(cur);
    if constexpr (SP2) {
        PG8_STAGE(PG8_SB(0, 0), cB, voffB); PG8_STAGE(PG8_SB(0, 1), cB + hstepB, voffB); PG8_STAGE(PG8_SA(0, 0), cA, voffA); PG8_STAGE(PG8_SA(0, 1), cA + hstepA, voffA);
        if (wr == 1) PG8_BAR;
        PG8_WAIT_V(2); PG8_BAR;
        PG8_STAGE(PG8_SB(1, 0), cB + kstep, voffB); PG8_STAGE(PG8_SA(1, 0), cA + kstep, voffA); PG8_STAGE(PG8_SB(1, 1), cB + hstepB + kstep, voffB);
        PG8_WAIT_V(6); PG8_BAR;
    } else {
        PG8_STAGE(PG8_SB(0, 0), cB, voffB); PG8_STAGE(PG8_SA(0, 0), cA, voffA); PG8_STAGE(PG8_SB(0, 1), cB + hstepB, voffB); PG8_STAGE(PG8_SA(0, 1), cA + hstepA, voffA);
        if (wr == 1) PG8_BAR;
        PG8_WAIT_V(4); PG8_BAR;
        PG8_STAGE(PG8_SB(1, 0), cB + kstep, voffB); PG8_STAGE(PG8_SA(1, 0), cA + kstep, voffA); PG8_STAGE(PG8_SB(1, 1), cB + hstepB + kstep, voffB);
        PG8_WAIT_V(6); PG8_BAR;
    }
    for (;;) {
        const bool has_next = S.next(ui + 1, nxt);
        const char* nA = has_next ? (const char*)g.A + (size_t)nxt.pm * tstepA : cA; const char* nB = has_next ? (const char*)g.Bt + (size_t)nxt.pn * tstepB : cB;
        for (int t = 0; t < nt; t += 2) {
            const bool last = (t == nt - 2);
            const char* a1 = cA + (size_t)(t + 1) * kstep;
            const char* a2 = last ? nA : cA + (size_t)(t + 2) * kstep; const char* b2 = last ? nB : cB + (size_t)(t + 2) * kstep;
            const char* a3 = a2 + kstep; const char* b3 = b2 + kstep;
            if (last && has_next) S.a_ready(nxt);
            if constexpr (SP2) {
            PG8_LDB(B0, 0, 0); PG8_LDB(B1, 0, 1); PG8_SCHED; PG8_LDA(At, 0, 0); PG8_STAGE(PG8_SA(1, 1), a1 + hstepA, voffA);
            PG8_WAIT_V(8); PG8_WAIT_L(0); PG8_BAR; PG8_MMA(0, 0, At, B0); PG8_MMA(0, 1, At, B1); PG8_BAR; PG8_SCHED;
            PG8_LDA(At, 0, 1); PG8_STAGE(PG8_SB(0, 0), b2, voffB); PG8_STAGE(PG8_SB(0, 1), b2 + hstepB, voffB); PG8_STAGE(PG8_SA(0, 0), a2, voffA);
            PG8_WAIT_V(8); PG8_WAIT_L(0); PG8_BAR; PG8_MMA(1, 0, At, B0); PG8_MMA(1, 1, At, B1); PG8_BAR; PG8_SCHED;
            PG8_LDB(B0, 1, 0); PG8_LDB(B1, 1, 1); PG8_SCHED; PG8_LDA(At, 1, 0); PG8_STAGE(PG8_SA(0, 1), a2 + hstepA, voffA);
            PG8_WAIT_V(8); PG8_WAIT_L(0); PG8_BAR; PG8_MMA(0, 0, At, B0); PG8_MMA(0, 1, At, B1); PG8_BAR; PG8_SCHED;
            PG8_LDA(At, 1, 1); PG8_STAGE(PG8_SB(1, 0), b3, voffB); PG8_STAGE(PG8_SB(1, 1), b3 + hstepB, voffB); PG8_STAGE(PG8_SA(1, 0), a3, voffA);
            PG8_WAIT_V(8); PG8_WAIT_L(0); PG8_BAR; PG8_MMA(1, 0, At, B0); PG8_MMA(1, 1, At, B1); PG8_BAR; PG8_SCHED;
            } else {
            PG8_LDB(B0, 0, 0); PG8_SCHED; PG8_LDA(At, 0, 0); PG8_STAGE(PG8_SA(1, 1), a1 + hstepA, voffA);
            PG8_WAIT_L(8); PG8_BAR; PG8_WAIT_L(0); PG8_MMA(0, 0, At, B0); PG8_BAR; PG8_SCHED;
            PG8_LDB(B1, 0, 1); PG8_STAGE(PG8_SB(0, 0), b2, voffB);
            PG8_BAR; PG8_WAIT_L(0); PG8_MMA(0, 1, At, B1); PG8_BAR;
            PG8_LDA(At, 0, 1); PG8_STAGE(PG8_SA(0, 0), a2, voffA);
            PG8_BAR; PG8_WAIT_L(0); PG8_MMA(1, 0, At, B0); PG8_BAR; PG8_SCHED;
            PG8_STAGE(PG8_SB(0, 1), b2 + hstepB, voffB);
            PG8_WAIT_V(6); PG8_BAR; PG8_MMA(1, 1, At, B1); PG8_BAR;
            PG8_LDB(B0, 1, 0); PG8_SCHED; PG8_LDA(At, 1, 0); PG8_STAGE(PG8_SA(0, 1), a2 + hstepA, voffA);
            PG8_WAIT_L(8); PG8_BAR; PG8_WAIT_L(0); PG8_MMA(0, 0, At, B0); PG8_BAR; PG8_SCHED;
            PG8_LDB(B1, 1, 1); PG8_STAGE(PG8_SB(1, 0), b3, voffB);
            PG8_BAR; PG8_WAIT_L(0); PG8_MMA(0, 1, At, B1); PG8_BAR;
            PG8_LDA(At, 1, 1); PG8_STAGE(PG8_SA(1, 0), a3, voffA);
            PG8_BAR; PG8_WAIT_L(0); PG8_MMA(1, 0, At, B0); PG8_BAR; PG8_SCHED;
            PG8_STAGE(PG8_SB(1, 1), b3 + hstepB, voffB);
            PG8_WAIT_V(6); PG8_BAR; PG8_MMA(1, 1, At, B1); PG8_BAR;
            }
        }
        if constexpr (ALIGN_EPI) { if (wr == 0) PG8_BAR; }
        if constexpr (!Epi::AFTER_DRAIN) { E(acc, cur, wr, wc, fr, fq); S.done(cur); }
        if (!has_next) break;
#pragma unroll
        for (int a = 0; a < 2; ++a)
#pragma unroll
            for (int b = 0; b < 2; ++b)
#pragma unroll
                for (int m = 0; m < 4; ++m)
#pragma unroll
                    for (int n = 0; n < 2; ++n) acc[a][b][m][n] = (f32x4){0.f, 0.f, 0.f, 0.f};
        cur = nxt; cA = nA; cB = nB; ++ui;
        if constexpr (ALIGN_EPI) { if (wr == 1) PG8_BAR; }
    }
    PG8_WAIT_V(0);
    if constexpr (!ALIGN_EPI) { if (wr == 0) PG8_BAR; }
    PG8_BAR;
    if constexpr (Epi::AFTER_DRAIN) { E.fused(acc, cur, wr, wc, fr, fq, lds, wid, lane); S.done(cur); }
#undef PG8_SA
#undef PG8_SB
#undef PG8_STAGE
#undef PG8_LDA
#undef PG8_LDB
#undef PG8_MMA
#undef PG8_WAIT_V
#undef PG8_WAIT_L
#undef PG8_BAR
#undef PG8_SCHED
}
}
#define GAS __attribute__((address_space(1)))
#define LAS __attribute__((address_space(3)))
typedef unsigned short bf16;
typedef unsigned v4u __attribute__((ext_vector_type(4)));
typedef float f32x4 __attribute__((ext_vector_type(4)));
typedef short bf16x8 __attribute__((ext_vector_type(8)));
typedef GAS unsigned gu32;
typedef GAS unsigned long long gu64;
#define RLX_AGENT __ATOMIC_RELAXED, __HIP_MEMORY_SCOPE_AGENT
#define LDS_WAIT() asm volatile("s_waitcnt lgkmcnt(0)" ::: "memory")
#define VM_WAIT() asm volatile("s_waitcnt vmcnt(0)" ::: "memory")
__device__ __forceinline__ unsigned long long rt() { return __builtin_amdgcn_s_memrealtime(); }
__device__ __forceinline__ unsigned f2bf(float f) { unsigned u = __builtin_bit_cast(unsigned, f); return (u + 0x7fffu + ((u >> 16) & 1u)) >> 16; }
__device__ __forceinline__ unsigned pk2(float lo, float hi) { return f2bf(lo) | (f2bf(hi) << 16); }

#define XB_TMO      128
#define XB_XCNT(j)  (256  + 64 * (j))
#define XB_XSUB(j)  (1280 + 64 * (j))
#define XB_XGEN(j)  (2304 + 64 * (j))
#define XB_TOP      3328
#define XB_TOPGEN   3392
#define XCD_BAR_WORDS 3456
#define XB_SPIN_CAP (1u << 18)

__device__ __forceinline__ unsigned xb_ld(unsigned* p)              { return __hip_atomic_load(p, __ATOMIC_RELAXED, __HIP_MEMORY_SCOPE_AGENT); }
__device__ __forceinline__ unsigned xb_add(unsigned* p, unsigned v) { return __hip_atomic_fetch_add(p, v, __ATOMIC_RELAXED, __HIP_MEMORY_SCOPE_AGENT); }
__device__ __forceinline__ unsigned xb_xcc_id() { return (unsigned)__builtin_amdgcn_s_getreg((3 << 11) | 20) & 0xFu; }
#define XB_SPIN(cond, bar) do { unsigned _sp = 0; while (cond) { __builtin_amdgcn_s_sleep(1); \
    if ((++_sp & 255u) == 0u) { if (xb_ld(&(bar)[XB_TMO])) break; if (_sp > XB_SPIN_CAP) { atomicAdd(&(bar)[XB_TMO], 1u); break; } } } } while (0)

struct XcdBarrier {
    unsigned* bar; unsigned x;
    volatile LAS unsigned* st;
};

__device__ __forceinline__ XcdBarrier xcd_barrier_post(unsigned* bar, volatile LAS unsigned* st) {
    XcdBarrier b; b.bar = bar; b.x = xb_xcc_id(); b.st = st;
    if (threadIdx.x == 0) (void)xb_add(&bar[XB_XCNT(b.x)], 1u);
    return b;
}
__device__ __forceinline__ void xcd_barrier_complete(unsigned* bar, unsigned x, unsigned& nloc, unsigned& nx) {
    const unsigned G = gridDim.x * gridDim.y * gridDim.z;
    unsigned sum, cnt, mine, sp = 0u;
    for (;;) {
        sum = 0u; cnt = 0u; mine = 0u;
#pragma unroll
        for (unsigned j = 0; j < 16; ++j) { const unsigned c = xb_ld(&bar[XB_XCNT(j)]); sum += c; cnt += (c > 0u) ? 1u : 0u; mine = (j == x) ? c : mine; }
        if (sum == G) break;
        __builtin_amdgcn_s_sleep(1);
        if ((++sp & 255u) == 0u) { if (xb_ld(&bar[XB_TMO])) break; if (sp > XB_SPIN_CAP) { atomicAdd(&bar[XB_TMO], 1u); break; } }
    }
    nloc = mine > 0u ? mine : 1u; nx = cnt > 0u ? cnt : 1u;
}

__device__ __forceinline__ void xcd_barrier(const XcdBarrier& b) {
    asm volatile("s_waitcnt vmcnt(0)" ::: "memory");
    __syncthreads();
    if (threadIdx.x == 0) {
        unsigned* bar = b.bar;
        __builtin_amdgcn_s_waitcnt(0);
        unsigned nloc = b.st[0], nx = b.st[1];
        if (nloc == 0u) { xcd_barrier_complete(bar, b.x, nloc, nx); b.st[0] = nloc; b.st[1] = nx; }
        const unsigned old = xb_add(&bar[XB_XSUB(b.x)], 1u);
        const unsigned gen = old / nloc;
        if (old + 1u == (gen + 1u) * nloc) {
            __builtin_amdgcn_fence(__ATOMIC_RELEASE, "agent");
            asm volatile("s_waitcnt vmcnt(0)" ::: "memory");
            const unsigned og = xb_add(&bar[XB_TOP], 1u);
            const unsigned tg = og / nx;
            if (og + 1u == (tg + 1u) * nx) xb_add(&bar[XB_TOPGEN], 1u);
            else XB_SPIN(xb_ld(&bar[XB_TOPGEN]) == tg, bar);
            __builtin_amdgcn_fence(__ATOMIC_ACQUIRE, "agent");
            xb_add(&bar[XB_XGEN(b.x)], 1u);
            asm volatile("s_waitcnt vmcnt(0)" ::: "memory");
        } else {
            XB_SPIN(xb_ld(&bar[XB_XGEN(b.x)]) == gen, bar);
            __builtin_amdgcn_fence(__ATOMIC_ACQUIRE, "agent");
            asm volatile("s_waitcnt vmcnt(0)" ::: "memory");
        }
    }
    __syncthreads();
}

typedef float f32x2 __attribute__((ext_vector_type(2)));
typedef unsigned v2u __attribute__((ext_vector_type(2)));
__device__ __forceinline__ unsigned pkc(float lo, float hi) { return pg8::pk2c(lo, hi); }
__device__ __forceinline__ float bf_lo(unsigned w) { return __uint_as_float(w << 16); }
__device__ __forceinline__ float bf_hi(unsigned w) { return __uint_as_float(w & 0xffff0000u); }
__device__ __forceinline__ float wave_sum(float v) {
#pragma unroll
    for (int o = 1; o < 64; o <<= 1) v += __shfl_xor(v, o);
    return v;
}
__device__ __forceinline__ f32x4 mfma16(bf16x8 a, bf16x8 b, f32x4 c) { return __builtin_amdgcn_mfma_f32_16x16x32_bf16(a, b, c, 0, 0, 0); }
__device__ __forceinline__ float ex2(float x) { return __builtin_amdgcn_exp2f(x); }
__device__ __forceinline__ bf16x8 pack8(const f32x4& a, const f32x4& b) { v4u w; w.x = pkc(a[0], a[1]); w.y = pkc(a[2], a[3]); w.z = pkc(b[0], b[1]); w.w = pkc(b[2], b[3]); return __builtin_bit_cast(bf16x8, w); }

__device__ __forceinline__ void tr_item(const float* W, int ldw, int col0, int nvalid, const float* gain, bf16* WT, int ldt, int drow0, LAS float* scr, int kb, int n0, int lane) {
    const int k0 = 64 * kb;
#pragma unroll 8
    for (int i = 0; i < 32; ++i) { const int kk = 2 * i + (lane >> 5), n = n0 + (lane & 31);
        float v = (n < nvalid) ? W[(size_t)(k0 + kk) * ldw + col0 + n] : 0.f; if (gain) v *= gain[k0 + kk];
        scr[kk * 33 + (lane & 31)] = v; }
    LDS_WAIT(); asm volatile("" ::: "memory");
    const int c = lane & 7;
#pragma unroll
    for (int j = 0; j < 4; ++j) { const int n = (lane >> 3) + 8 * j; const LAS float* s = scr + (8 * c) * 33 + n;
        v4u o; o.x = pkc(s[0 * 33], s[1 * 33]); o.y = pkc(s[2 * 33], s[3 * 33]); o.z = pkc(s[4 * 33], s[5 * 33]); o.w = pkc(s[6 * 33], s[7 * 33]);
        *(GAS v4u*)(WT + (size_t)(drow0 + n) * ldt + k0 + 8 * c) = o; }
    LDS_WAIT(); asm volatile("" ::: "memory");
}

struct In {
    const float *x; const int* pos;
    const float *f1_pre, *f1_wg, *f1_wu, *f1_wd, *f1_post, *mix_pre, *w_in, *pe_k, *w1_k, *w2_k, *pe_v, *w1_v, *w2_v, *conv_w, *aon, *con, *w_out, *mix_post, *f2_pre, *f2_wg, *f2_wu, *f2_wd, *f2_post;
};

__device__ __forceinline__ void pro_weights(const In& I, unsigned char* ws, LAS float* scr, int gw, int NGW, int lane) {
    constexpr int I_GU = 16 * 88, I_D = 44 * 32, I_INM = 16 * 40, I_ING = 16, I_INC = 16 * 16, I_O = 16 * 32, I_W1 = 32 * 8;
    constexpr int PER_LAYER = 4 * I_GU + 2 * I_D + I_INM + I_ING + 3 * I_INC + I_O + 2 * I_W1;
    for (int it = gw; it < NLAYER * PER_LAYER; it += NGW) {
        const int l = it / PER_LAYER; int r = it % PER_LAYER;
        unsigned char* wl = ws + WS_W + (size_t)l * W_LAYER;
        if (r < I_GU) { const int kb = r / 88, n0 = 32 * (r % 88); tr_item(I.f1_wg + (size_t)l * DM * DFF, DFF, 0, DFF, I.f1_pre + (size_t)l * DM, (bf16*)(wl + WO_GU1), DM, (n0 >> 7) * 256 + (n0 & 127), scr, kb, n0, lane); continue; } r -= I_GU;
        if (r < I_GU) { const int kb = r / 88, n0 = 32 * (r % 88); tr_item(I.f1_wu + (size_t)l * DM * DFF, DFF, 0, DFF, I.f1_pre + (size_t)l * DM, (bf16*)(wl + WO_GU1), DM, (n0 >> 7) * 256 + (n0 & 127) + 128, scr, kb, n0, lane); continue; } r -= I_GU;
        if (r < I_D) { const int kb = r / 32, n0 = 32 * (r % 32); tr_item(I.f1_wd + (size_t)l * DFF * DM, DM, 0, DM, nullptr, (bf16*)(wl + WO_D1), DFF, n0, scr, kb, n0, lane); continue; } r -= I_D;
        if (r < I_GU) { const int kb = r / 88, n0 = 32 * (r % 88); tr_item(I.f2_wg + (size_t)l * DM * DFF, DFF, 0, DFF, I.f2_pre + (size_t)l * DM, (bf16*)(wl + WO_GU2), DM, (n0 >> 7) * 256 + (n0 & 127), scr, kb, n0, lane); continue; } r -= I_GU;
        if (r < I_GU) { const int kb = r / 88, n0 = 32 * (r % 88); tr_item(I.f2_wu + (size_t)l * DM * DFF, DFF, 0, DFF, I.f2_pre + (size_t)l * DM, (bf16*)(wl + WO_GU2), DM, (n0 >> 7) * 256 + (n0 & 127) + 128, scr, kb, n0, lane); continue; } r -= I_GU;
        if (r < I_D) { const int kb = r / 32, n0 = 32 * (r % 32); tr_item(I.f2_wd + (size_t)l * DFF * DM, DM, 0, DM, nullptr, (bf16*)(wl + WO_D2), DFF, n0, scr, kb, n0, lane); continue; } r -= I_D;
        const float* Win = I.w_in + (size_t)l * DM * 2840; const float* mpre = I.mix_pre + (size_t)l * DM; bf16* WI = (bf16*)(wl + WO_IN);
        if (r < I_INM) { const int kb = r / 40, n0 = 32 * (r % 40); tr_item(Win, 2840, 0, 1280, mpre, WI, DM, n0, scr, kb, n0, lane); continue; } r -= I_INM;
        if (r < I_ING) { tr_item(Win, 2840, 1280, 24, mpre, WI, DM, 2816, scr, r, 0, lane); continue; } r -= I_ING;
        if (r < I_INC) { const int kb = r / 16, n0 = 32 * (r % 16); tr_item(Win, 2840, 1304, 512, mpre, WI, DM, 1280 + n0, scr, kb, n0, lane); continue; } r -= I_INC;
        if (r < I_INC) { const int kb = r / 16, n0 = 32 * (r % 16); tr_item(Win, 2840, 1816, 512, mpre, WI, DM, 1792 + n0, scr, kb, n0, lane); continue; } r -= I_INC;
        if (r < I_INC) { const int kb = r / 16, n0 = 32 * (r % 16); tr_item(Win, 2840, 2328, 512, mpre, WI, DM, 2304 + n0, scr, kb, n0, lane); continue; } r -= I_INC;
        if (r < I_O) { const int kb = r / 32, n0 = 32 * (r % 32);
            const float* gn = (kb < 8) ? (I.aon + (size_t)l * 512) : (I.con + (size_t)l * 512 - 512);
            tr_item(I.w_out + (size_t)l * DM * DM, DM, 0, DM, gn, (bf16*)(wl + WO_O), DM, n0, scr, kb, n0, lane); continue; } r -= I_O;
        if (r < I_W1) { const int kb = r / 8, n0 = 32 * (r % 8); tr_item(I.w1_k + (size_t)l * 2048 * 256, 256, 0, 256, nullptr, (bf16*)(wl + WO_W1), 2048, n0, scr, kb, n0, lane); continue; } r -= I_W1;
        { const int kb = r / 8, n0 = 32 * (r % 8); tr_item(I.w1_v + (size_t)l * 2048 * 256, 256, 0, 256, nullptr, (bf16*)(wl + WO_W1), 2048, 256 + n0, scr, kb, n0, lane); }
    }
    for (int i = gw * 64 + lane; i < NLAYER * 28672; i += NGW * 64) { const int l = i / 28672, q = i % 28672;
        *(GAS v4u*)(ws + WS_W + (size_t)l * W_LAYER + WO_IN + (size_t)2848 * DM * 2 + (size_t)q * 16) = (v4u){0u, 0u, 0u, 0u}; }
    for (int j = gw; j < NLAYER * 2 * 4; j += NGW) { const int l = j >> 3, kv = (j >> 2) & 1, c = (j & 3) * 64 + lane;
        const float* pe = (kv == 0 ? I.pe_k : I.pe_v) + (size_t)l * 2048; const float* w1 = (kv == 0 ? I.w1_k : I.w1_v) + (size_t)l * 2048 * 256;
        float s = 0.f;
        for (int k = 0; k < 2048; ++k) s += pe[k] * w1[(size_t)k * 256 + c];
        ((float*)(ws + WS_BIAS))[(l * 2 + kv) * 256 + c] = s; }
}

__device__ __forceinline__ void pro_rope(const int* pos, float* rope, int gtid, int nthreads) {
    const double invf[8] = {1.0, 0.19392274474868576, 0.03760603093086393, 0.007292664737217109, 0.001414213562373095, 0.0002742481756762073, 5.318295896944988e-05, 1.031338537721246e-05};
    for (int e = gtid; e < M * 8; e += nthreads) { const int row = e >> 3, i = e & 7;
        double f = 1.0;
#pragma unroll
        for (int q = 0; q < 8; ++q) f = (i == q) ? invf[q] : f;
        const double ang = (double)pos[row] * f;
        const double k = __builtin_rint(ang * 0.15915494309189535);
        const double red = __builtin_fma(-k, 1.2246467991473532e-16 * 2.0, __builtin_fma(-k, 6.283185307179586, ang));
        const float rf = (float)red;
        rope[(size_t)row * 16 + i] = cosf(rf); rope[(size_t)row * 16 + 8 + i] = sinf(rf); }
}

__device__ __forceinline__ void pro_xrow(const float* xrow, bf16* xbrow, float* rstd_out, int lane) {
    const GAS f32x4* xr = (const GAS f32x4*)xrow + lane;
    f32x4 v[4]; float s = 0.f;
#pragma unroll
    for (int j = 0; j < 4; ++j) { v[j] = xr[64 * j]; s += (v[j].x * v[j].x + v[j].y * v[j].y) + (v[j].z * v[j].z + v[j].w * v[j].w); }
    s = wave_sum(s);
    GAS v2u* o8 = (GAS v2u*)xbrow + lane;
#pragma unroll
    for (int j = 0; j < 4; ++j) o8[64 * j] = (v2u){pkc(v[j].x, v[j].y), pkc(v[j].z, v[j].w)};
    if (lane == 0) *rstd_out = 1.0f / sqrtf(s * (1.0f / DM) + EPS);
}

__device__ __forceinline__ void rowpass(const float* xin, float* xout, const bf16* h, const float* gpost, float scale, bf16* xb, float* rstd, int gw, int NGW, int lane) {
    f32x4 gv[4];
#pragma unroll
    for (int j = 0; j < 4; ++j) gv[j] = *((const GAS f32x4*)gpost + lane + 64 * j);
    for (int row = gw; row < M; row += NGW) {
        const GAS v2u* hr = (const GAS v2u*)(h + (size_t)row * DM) + lane;
        const GAS f32x4* xr = (const GAS f32x4*)(xin + (size_t)row * DM) + lane;
        f32x4 hv[4], xv[4]; float s = 0.f;
#pragma unroll
        for (int j = 0; j < 4; ++j) { const v2u w = hr[64 * j]; hv[j] = (f32x4){bf_lo(w.x), bf_hi(w.x), bf_lo(w.y), bf_hi(w.y)}; xv[j] = xr[64 * j];
            s += (hv[j].x * hv[j].x + hv[j].y * hv[j].y) + (hv[j].z * hv[j].z + hv[j].w * hv[j].w); }
        s = wave_sum(s);
        const float rh = scale / sqrtf(s * (1.0f / DM) + EPS);
        float s2 = 0.f;
#pragma unroll
        for (int j = 0; j < 4; ++j) { xv[j] = xv[j] + hv[j] * gv[j] * rh; s2 += (xv[j].x * xv[j].x + xv[j].y * xv[j].y) + (xv[j].z * xv[j].z + xv[j].w * xv[j].w); }
        s2 = wave_sum(s2);
        GAS f32x4* xo = (GAS f32x4*)(xout + (size_t)row * DM) + lane;
        GAS v2u* o8 = (GAS v2u*)(xb + (size_t)row * DM) + lane;
#pragma unroll
        for (int j = 0; j < 4; ++j) { xo[64 * j] = xv[j]; o8[64 * j] = (v2u){pkc(xv[j].x, xv[j].y), pkc(xv[j].z, xv[j].w)}; }
        if (lane == 0) rstd[row] = 1.0f / sqrtf(s2 * (1.0f / DM) + EPS);
    }
}

__device__ __forceinline__ float gelu_tanh(float x) {
    const float u = 0.7978845608028654f * (x + 0.044715f * x * x * x);
    const float e = ex2(2.0f * 1.4426950408889634f * u);
    const float th = 1.0f - 2.0f * __builtin_amdgcn_rcpf(e + 1.0f);
    return 0.5f * x * (1.0f + th);
}
__device__ __forceinline__ int kt_off(int key, int d) { return (((key >> 4) * 2 + (d >> 5)) * 64 + ((d & 31) >> 3) * 16 + (key & 15)) * 8 + (d & 7); }
__device__ __forceinline__ int vt_off(int key, int d) { return ((((key >> 5) * 4 + (d >> 4)) * 64) + ((key & 15) >> 2) * 16 + (d & 15)) * 8 + (key & 3) + 4 * ((key >> 4) & 1); }

__device__ __forceinline__ void cmp2_phase(const float* hid, const float* bias, const float* w2k, const float* w2v, bf16* kc_t, bf16* vc_t, int gw, int NGW, int lane) {
    for (int m = gw; m < 8192; m += NGW) {
        const int kv = m >> 12, bg = (m >> 10) & 3, n = m & 1023;
        const float* hr = hid + (size_t)m * 256; const float* bs = bias + kv * 256; const float* w2 = kv == 0 ? w2k : w2v;
        float a[4];
#pragma unroll
        for (int i = 0; i < 4; ++i) a[i] = gelu_tanh(hr[lane + 64 * i] + bs[lane + 64 * i]);
        float o = 0.f;
#pragma unroll
        for (int i = 0; i < 4; ++i)
#pragma unroll 16
            for (int c = 0; c < 64; ++c) o += __shfl(a[i], c) * w2[(size_t)(64 * i + c) * 64 + lane];
        if (n == 1023) o = 0.f;
        const unsigned short ob = (unsigned short)(pkc(o, 0.f) & 0xffffu);
        if (kv == 0) kc_t[(size_t)bg * 65536 + kt_off(n, lane)] = ob; else vc_t[(size_t)bg * 65536 + vt_off(n, lane)] = ob;
    }
}
__device__ __forceinline__ void vretile(const bf16* vrm, bf16* vt, int gw, int NGW, int lane) {
    for (int it = gw; it < 4 * (SEQ / 32); it += NGW) {
        const int bg = it / (SEQ / 32), kg = it % (SEQ / 32);
        const bf16* src = vrm + ((size_t)bg * SEQ + kg * 32) * 64; bf16* dst = vt + (size_t)bg * SEQ * 64;
#pragma unroll
        for (int g4 = 0; g4 < 4; ++g4) { unsigned short e[8];
#pragma unroll
            for (int j = 0; j < 8; ++j) { const int key = 4 * g4 + (j & 3) + 16 * (j >> 2); e[j] = src[key * 64 + lane]; }
            v4u w; w.x = e[0] | ((unsigned)e[1] << 16); w.y = e[2] | ((unsigned)e[3] << 16); w.z = e[4] | ((unsigned)e[5] << 16); w.w = e[6] | ((unsigned)e[7] << 16);
            *(GAS v4u*)(dst + (size_t)((kg * 4 + (lane >> 4)) * 64 + g4 * 16 + (lane & 15)) * 8) = w; }
    }
}

__device__ __forceinline__ void acmp_item(const bf16* qraw_ocmp, bf16* ocmp, const bf16* kc_t, const bf16* vc_t, float* scores, int bg, int qt, int lane) {
    const int col = lane & 15, g4 = lane >> 4, b = bg >> 1, g = bg & 1;
    const int t = 16 * qt + col; const size_t row = (size_t)b * SEQ + t;
    const int nmax = (t - 31) >> 4;
    const int ntiles = (qt + 15) >> 4;
    bf16x8 qf[4][2];
#pragma unroll
    for (int hh = 0; hh < 4; ++hh)
#pragma unroll
        for (int s = 0; s < 2; ++s) qf[hh][s] = *(const bf16x8*)(qraw_ocmp + row * 512 + (4 * g + hh) * 64 + 32 * s + 8 * g4);
    const bf16* kb = kc_t + (size_t)bg * 65536 + lane * 8; const bf16* vb = vc_t + (size_t)bg * 65536 + lane * 8;
    float mx[4], ls[4];
#pragma unroll
    for (int hh = 0; hh < 4; ++hh) { mx[hh] = -1e30f; ls[hh] = 0.f; }
    const f32x4 zero = {0.f, 0.f, 0.f, 0.f};
    for (int T = 0; T < ntiles; ++T) {
        const bf16x8 k0 = *(const bf16x8*)(kb + (T * 2 + 0) * 512), k1 = *(const bf16x8*)(kb + (T * 2 + 1) * 512);
#pragma unroll
        for (int hh = 0; hh < 4; ++hh) {
            f32x4 s = mfma16(k0, qf[hh][0], zero); s = mfma16(k1, qf[hh][1], s);
            float e[4]; float mt = mx[hh];
#pragma unroll
            for (int r = 0; r < 4; ++r) { const bool valid = (16 * T + 4 * g4 + r) <= nmax; e[r] = valid ? s[r] * C2 : -1e30f; mt = fmaxf(mt, e[r]); }
            float add = 0.f;
#pragma unroll
            for (int r = 0; r < 4; ++r) { const bool valid = (16 * T + 4 * g4 + r) <= nmax; add += valid ? ex2(e[r] - mt) : 0.f; }
            ls[hh] = ls[hh] * ex2(mx[hh] - mt) + add; mx[hh] = mt;
        }
    }
#pragma unroll
    for (int hh = 0; hh < 4; ++hh) {
        float Mx = fmaxf(mx[hh], __shfl_xor(mx[hh], 16)); Mx = fmaxf(Mx, __shfl_xor(Mx, 32));
        float l = ls[hh] * ex2(mx[hh] - Mx); l += __shfl_xor(l, 16); l += __shfl_xor(l, 32);
        mx[hh] = Mx; ls[hh] = l > 0.f ? 1.0f / l : 0.f;
    }
    f32x4 O[4][4];
#pragma unroll
    for (int hh = 0; hh < 4; ++hh)
#pragma unroll
        for (int dt = 0; dt < 4; ++dt) O[hh][dt] = zero;
    float carry = 0.f;
    const int npairs = (ntiles + 1) >> 1;
    float* srow = scores + (row * 2 + g) * 256;
    for (int kg = 0; kg < npairs; ++kg) {
        bf16x8 vf[4];
#pragma unroll
        for (int dt = 0; dt < 4; ++dt) vf[dt] = *(const bf16x8*)(vb + (kg * 4 + dt) * 512);
        f32x4 p[2][4]; float aa[2], bb[2];
#pragma unroll
        for (int tt = 0; tt < 2; ++tt) {
            const int T = 2 * kg + tt;
            const bf16x8 k0 = *(const bf16x8*)(kb + (T * 2 + 0) * 512), k1 = *(const bf16x8*)(kb + (T * 2 + 1) * 512);
            aa[tt] = 0.f; bb[tt] = 0.f;
#pragma unroll
            for (int hh = 0; hh < 4; ++hh) {
                f32x4 s = mfma16(k0, qf[hh][0], zero); s = mfma16(k1, qf[hh][1], s);
#pragma unroll
                for (int r = 0; r < 4; ++r) { const bool valid = (16 * T + 4 * g4 + r) <= nmax; p[tt][hh][r] = valid ? ex2(s[r] * C2 - mx[hh]) * ls[hh] : 0.f; }
                aa[tt] += 2.0f * (p[tt][hh][0] + p[tt][hh][1] + p[tt][hh][2]) + p[tt][hh][3]; bb[tt] += p[tt][hh][3];
            }
        }
#pragma unroll
        for (int hh = 0; hh < 4; ++hh) { const bf16x8 pf = pack8(p[0][hh], p[1][hh]);
#pragma unroll
            for (int dt = 0; dt < 4; ++dt) O[hh][dt] = mfma16(vf[dt], pf, O[hh][dt]); }
#pragma unroll
        for (int tt = 0; tt < 2; ++tt) {
            const int T = 2 * kg + tt;
            const float bsh = __shfl(bb[tt], (lane + 48) & 63);
            const float val = aa[tt] + (g4 == 0 ? carry : bsh);
            carry = bsh;
            srow[4 * T + g4] = val;
        }
    }
    for (int j = 8 * npairs + g4; j < NSELB; j += 4) srow[j] = (j == 8 * npairs) ? carry : 0.f;
#pragma unroll
    for (int hh = 0; hh < 4; ++hh)
#pragma unroll
        for (int dt = 0; dt < 4; ++dt) { const f32x4 o = O[hh][dt];
            *(GAS v2u*)(ocmp + row * 512 + (4 * g + hh) * 64 + 16 * dt + 4 * g4) = (v2u){pkc(o[0], o[1]), pkc(o[2], o[3])}; }
}

__device__ __forceinline__ void sel_phase(const float* scores, int* idx, int gw, int NGW, int lane) {
    for (int it = gw; it < M * 2; it += NGW) {
        const int row = it >> 1; const int t = row & (SEQ - 1), cur = t >> 6;
        const f32x4 sv = *((const GAS f32x4*)(scores + (size_t)it * 256) + lane);
        float v0, v1, v2, v3;
        { const int j = 4 * lane;
          v0 = (j + 0 <= cur) ? ((j + 0 == 0 || j + 0 == cur || j + 0 == cur - 1) ? 1e9f : sv[0]) : -1e30f;
          v1 = (j + 1 <= cur) ? ((j + 1 == cur || j + 1 == cur - 1) ? 1e9f : sv[1]) : -1e30f;
          v2 = (j + 2 <= cur) ? ((j + 2 == cur || j + 2 == cur - 1) ? 1e9f : sv[2]) : -1e30f;
          v3 = (j + 3 <= cur) ? ((j + 3 == cur || j + 3 == cur - 1) ? 1e9f : sv[3]) : -1e30f; }
        int mine = -1;
#pragma unroll 1
        for (int k = 0; k < KTOP; ++k) {
            float bv = v0; int bi = 4 * lane;
            if (v1 > bv) { bv = v1; bi = 4 * lane + 1; }
            if (v2 > bv) { bv = v2; bi = 4 * lane + 2; }
            if (v3 > bv) { bv = v3; bi = 4 * lane + 3; }
#pragma unroll
            for (int o = 1; o < 64; o <<= 1) { const float ov = __shfl_xor(bv, o); const int oi = __shfl_xor(bi, o); if (ov > bv || (ov == bv && oi < bi)) { bv = ov; bi = oi; } }
            if (lane == k) mine = (bv > -1e29f) ? bi : -1;
            if ((bi >> 2) == lane) { const int sl = bi & 3; if (sl == 0) v0 = -3e38f; else if (sl == 1) v1 = -3e38f; else if (sl == 2) v2 = -3e38f; else v3 = -3e38f; }
        }
        if (lane < KTOP) idx[(size_t)it * KTOP + lane] = mine;
    }
}

__device__ __forceinline__ void aslc_item(const bf16* qrot, const bf16* ks_t, const bf16* vs_t, const int* idx, bf16* oslc, int row, int g, int lane) {
    const int col = lane & 15, g4 = lane >> 4, b = row >> 14, t = row & (SEQ - 1), bg = b * 2 + g, cur = t >> 6;
    const int myidx = (lane < KTOP) ? idx[((size_t)row * 2 + g) * KTOP + lane] : -1;
    const int nsel = __builtin_popcountll(__ballot(myidx >= 0));
    bf16x8 qf[2];
#pragma unroll
    for (int s = 0; s < 2; ++s) { if (col < 4) qf[s] = *(const bf16x8*)(qrot + (size_t)row * 512 + (4 * g + col) * 64 + 32 * s + 8 * g4); else qf[s] = (bf16x8){0, 0, 0, 0, 0, 0, 0, 0}; }
    const bf16* kb = ks_t + (size_t)bg * SEQ * 64 + lane * 8; const bf16* vb = vs_t + (size_t)bg * SEQ * 64 + lane * 8;
    const f32x4 zero = {0.f, 0.f, 0.f, 0.f};
    f32x4 O[4] = {zero, zero, zero, zero}; float Mx = -1e30f, l = 0.f;
    for (int k = 0; k < nsel; ++k) {
        const int blk = __builtin_amdgcn_readlane(myidx, k);
        bf16x8 kf[4][2], vf[2][4];
#pragma unroll
        for (int T = 0; T < 4; ++T)
#pragma unroll
            for (int s = 0; s < 2; ++s) kf[T][s] = *(const bf16x8*)(kb + (size_t)((blk * 4 + T) * 2 + s) * 512);
#pragma unroll
        for (int ks = 0; ks < 2; ++ks)
#pragma unroll
            for (int dt = 0; dt < 4; ++dt) vf[ks][dt] = *(const bf16x8*)(vb + (size_t)((blk * 2 + ks) * 4 + dt) * 512);
        f32x4 e[4]; float mt = -1e30f;
        const bool diag = (blk == cur);
#pragma unroll
        for (int T = 0; T < 4; ++T) { f32x4 s = mfma16(kf[T][0], qf[0], zero); s = mfma16(kf[T][1], qf[1], s);
#pragma unroll
            for (int r = 0; r < 4; ++r) { const bool valid = !diag || (64 * blk + 16 * T + 4 * g4 + r) <= t; e[T][r] = valid ? s[r] * C2 : -1e30f; mt = fmaxf(mt, e[T][r]); } }
        mt = fmaxf(mt, __shfl_xor(mt, 16)); mt = fmaxf(mt, __shfl_xor(mt, 32));
        const float Mn = fmaxf(Mx, mt), alpha = ex2(Mx - Mn); Mx = Mn;
        float add = 0.f;
#pragma unroll
        for (int T = 0; T < 4; ++T)
#pragma unroll
            for (int r = 0; r < 4; ++r) { const float pv = (e[T][r] > -1e29f) ? ex2(e[T][r] - Mn) : 0.f; e[T][r] = pv; add += pv; }
        l = l * alpha + add;
#pragma unroll
        for (int dt = 0; dt < 4; ++dt) O[dt] = O[dt] * alpha;
#pragma unroll
        for (int ks = 0; ks < 2; ++ks) { const bf16x8 pf = pack8(e[2 * ks], e[2 * ks + 1]);
#pragma unroll
            for (int dt = 0; dt < 4; ++dt) O[dt] = mfma16(vf[ks][dt], pf, O[dt]); }
    }
    l += __shfl_xor(l, 16); l += __shfl_xor(l, 32);
    const float inv = l > 0.f ? 1.0f / l : 0.f;
    if (col < 4) {
#pragma unroll
        for (int dt = 0; dt < 4; ++dt) { const f32x4 o = O[dt] * inv;
            *(GAS v2u*)(oslc + (size_t)row * 512 + (4 * g + col) * 64 + 16 * dt + 4 * g4) = (v2u){pkc(o[0], o[1]), pkc(o[2], o[3])}; }
    }
}

__device__ __forceinline__ void awin_item(const bf16* qrot, bf16* owin, const bf16* kw_t, const bf16* vw_t, int b, int h, int qt, int lane) {
    const int col = lane & 15, g4 = lane >> 4, g = h >> 2, bg = b * 2 + g;
    const int t = 16 * qt + col; const size_t row = (size_t)b * SEQ + t;
    bf16x8 qf[2];
#pragma unroll
    for (int s = 0; s < 2; ++s) qf[s] = *(const bf16x8*)(qrot + row * 512 + h * 64 + 32 * s + 8 * g4);
    const bf16* kb = kw_t + (size_t)bg * SEQ * 64 + lane * 8; const bf16* vb = vw_t + (size_t)bg * SEQ * 64 + lane * 8;
    const f32x4 zero = {0.f, 0.f, 0.f, 0.f};
    f32x4 O[4] = {zero, zero, zero, zero}; float Mx = -1e30f, l = 0.f;
    const int tlo = qt - 32 > 0 ? qt - 32 : 0, kg0 = tlo >> 1, kg1 = qt >> 1;
    for (int kg = kg0; kg <= kg1; ++kg) {
        bf16x8 kf[2][2], vf[4];
#pragma unroll
        for (int tt = 0; tt < 2; ++tt)
#pragma unroll
            for (int s = 0; s < 2; ++s) kf[tt][s] = *(const bf16x8*)(kb + (size_t)((2 * kg + tt) * 2 + s) * 512);
#pragma unroll
        for (int dt = 0; dt < 4; ++dt) vf[dt] = *(const bf16x8*)(vb + (size_t)(kg * 4 + dt) * 512);
        f32x4 e[2]; float mt = -1e30f;
#pragma unroll
        for (int tt = 0; tt < 2; ++tt) { f32x4 s = mfma16(kf[tt][0], qf[0], zero); s = mfma16(kf[tt][1], qf[1], s);
#pragma unroll
            for (int r = 0; r < 4; ++r) { const int df = t - (32 * kg + 16 * tt + 4 * g4 + r); const bool valid = df >= 0 && df < 512; e[tt][r] = valid ? s[r] * C2 : -1e30f; mt = fmaxf(mt, e[tt][r]); } }
        mt = fmaxf(mt, __shfl_xor(mt, 16)); mt = fmaxf(mt, __shfl_xor(mt, 32));
        const float Mn = fmaxf(Mx, mt), alpha = ex2(Mx - Mn); Mx = Mn;
        float add = 0.f;
#pragma unroll
        for (int tt = 0; tt < 2; ++tt)
#pragma unroll
            for (int r = 0; r < 4; ++r) { const float pv = (e[tt][r] > -1e29f) ? ex2(e[tt][r] - Mn) : 0.f; e[tt][r] = pv; add += pv; }
        l = l * alpha + add;
        const bf16x8 pf = pack8(e[0], e[1]);
#pragma unroll
        for (int dt = 0; dt < 4; ++dt) O[dt] = mfma16(vf[dt], pf, O[dt] * alpha);
    }
    l += __shfl_xor(l, 16); l += __shfl_xor(l, 32);
    const float inv = l > 0.f ? 1.0f / l : 0.f;
#pragma unroll
    for (int dt = 0; dt < 4; ++dt) { const f32x4 o = O[dt] * inv;
        *(GAS v2u*)(owin + row * 512 + h * 64 + 16 * dt + 4 * g4) = (v2u){pkc(o[0], o[1]), pkc(o[2], o[3])}; }
}

__device__ __forceinline__ void unpack8(const v4u w, float (&f)[8]) { f[0] = bf_lo(w.x); f[1] = bf_hi(w.x); f[2] = bf_lo(w.y); f[3] = bf_hi(w.y); f[4] = bf_lo(w.z); f[5] = bf_hi(w.z); f[6] = bf_lo(w.w); f[7] = bf_hi(w.w); }
__device__ __forceinline__ void mrg_phase(const bf16* ocmp, const bf16* oslc, const bf16* owin, const float* gates, const bf16* bgp, const bf16* cgp, const bf16* xcp, const float* convw, bf16* merged, int gw, int NGW, int lane) {
    float w0[8], w1[8], w2[8];
#pragma unroll
    for (int j = 0; j < 8; ++j) { w0[j] = convw[8 * lane + j]; w1[j] = convw[512 + 8 * lane + j]; w2[j] = convw[1024 + 8 * lane + j]; }
    for (int row = gw; row < M; row += NGW) {
        const int t = row & (SEQ - 1); const size_t o = (size_t)row * 512 + 8 * lane;
        float a[8], c[8], d[8], att[8];
        unpack8(*(const GAS v4u*)(ocmp + o), a); unpack8(*(const GAS v4u*)(oslc + o), c); unpack8(*(const GAS v4u*)(owin + o), d);
        const float* gr = gates + (size_t)row * NGATE + (lane >> 3) * 3; const float g0 = gr[0], g1 = gr[1], g2 = gr[2];
        float sa = 0.f;
#pragma unroll
        for (int j = 0; j < 8; ++j) { att[j] = g0 * a[j] + g1 * c[j] + g2 * d[j]; sa += att[j] * att[j]; }
        float bgv[8], u0[8], u1[8], u2[8], tmp[8];
        unpack8(*(const GAS v4u*)(bgp + o), bgv);
        unpack8(*(const GAS v4u*)(cgp + o), u2); unpack8(*(const GAS v4u*)(xcp + o), tmp);
#pragma unroll
        for (int j = 0; j < 8; ++j) u2[j] *= tmp[j];
        if (t >= 1) { unpack8(*(const GAS v4u*)(cgp + o - 512), u1); unpack8(*(const GAS v4u*)(xcp + o - 512), tmp);
#pragma unroll
            for (int j = 0; j < 8; ++j) u1[j] *= tmp[j]; }
        else {
#pragma unroll
            for (int j = 0; j < 8; ++j) u1[j] = 0.f; }
        if (t >= 2) { unpack8(*(const GAS v4u*)(cgp + o - 1024), u0); unpack8(*(const GAS v4u*)(xcp + o - 1024), tmp);
#pragma unroll
            for (int j = 0; j < 8; ++j) u0[j] *= tmp[j]; }
        else {
#pragma unroll
            for (int j = 0; j < 8; ++j) u0[j] = 0.f; }
        float y[8]; float sc = 0.f;
#pragma unroll
        for (int j = 0; j < 8; ++j) { y[j] = bgv[j] * (w0[j] * u0[j] + w1[j] * u1[j] + w2[j] * u2[j]); sc += y[j] * y[j]; }
        sa = wave_sum(sa); sc = wave_sum(sc);
        const float ra = 1.0f / sqrtf(sa * (1.0f / 512.0f) + EPS), rc = 1.0f / sqrtf(sc * (1.0f / 512.0f) + EPS);
        v4u wa, wc;
        wa.x = pkc(att[0] * ra, att[1] * ra); wa.y = pkc(att[2] * ra, att[3] * ra); wa.z = pkc(att[4] * ra, att[5] * ra); wa.w = pkc(att[6] * ra, att[7] * ra);
        wc.x = pkc(y[0] * rc, y[1] * rc); wc.y = pkc(y[2] * rc, y[3] * rc); wc.z = pkc(y[4] * rc, y[5] * rc); wc.w = pkc(y[6] * rc, y[7] * rc);
        *(GAS v4u*)(merged + (size_t)row * DM + 8 * lane) = wa; *(GAS v4u*)(merged + (size_t)row * DM + 512 + 8 * lane) = wc;
    }
}

struct Args { const void* in[25]; float* out; unsigned char* ws; int ph_lo, ph_hi; };
__device__ __forceinline__ unsigned char* opaque_ptr(unsigned char* p) { GAS unsigned char* g = (GAS unsigned char*)p; asm volatile("" : "+s"(g)); return (unsigned char*)g; }
__device__ __forceinline__ int opaque_v(int v) { asm volatile("" : "+v"(v)); return v; }
#define PH_LOCALS \
    unsigned char* ws = opaque_ptr(args.ws); \
    const int tid = opaque_v((int)threadIdx.x), lane = tid & 63, wave = __builtin_amdgcn_readfirstlane(tid >> 6); \
    const int G = gridDim.x, bx = blockIdx.x, vcu = (G % 8 == 0) ? (bx % 8) * (G / 8) + bx / 8 : bx, gw = vcu * NWAVES + wave, NGW = G * NWAVES; \
    (void)lane; (void)gw; (void)NGW; (void)ws; (void)bx;
#define INF(k) ((const float*)args.in[k])
#define WSP(T, off) ((T*)(ws + (off)))

__global__ void __launch_bounds__(NWAVES * 64, 2) mk_fwd(Args args) {
    extern __shared__ __attribute__((aligned(16))) unsigned char lds_raw[];
    LAS unsigned char* lds = (LAS unsigned char*)lds_raw;
    const int lo = args.ph_lo, hi = args.ph_hi;
    XcdBarrier bar; bar.bar = (unsigned*)(args.ws + WS_CTL) + CW_BAR; bar.x = 0; bar.st = nullptr;
    {
        const int tid0 = threadIdx.x;
        for (int u = tid0; u < (LDS_BYTES - RING_BYTES) / 4; u += NWAVES * 64) ((LAS unsigned*)(lds + RING_BYTES))[u] = 0u;
        __syncthreads();
        if (hi - lo > 1) bar = xcd_barrier_post((unsigned*)(args.ws + WS_CTL) + CW_BAR, (volatile LAS unsigned*)(lds + MISC_OFF) + 8);
    }
#define IN(k) (lo <= (k) && (k) < hi)
#define SEAM(k) do { if (IN(k) && IN((k) + 1)) xcd_barrier(bar); } while (0)

    if (EN(0) && IN(0)) {
        PH_LOCALS
        In I;
        I.x = INF(0); I.pos = (const int*)args.in[1]; I.f1_pre = INF(2); I.f1_wg = INF(3); I.f1_wu = INF(4); I.f1_wd = INF(5);
        I.f1_post = INF(6); I.mix_pre = INF(7); I.w_in = INF(8); I.pe_k = INF(9); I.w1_k = INF(10); I.w2_k = INF(11);
        I.pe_v = INF(12); I.w1_v = INF(13); I.w2_v = INF(14); I.conv_w = INF(15); I.aon = INF(16); I.con = INF(17);
        I.w_out = INF(18); I.mix_post = INF(19); I.f2_pre = INF(20); I.f2_wg = INF(21); I.f2_wu = INF(22); I.f2_wd = INF(23); I.f2_post = INF(24);
        pro_weights(I, ws, (LAS float*)(lds + wave * 16384), gw, NGW, lane);
        pro_rope(I.pos, WSP(float, WS_ROPE), vcu * NWAVES * 64 + tid, G * NWAVES * 64);
        for (int m = gw; m < M; m += NGW) pro_xrow(I.x + (size_t)m * DM, WSP(bf16, WS_XB) + (size_t)m * DM, WSP(float, WS_RSTD) + m, lane);
    }
    SEAM(0);

    for (int l = 0; l < NLAYER; ++l) {
        const int P = 1 + l * PH_PER_LAYER;
        if (hi <= P || lo >= P + PH_PER_LAYER) continue;
        if (EN(1) && IN(P + 0)) {
            PH_LOCALS
            pg8::Gemm g{WSP(bf16, WS_XB), WSP(const bf16, WS_W + (size_t)l * W_LAYER + WO_GU1), M, 2 * DFF, DM, DM, DM}; pg8::StaticOrder S; S.init(M, 2 * DFF, G, bx);
            pg8::EpiSwiGLU E{WSP(bf16, WS_BIG), DFF, WSP(float, WS_RSTD)};
            pg8::gemm_phase<pg8::EpiSwiGLU, pg8::StaticOrder, true, true>(lds, g, S, E);
        }
        SEAM(P + 0);
        if (EN(2) && IN(P + 1)) {
            PH_LOCALS
            pg8::Gemm g{WSP(bf16, WS_BIG), WSP(const bf16, WS_W + (size_t)l * W_LAYER + WO_D1), M, DM, DFF, DFF, DFF}; pg8::StaticOrder S; S.init(M, DM, G, bx);
            pg8::EpiBf16<0> E{WSP(bf16, WS_H), DM, nullptr, 0, 0, 1.f};
            pg8::gemm_phase<pg8::EpiBf16<0>, pg8::StaticOrder, true, true>(lds, g, S, E);
        }
        SEAM(P + 1);
        if (EN(3) && IN(P + 2)) { PH_LOCALS rowpass(l == 0 ? INF(0) : args.out, args.out, WSP(bf16, WS_H), INF(6) + (size_t)l * DM, 0.5f, WSP(bf16, WS_XB), WSP(float, WS_RSTD), gw, NGW, lane); }
        SEAM(P + 2);
        if (EN(4) && IN(P + 3)) {
            PH_LOCALS
            pg8::Gemm g{WSP(bf16, WS_XB), WSP(const bf16, WS_W + (size_t)l * W_LAYER + WO_IN), M, NIN, DM, DM, DM}; pg8::StaticOrder S; S.init(M, NIN, G, bx);
            pg8::EpiInProj E{ws};
            pg8::gemm_phase<pg8::EpiInProj, pg8::StaticOrder, true, true>(lds, g, S, E);
        }
        SEAM(P + 3);
        if (EN(5) && IN(P + 4)) {
            PH_LOCALS
            vretile(WSP(bf16, WS_VS_RM), WSP(bf16, WS_VS_T), gw, NGW, lane); vretile(WSP(bf16, WS_VW_RM), WSP(bf16, WS_VW_T), gw, NGW, lane);
            pg8::Gemm g{WSP(bf16, WS_KRAW), WSP(const bf16, WS_W + (size_t)l * W_LAYER + WO_W1), 8192, 512, 2048, 1024, 2048}; pg8::CmpOrder S{G, bx};
            pg8::EpiHid E{WSP(float, WS_HID)};
            pg8::gemm_phase<pg8::EpiHid, pg8::CmpOrder, true, true>(lds, g, S, E);
        }
        SEAM(P + 4);
        if (EN(6) && IN(P + 5)) { PH_LOCALS cmp2_phase(WSP(float, WS_HID), WSP(float, WS_BIAS) + l * 512, INF(11) + (size_t)l * 256 * 64, INF(14) + (size_t)l * 256 * 64, WSP(bf16, WS_KC_T), WSP(bf16, WS_VC_T), gw, NGW, lane); }
        SEAM(P + 5);
        if (EN(7) && IN(P + 6)) {
            PH_LOCALS
            for (int p = gw; p < 2048; p += NGW) { const int bg = p >> 9, i = p & 511;
                acmp_item(WSP(bf16, WS_QRAW), WSP(bf16, WS_QRAW), WSP(bf16, WS_KC_T), WSP(bf16, WS_VC_T), WSP(float, WS_SCORES), bg, i, lane);
                acmp_item(WSP(bf16, WS_QRAW), WSP(bf16, WS_QRAW), WSP(bf16, WS_KC_T), WSP(bf16, WS_VC_T), WSP(float, WS_SCORES), bg, 1023 - i, lane); }
        }
        SEAM(P + 6);
        if (EN(8) && IN(P + 7)) { PH_LOCALS sel_phase(WSP(float, WS_SCORES), WSP(int, WS_IDX), gw, NGW, lane); }
        SEAM(P + 7);
        if (EN(9) && IN(P + 8)) { PH_LOCALS for (int it = gw; it < M * 2; it += NGW) aslc_item(WSP(bf16, WS_QROT), WSP(bf16, WS_KS_T), WSP(bf16, WS_VS_T), WSP(int, WS_IDX), WSP(bf16, WS_OSLC), it >> 1, it & 1, lane); }
        SEAM(P + 8);
        if (EN(10) && IN(P + 9)) { PH_LOCALS for (int it = gw; it < BATCH * 8 * (SEQ / 16); it += NGW) { const int qt = it & 1023, h = (it >> 10) & 7, b = it >> 13; awin_item(WSP(bf16, WS_QROT), WSP(bf16, WS_QROT), WSP(bf16, WS_KW_T), WSP(bf16, WS_VW_T), b, h, qt, lane); } }
        SEAM(P + 9);
        if (EN(11) && IN(P + 10)) { PH_LOCALS mrg_phase(WSP(bf16, WS_QRAW), WSP(bf16, WS_OSLC), WSP(bf16, WS_QROT), WSP(float, WS_GATES), WSP(bf16, WS_BG), WSP(bf16, WS_CG), WSP(bf16, WS_XC), INF(15) + (size_t)l * 3 * 512, WSP(bf16, WS_MERGED), gw, NGW, lane); }
        SEAM(P + 10);
        if (EN(12) && IN(P + 11)) {
            PH_LOCALS
            pg8::Gemm g{WSP(bf16, WS_MERGED), WSP(const bf16, WS_W + (size_t)l * W_LAYER + WO_O), M, DM, DM, DM, DM}; pg8::StaticOrder S; S.init(M, DM, G, bx);
            pg8::EpiBf16<0> E{WSP(bf16, WS_H), DM, nullptr, 0, 0, 1.f};
            pg8::gemm_phase<pg8::EpiBf16<0>, pg8::StaticOrder, true, true>(lds, g, S, E);
        }
        SEAM(P + 11);
        if (EN(13) && IN(P + 12)) { PH_LOCALS rowpass(args.out, args.out, WSP(bf16, WS_H), INF(19) + (size_t)l * DM, 1.0f, WSP(bf16, WS_XB), WSP(float, WS_RSTD), gw, NGW, lane); }
        SEAM(P + 12);
        if (EN(14) && IN(P + 13)) {
            PH_LOCALS
            pg8::Gemm g{WSP(bf16, WS_XB), WSP(const bf16, WS_W + (size_t)l * W_LAYER + WO_GU2), M, 2 * DFF, DM, DM, DM}; pg8::StaticOrder S; S.init(M, 2 * DFF, G, bx);
            pg8::EpiSwiGLU E{WSP(bf16, WS_BIG), DFF, WSP(float, WS_RSTD)};
            pg8::gemm_phase<pg8::EpiSwiGLU, pg8::StaticOrder, true, true>(lds, g, S, E);
        }
        SEAM(P + 13);
        if (EN(15) && IN(P + 14)) {
            PH_LOCALS
            pg8::Gemm g{WSP(bf16, WS_BIG), WSP(const bf16, WS_W + (size_t)l * W_LAYER + WO_D2), M, DM, DFF, DFF, DFF}; pg8::StaticOrder S; S.init(M, DM, G, bx);
            pg8::EpiBf16<0> E{WSP(bf16, WS_H), DM, nullptr, 0, 0, 1.f};
            pg8::gemm_phase<pg8::EpiBf16<0>, pg8::StaticOrder, true, true>(lds, g, S, E);
        }
        SEAM(P + 14);
        if (EN(16) && IN(P + 15)) { PH_LOCALS rowpass(args.out, args.out, WSP(bf16, WS_H), INF(24) + (size_t)l * DM, 0.5f, WSP(bf16, WS_XB), WSP(float, WS_RSTD), gw, NGW, lane); }
        if (l != NLAYER - 1) SEAM(P + 15);
    }
#undef IN
#undef SEAM
}

extern "C" void kernel_launch(void* const* d_in, const int* in_sizes, int n_in, void* d_out, int out_size, void* d_ws, size_t ws_size, hipStream_t stream) {
    static int grid = 0;
    if (grid == 0) {
        if (n_in != 25 || out_size != M * DM || ws_size < WS_END) { fprintf(stderr, "kernel_launch: unexpected shapes (n_in %d out %d ws %zu)\n", n_in, out_size, ws_size); grid = -1; return; }
        int dev = 0, cus = 0, per_cu = 0;
        if (hipGetDevice(&dev) != hipSuccess || hipDeviceGetAttribute(&cus, hipDeviceAttributeMultiprocessorCount, dev) != hipSuccess) { grid = -1; return; }
        if (hipFuncSetAttribute((const void*)mk_fwd, hipFuncAttributeMaxDynamicSharedMemorySize, LDS_BYTES) != hipSuccess) { fprintf(stderr, "kernel_launch: hipFuncSetAttribute failed\n"); grid = -1; return; }
        if (hipOccupancyMaxActiveBlocksPerMultiprocessor(&per_cu, (const void*)mk_fwd, NWAVES * 64, LDS_BYTES) != hipSuccess || per_cu < 1) fprintf(stderr, "kernel_launch: occupancy query reports %d\n", per_cu);
        (void)hipGetLastError();
        grid = cus;
    }
    if (grid < 0) return;
    if (hipMemsetAsync((char*)d_ws + WS_CTL, 0, CTL_ZERO_BYTES, stream) != hipSuccess) return;
    Args a{};
    for (int i = 0; i < 25; ++i) a.in[i] = d_in[i];
    a.out = (float*)d_out; a.ws = (unsigned char*)d_ws;
#if MK_ONE_LAUNCH
    a.ph_lo = 0; a.ph_hi = N_PHASES;
    hipLaunchKernelGGL(mk_fwd, dim3(grid), dim3(NWAVES * 64), LDS_BYTES, stream, a);
#else
    for (int p = 0; p < N_PHASES; ++p) { a.ph_lo = p; a.ph_hi = p + 1; hipLaunchKernelGGL(mk_fwd, dim3(grid), dim3(NWAVES * 64), LDS_BYTES, stream, a); }
#endif
}
```

```cpp
#include <hip/hip_runtime.h>
#include <cstdio>
#include <cstdint>

constexpr int NWAVES = 8;
constexpr int BATCH = 2, SEQ = 16384, DM = 1024, M = BATCH * SEQ, DFF = 2816, NIN = 3072, NLAYER = 2;
constexpr int DATT = 512, NGATE = 24, NSELB = 256, KTOP = 16;
constexpr float EPS = 1e-6f;
constexpr float C2 = 0.125f * 1.4426950408889634f;
constexpr size_t MiB = 1u << 20;
constexpr size_t WS_CTL = 0, CTL_ZERO_BYTES = 1 * MiB;
constexpr size_t WS_W = 2 * MiB, W_LAYER = 43 * MiB;
constexpr size_t WO_GU1 = 0, WO_D1 = 11 * MiB, WO_IN = 11 * MiB + 5632 * 1024, WO_O = WO_IN + 6 * MiB, WO_GU2 = WO_O + 2 * MiB, WO_D2 = WO_GU2 + 11 * MiB, WO_W1 = WO_D2 + 5632 * 1024;
static_assert(WO_W1 + 2 * MiB == W_LAYER, "weight map");
constexpr size_t WS_XB = 88 * MiB;
constexpr size_t WS_H = 152 * MiB;
constexpr size_t WS_BIG = 216 * MiB;
constexpr size_t WS_QRAW = WS_BIG, WS_QROT = WS_BIG + 32 * MiB, WS_OSLC = WS_BIG + 64 * MiB, WS_BG = WS_BIG + 96 * MiB, WS_CG = WS_BIG + 128 * MiB, WS_KRAW = WS_BIG + 160 * MiB, WS_VRAW = WS_KRAW + 8 * MiB;
constexpr size_t WS_XC = 392 * MiB, WS_KS_T = 424 * MiB, WS_KW_T = 432 * MiB, WS_VS_T = 440 * MiB, WS_VW_T = 448 * MiB, WS_GATES = 456 * MiB, WS_IDX = 460 * MiB, WS_HID = 464 * MiB;
constexpr size_t WS_KC_T = 472 * MiB, WS_VC_T = WS_KC_T + 512 * 1024, WS_ROPE = 473 * MiB, WS_RSTD = 475 * MiB, WS_BIAS = 476 * MiB, WS_HIDP = 477 * MiB, WS_END = 509 * MiB;
constexpr size_t WS_VS_RM = WS_H, WS_VW_RM = WS_H + 8 * MiB, WS_SCORES = WS_H, WS_MERGED = WS_XB;
constexpr int CW_BAR = 4096;
constexpr int CW_KMAX = 64;

constexpr int RING_BYTES = 131072, MISC_OFF = RING_BYTES + 320, LDS_BYTES = 147456;

constexpr int PH_PER_LAYER = 16, N_PHASES = 1 + NLAYER * PH_PER_LAYER;
#ifndef PH_MASK
#define PH_MASK 0x1ffff
#endif
#define EN(k) (((PH_MASK) >> (k)) & 1)
#ifndef MK_ONE_LAUNCH
#define MK_ONE_LAUNCH 1
#endif

namespace pg8 {
#define PG8_LAS __attribute__((address_space(3)))
typedef unsigned short bf16_t;
typedef short bf16x8 __attribute__((ext_vector_type(8)));
typedef float f32x4 __attribute__((ext_vector_type(4)));
typedef unsigned u32x4 __attribute__((ext_vector_type(4)));
constexpr int BM = 256, BK = 64, HALF = 128, HTB = HALF * BK * 2  , STAGE_BYTES = 8 * HTB, NXCD = 8, WGM = 8;

__host__ __device__ __forceinline__ int lds_byte(int r, int c) { const int st = (r >> 4) * 2 + (c >> 5), rr = r & 15, cc = c & 31, ob = rr * 64 + cc * 2; return st * 1024 + (ob ^ (((ob >> 9) & 1) << 5)); }
__host__ __device__ __forceinline__ void stage_rc(int b, int& R, int& C) { const int st = b / 1024, sb = b % 1024, swz = sb ^ (((sb >> 9) & 1) << 5); R = (st >> 1) * 16 + swz / 64; C = (st & 1) * 32 + (swz % 64) / 2; }
__host__ __device__ __forceinline__ int perm32(int rho) { const int n = rho >> 4, i = rho & 15; return 8 * (i >> 2) + 4 * n + (i & 3); }

struct Unit { int pm, pn; };
struct Gemm { const bf16_t* A; const bf16_t* Bt; int M, N, K, lda, ldb; };

struct StaticOrder {
    int nM, nN, nwg, G, c;
    __host__ __device__ void init(int M, int N, int G_, int c_) { nM = M / BM; nN = N / BM; nwg = nM * nN; G = G_; c = c_; }
    __host__ __device__ bool next(int i, Unit& u) const {
        const long L = (long)i * G + c; if (L >= nwg) return false;
        int wgid = (int)L; { const int q = nwg / NXCD, r = nwg % NXCD, xcd = wgid % NXCD, off = wgid / NXCD; wgid = (xcd < r ? xcd * (q + 1) : r * (q + 1) + (xcd - r) * q) + off; }
        const int nig = WGM * nN, gid = wgid / nig, fm = gid * WGM, gsz = (nM - fm) < WGM ? (nM - fm) : WGM;
        u.pm = fm + ((wgid % nig) % gsz); u.pn = (wgid % nig) / gsz; return true;
    }
    __device__ __forceinline__ void a_ready(const Unit&) const {}
    __device__ __forceinline__ void done(const Unit&) const {}
};

__device__ __forceinline__ unsigned cvt_pk_bf16(float lo, float hi) { unsigned r; asm volatile("v_cvt_pk_bf16_f32 %0, %1, %2" : "=v"(r) : "v"(lo), "v"(hi)); return r; }
typedef float f32x2 __attribute__((ext_vector_type(2)));
__device__ __forceinline__ f32x2 gelu_pk(f32x2 v) {
    const f32x2 av = __builtin_elementwise_abs(v), d = av * 0.2316418882f + 1.0f;
    f32x2 t; t.x = __builtin_amdgcn_rcpf(d.x); t.y = __builtin_amdgcn_rcpf(d.y);
    f32x2 q = t * 0.5307027145f + (-0.7265760135f); q = q * t + 0.7107068705f; q = q * t + (-0.142248368f); q = q * t + 0.127414796f; q = q * t;
    const f32x2 s = (v * v) * (-0.72134752044f);
    f32x2 e; e.x = __builtin_amdgcn_exp2f(s.x); e.y = __builtin_amdgcn_exp2f(s.y);
    const f32x2 m = v * (q * e), r = v - m;
    f32x2 o; o.x = v.x < 0.f ? m.x : r.x; o.y = v.y < 0.f ? m.y : r.y; return o;
}

template <int ACT  > struct EpiBf16 {
    static constexpr bool PERM = true, AFTER_DRAIN = false; static_assert(ACT == 0 || ACT == 1, "EpiBf16: ACT is 0 (none) or 1 (gelu_pk)");
    bf16_t* O; int ldc; const float* bias; int split_cols; size_t split_stride; float scale0;
    __device__ __forceinline__ void operator()(const f32x4 (&acc)[2][2][4][2], const Unit& u, int wr, int wc, int fr, int fq) const {
        const int row0 = u.pm * BM + wr * 64 + fr; int colt = u.pn * BM; bf16_t* base = O;
        float sc = 1.f; if (split_cols) { const int t = colt / split_cols; base += (size_t)t * split_stride; colt -= t * split_cols; if (t == 0) sc = scale0; }
        const int col0 = colt + wc * 32 + 8 * fq, bcol0 = u.pn * BM + wc * 32 + 8 * fq;
        f32x4 bv[2][2];
#pragma unroll
        for (int bj = 0; bj < 2; ++bj)
#pragma unroll
            for (int n = 0; n < 2; ++n) bv[bj][n] = bias ? *(const f32x4*)(bias + bcol0 + bj * HALF + 4 * n) : (f32x4){0.f, 0.f, 0.f, 0.f};
#pragma unroll
        for (int ai = 0; ai < 2; ++ai)
#pragma unroll
            for (int m = 0; m < 4; ++m) { bf16_t* rowp = base + (size_t)(row0 + ai * HALF + m * 16) * ldc + col0;
#pragma unroll
                for (int bj = 0; bj < 2; ++bj) { f32x4 v0 = acc[ai][bj][m][0] + bv[bj][0], v1 = acc[ai][bj][m][1] + bv[bj][1];
                    if (ACT == 1) { f32x2 a = gelu_pk((f32x2){v0[0], v0[1]}), b = gelu_pk((f32x2){v0[2], v0[3]}), c = gelu_pk((f32x2){v1[0], v1[1]}), d = gelu_pk((f32x2){v1[2], v1[3]});
                        v0 = (f32x4){a.x, a.y, b.x, b.y}; v1 = (f32x4){c.x, c.y, d.x, d.y}; }
                    v0 = v0 * sc; v1 = v1 * sc; u32x4 w; w.x = cvt_pk_bf16(v0[0], v0[1]); w.y = cvt_pk_bf16(v0[2], v0[3]); w.z = cvt_pk_bf16(v1[0], v1[1]); w.w = cvt_pk_bf16(v1[2], v1[3]);
                    *(u32x4*)(rowp + bj * HALF) = w; } }
    }
};

constexpr int SEQ_ = SEQ;
__device__ __forceinline__ unsigned pk2c(float lo, float hi) { typedef float f2_t __attribute__((ext_vector_type(2))); typedef __bf16 b2_t __attribute__((ext_vector_type(2))); f2_t v = {lo, hi}; b2_t b = __builtin_convertvector(v, b2_t); return __builtin_bit_cast(unsigned, b); }
__device__ __forceinline__ void store8(bf16_t* dst, const f32x4& v0, const f32x4& v1) { u32x4 w; w.x = pk2c(v0[0], v0[1]); w.y = pk2c(v0[2], v0[3]); w.z = pk2c(v1[0], v1[1]); w.w = pk2c(v1[2], v1[3]); *(u32x4*)dst = w; }
__device__ __forceinline__ float silu_f(float x) { return x * __builtin_amdgcn_rcpf(1.0f + __builtin_amdgcn_exp2f(-1.4426950408889634f * x)); }
__device__ __forceinline__ float sigmoid_f(float x) { return __builtin_amdgcn_rcpf(1.0f + __builtin_amdgcn_exp2f(-1.4426950408889634f * x)); }

struct EpiSwiGLU {
    static constexpr bool PERM = true, AFTER_DRAIN = false;
    bf16_t* O; int ldc; const float* rstd;
    __device__ __forceinline__ void operator()(const f32x4 (&acc)[2][2][4][2], const Unit& u, int wr, int wc, int fr, int fq) const {
        const int row0 = u.pm * BM + wr * 64 + fr, col0 = u.pn * 128 + wc * 32 + 8 * fq;
#pragma unroll
        for (int ai = 0; ai < 2; ++ai)
#pragma unroll
            for (int m = 0; m < 4; ++m) { const int r = row0 + ai * HALF + m * 16; const float rs = rstd[r];
                const f32x4 g0 = acc[ai][0][m][0] * rs, g1 = acc[ai][0][m][1] * rs, u0 = acc[ai][1][m][0] * rs, u1 = acc[ai][1][m][1] * rs;
                f32x4 o0, o1;
#pragma unroll
                for (int j = 0; j < 4; ++j) { o0[j] = silu_f(g0[j]) * u0[j]; o1[j] = silu_f(g1[j]) * u1[j]; }
                store8(O + (size_t)r * ldc + col0, o0, o1); }
    }
};

struct EpiHid {
    static constexpr bool PERM = false, AFTER_DRAIN = false;
    float* C;
    __device__ __forceinline__ void operator()(const f32x4 (&acc)[2][2][4][2], const Unit& u, int wr, int wc, int fr, int fq) const {
        const int row0 = u.pm * BM + wr * 64 + fr, col0 = wc * 32 + 4 * fq;
#pragma unroll
        for (int ai = 0; ai < 2; ++ai)
#pragma unroll
            for (int m = 0; m < 4; ++m) { float* rowp = C + (size_t)(row0 + ai * HALF + m * 16) * 256 + col0;
#pragma unroll
                for (int bj = 0; bj < 2; ++bj)
#pragma unroll
                    for (int n = 0; n < 2; ++n) *(f32x4*)(rowp + bj * HALF + n * 16) = acc[ai][bj][m][n]; }
    }
};

__device__ __forceinline__ void rope8(f32x4& v0, f32x4& v1, const float* rope_row, int wc, int fq) {
    if ((wc & 1) == 0) {
        f32x4 o0, o1;
#pragma unroll
        for (int j = 0; j < 4; ++j) { o0[j] = __shfl_xor(v0[j], 16); o1[j] = __shfl_xor(v1[j], 16); }
        if (fq < 2) {
            const f32x4 c0 = *(const f32x4*)(rope_row), c1 = *(const f32x4*)(rope_row + 4), s0 = *(const f32x4*)(rope_row + 8), s1 = *(const f32x4*)(rope_row + 12);
            if (fq == 0) { v0 = v0 * c0 - o0 * s0; v1 = v1 * c1 - o1 * s1; }
            else         { v0 = v0 * c0 + o0 * s0; v1 = v1 * c1 + o1 * s1; }
        }
    }
}

struct EpiInProj {
    static constexpr bool PERM = true, AFTER_DRAIN = false;
    unsigned char* ws;
    __device__ __forceinline__ void operator()(const f32x4 (&acc)[2][2][4][2], const Unit& u, int wr, int wc, int fr, int fq) const {
        const float* rstd = (const float*)(ws + WS_RSTD); const float* rope = (const float*)(ws + WS_ROPE);
        bf16_t* qraw = (bf16_t*)(ws + WS_QRAW); bf16_t* qrot = (bf16_t*)(ws + WS_QROT); bf16_t* kraw = (bf16_t*)(ws + WS_KRAW); bf16_t* vraw = (bf16_t*)(ws + WS_VRAW);
        bf16_t* ks_t = (bf16_t*)(ws + WS_KS_T); bf16_t* vs_rm = (bf16_t*)(ws + WS_VS_RM); bf16_t* kw_t = (bf16_t*)(ws + WS_KW_T); bf16_t* vw_rm = (bf16_t*)(ws + WS_VW_RM);
        bf16_t* bg = (bf16_t*)(ws + WS_BG); bf16_t* cg = (bf16_t*)(ws + WS_CG); bf16_t* xc = (bf16_t*)(ws + WS_XC); float* gates = (float*)(ws + WS_GATES);
        const int pn = u.pn, row0 = u.pm * BM + wr * 64 + fr;
#pragma unroll
        for (int ai = 0; ai < 2; ++ai)
#pragma unroll
            for (int m = 0; m < 4; ++m) {
                const int r = row0 + ai * HALF + m * 16; const float rs = rstd[r];
                const int b = r >> 14, s = r & (SEQ_ - 1);
                const float* rrow = rope + (size_t)r * 16;
#pragma unroll
                for (int bj = 0; bj < 2; ++bj) {
                    f32x4 v0 = acc[ai][bj][m][0] * rs, v1 = acc[ai][bj][m][1] * rs;
                    const int ct = bj * HALF + wc * 32 + 8 * fq;
                    const int c = wc * 32 + 8 * fq, g = c >> 6, d0 = c & 63;
                    if (pn <= 1) {
                        const size_t o = (size_t)r * 512 + pn * 256 + ct;
                        store8(qraw + o, v0, v1);
                        rope8(v0, v1, rrow, wc, fq);
                        store8(qrot + o, v0, v1);
                    } else if (pn == 2) {
                        bf16_t* dst = (bj == 0 ? kraw : vraw) + ((size_t)((b * 2 + g) * SEQ_ + s)) * 64 + d0;
                        store8(dst, v0, v1);
                    } else if (pn <= 4) {
                        if (bj == 0) {
                            rope8(v0, v1, rrow, wc, fq);
                            bf16_t* base = (pn == 3 ? ks_t : kw_t) + (size_t)(b * 2 + g) * SEQ_ * 64;
                            const int off = (((s >> 4) * 2 + (d0 >> 5)) * 64 + ((d0 & 31) >> 3) * 16 + (s & 15)) * 8;
                            store8(base + off, v0, v1);
                        } else {
                            bf16_t* dst = (pn == 3 ? vs_rm : vw_rm) + ((size_t)((b * 2 + g) * SEQ_ + s)) * 64 + d0;
                            store8(dst, v0, v1);
                        }
                    } else if (pn <= 10) {
                        bf16_t* base = pn <= 6 ? bg : (pn <= 8 ? cg : xc);
                        store8(base + (size_t)r * 512 + ((pn - 5) & 1) * 256 + ct, v0, v1);
                    } else {
                        if (bj == 0 && wc == 0 && fq < 3) {
                            f32x4 a, bb;
#pragma unroll
                            for (int j = 0; j < 4; ++j) { a[j] = sigmoid_f(v0[j]); bb[j] = sigmoid_f(v1[j]); }
                            float* dst = gates + (size_t)r * 24 + 8 * fq;
                            *(f32x4*)dst = a; *(f32x4*)(dst + 4) = bb;
                        }
                    }
                }
            }
    }
};

struct CmpOrder {
    int G, c;
    __device__ __forceinline__ bool next(int i, Unit& u) const { const int L = i * G + c; if (L >= 32) return false; u.pm = L; u.pn = L >> 4; return true; }
    __device__ __forceinline__ void a_ready(const Unit&) const {}
    __device__ __forceinline__ void done(const Unit&) const {}
};
template <class Epi, class Sched, bool ALIGN_EPI = false, bool SP2 = false>
__device__ __forceinline__ void gemm_phase(PG8_LAS unsigned char* lds, const Gemm g, const Sched& S, const Epi& E) {
    int tid_ = threadIdx.x; asm volatile("" : "+v"(tid_));
    const int tid = tid_, wid = __builtin_amdgcn_readfirstlane(tid >> 6), lane = tid & 63, wr = wid >> 2, wc = wid & 3, fr = lane & 15, fq = lane >> 4;
    const int K = g.K, nt = K / BK;
    unsigned voffA[2], voffB[2];
#pragma unroll
    for (int i = 0; i < 2; ++i) { int R, C; stage_rc(tid * 16 + i * 8192, R, C); const int Rb = Epi::PERM ? ((R & ~31) + perm32(R & 31)) : R;
        voffA[i] = (unsigned)(R * g.lda + C) * 2u; voffB[i] = (unsigned)(Rb * g.ldb + C) * 2u; }
    const size_t kstep = (size_t)(BK * 2);
    const size_t hstepA = (size_t)HALF * g.lda * 2, hstepB = (size_t)HALF * g.ldb * 2;
    const size_t tstepA = 2 * hstepA, tstepB = 2 * hstepB;
    const unsigned ldsw = (unsigned)wid * 1024u;
    const int aoff = lds_byte(wr * 64 + fr, fq * 8), boff = lds_byte(wc * 32 + fr, fq * 8);
#define PG8_SA(b, h) (((b) * 2 + (h)) * HTB)
#define PG8_SB(b, h) ((4 + (b) * 2 + (h)) * HTB)
#define PG8_STAGE(bufoff, gbase, voff) do { _Pragma("unroll") for (int _i = 0; _i < 2; ++_i) \
        __builtin_amdgcn_global_load_lds((const unsigned*)((const char*)(gbase) + (voff)[_i]), (PG8_LAS unsigned*)(lds + (bufoff) + ldsw + _i * 8192), 16, 0, 0); } while (0)
#define PG8_LDA(dst, b, h) do { _Pragma("unroll") for (int m = 0; m < 4; ++m) _Pragma("unroll") for (int k = 0; k < 2; ++k) dst[m][k] = *(const PG8_LAS bf16x8*)(lds + PG8_SA(b, h) + aoff + m * 2048 + k * 1024); } while (0)
#define PG8_LDB(dst, b, h) do { _Pragma("unroll") for (int n = 0; n < 2; ++n) _Pragma("unroll") for (int k = 0; k < 2; ++k) dst[n][k] = *(const PG8_LAS bf16x8*)(lds + PG8_SB(b, h) + boff + n * 2048 + k * 1024); } while (0)
#define PG8_MMA(ai, bj, At, Bt) do { __builtin_amdgcn_s_setprio(1); _Pragma("unroll") for (int m = 0; m < 4; ++m) _Pragma("unroll") for (int n = 0; n < 2; ++n) _Pragma("unroll") for (int k = 0; k < 2; ++k) \
        acc[ai][bj][m][n] = __builtin_amdgcn_mfma_f32_16x16x32_bf16(Bt[n][k], At[m][k], acc[ai][bj][m][n], 0, 0, 0); __builtin_amdgcn_s_setprio(0); } while (0)
#define PG8_WAIT_V(n) asm volatile("s_waitcnt vmcnt(" #n ")" ::: "memory")
#define PG8_WAIT_L(n) asm volatile("s_waitcnt lgkmcnt(" #n ")" ::: "memory")
#define PG8_BAR __builtin_amdgcn_s_barrier()
#define PG8_SCHED __builtin_amdgcn_sched_barrier(0)
    Unit cur, nxt; int ui = 0;
    if (!S.next(0, cur)) return;
    f32x4 acc[2][2][4][2];
#pragma unroll
    for (int a = 0; a < 2; ++a)
#pragma unroll
        for (int b = 0; b < 2; ++b)
#pragma unroll
            for (int m = 0; m < 4; ++m)
#pragma unroll
                for (int n = 0; n < 2; ++n) acc[a][b][m][n] = (f32x4){0.f, 0.f, 0.f, 0.f};
    bf16x8 At[4][2], B0[2][2], B1[2][2];
    const char* cA = (const char*)g.A + (size_t)cur.pm * tstepA; const char* cB = (const char*)g.Bt + (size_t)cur.pn * tstepB;
    S.a_ready(cur);
    if constexpr (SP2) {
        PG8_STAGE(PG8_SB(0, 0), cB, voffB); PG8_STAGE(PG8_SB(0, 1), cB + hstepB, voffB); PG8_STAGE(PG8_SA(0, 0), cA, voffA); PG8_STAGE(PG8_SA(0, 1), cA + hstepA, voffA);
        if (wr == 1) PG8_BAR;
        PG8_WAIT_V(2); PG8_BAR;
        PG8_STAGE(PG8_SB(1, 0), cB + kstep, voffB); PG8_STAGE(PG8_SA(1, 0), cA + kstep, voffA); PG8_STAGE(PG8_SB(1, 1), cB + hstepB + kstep, voffB);
        PG8_WAIT_V(6); PG8_BAR;
    } else {
        PG8_STAGE(PG8_SB(0, 0), cB, voffB); PG8_STAGE(PG8_SA(0, 0), cA, voffA); PG8_STAGE(PG8_SB(0, 1), cB + hstepB, voffB); PG8_STAGE(PG8_SA(0, 1), cA + hstepA, voffA);
        if (wr == 1) PG8_BAR;
        PG8_WAIT_V(4); PG8_BAR;
        PG8_STAGE(PG8_SB(1, 0), cB + kstep, voffB); PG8_STAGE(PG8_SA(1, 0), cA + kstep, voffA); PG8_STAGE(PG8_SB(1, 1), cB + hstepB + kstep, voffB);
        PG8_WAIT_V(6); PG8_BAR;
    }
    for (;;) {
        const bool has_next = S.next(ui + 1, nxt);
        const char* nA = has_next ? (const char*)g.A + (size_t)nxt.pm * tstepA : cA; const char* nB = has_next ? (const char*)g.Bt + (size_t)nxt.pn * tstepB : cB;
        for (int t = 0; t < nt; t += 2) {
            const bool last = (t == nt - 2);
            const char* a1 = cA + (size_t)(t + 1) * kstep;
            const char* a2 = last ? nA : cA + (size_t)(t + 2) * kstep; const char* b2 = last ? nB : cB + (size_t)(t + 2) * kstep;
            const char* a3 = a2 + kstep; const char* b3 = b2 + kstep;
            if (last && has_next) S.a_ready(nxt);
            if constexpr (SP2) {
            PG8_LDB(B0, 0, 0); PG8_LDB(B1, 0, 1); PG8_SCHED; PG8_LDA(At, 0, 0); PG8_STAGE(PG8_SA(1, 1), a1 + hstepA, voffA);
            PG8_WAIT_V(8); PG8_WAIT_L(0); PG8_BAR; PG8_MMA(0, 0, At, B0); PG8_MMA(0, 1, At, B1); PG8_BAR; PG8_SCHED;
            PG8_LDA(At, 0, 1); PG8_STAGE(PG8_SB(0, 0), b2, voffB); PG8_STAGE(PG8_SB(0, 1), b2 + hstepB, voffB); PG8_STAGE(PG8_SA(0, 0), a2, voffA);
            PG8_WAIT_V(8); PG8_WAIT_L(0); PG8_BAR; PG8_MMA(1, 0, At, B0); PG8_MMA(1, 1, At, B1); PG8_BAR; PG8_SCHED;
            PG8_LDB(B0, 1, 0); PG8_LDB(B1, 1, 1); PG8_SCHED; PG8_LDA(At, 1, 0); PG8_STAGE(PG8_SA(0, 1), a2 + hstepA, voffA);
            PG8_WAIT_V(8); PG8_WAIT_L(0); PG8_BAR; PG8_MMA(0, 0, At, B0); PG8_MMA(0, 1, At, B1); PG8_BAR; PG8_SCHED;
            PG8_LDA(At, 1, 1); PG8_STAGE(PG8_SB(1, 0), b3, voffB); PG8_STAGE(PG8_SB(1, 1), b3 + hstepB, voffB); PG8_STAGE(PG8_SA(1, 0), a3, voffA);
            PG8_WAIT_V(8); PG8_WAIT_L(0); PG8_BAR; PG8_MMA(1, 0, At, B0); PG8_MMA(1, 1, At, B1); PG8_BAR; PG8_SCHED;
            } else {
            PG8_LDB(B0, 0, 0); PG8_SCHED; PG8_LDA(At, 0, 0); PG8_STAGE(PG8_SA(1, 1), a1 + hstepA, voffA);
            PG8_WAIT_L(8); PG8_BAR; PG8_WAIT_L(0); PG8_MMA(0, 0, At, B0); PG8_BAR; PG8_SCHED;
            PG8_LDB(B1, 0, 1); PG8_STAGE(PG8_SB(0, 0), b2, voffB);
            PG8_BAR; PG8_WAIT_L(0); PG8_MMA(0, 1, At, B1); PG8_BAR;
            PG8_LDA(At, 0, 1); PG8_STAGE(PG8_SA(0, 0), a2, voffA);
            PG8_BAR; PG8_WAIT_L(0); PG8_MMA(1, 0, At, B0); PG8_BAR; PG8_SCHED;
            PG8_STAGE(PG8_SB(0, 1), b2 + hstepB, voffB);
            PG8_WAIT_V(6); PG8_BAR; PG8_MMA(1, 1, At, B1); PG8_BAR;
            PG8_LDB(B0, 1, 0); PG8_SCHED; PG8_LDA(At, 1, 0); PG8_STAGE(PG8_SA(0, 1), a2 + hstepA, voffA);
            PG8_WAIT_L(8); PG8_BAR; PG8_WAIT_L(0); PG8_MMA(0, 0, At, B0); PG8_BAR; PG8_SCHED;
            PG8_LDB(B1, 1, 1); PG8_STAGE(PG8_SB(1, 0), b3, voffB);
            PG8_BAR; PG8_WAIT_L(0); PG8_MMA(0, 1, At, B1); PG8_BAR;
            PG8_LDA(At, 1, 1); PG8_STAGE(PG8_SA(1, 0), a3, voffA);
            PG8_BAR; PG8_WAIT_L(0); PG8_MMA(1, 0, At, B0); PG8_BAR; PG8_SCHED;
            PG8_STAGE(PG8_SB(1, 1), b3 + hstepB, voffB);
            PG8_WAIT_V(6); PG8_BAR; PG8_MMA(1, 1, At, B1); PG8_BAR;
            }
        }
        if constexpr (ALIGN_EPI) { if (wr == 0) PG8_BAR; }
        if constexpr (!Epi::AFTER_DRAIN) { E(acc, cur, wr, wc, fr, fq); S.done(cur); }
        if (!has_next) break;
#pragma unroll
        for (int a = 0; a < 2; ++a)
#pragma unroll
            for (int b = 0; b < 2; ++b)
#pragma unroll
                for (int m = 0; m < 4; ++m)
#pragma unroll
                    for (int n = 0; n < 2; ++n) acc[a][b][m][n] = (f32x4){0.f, 0.f, 0.f, 0.f};
        cur = nxt; cA = nA; cB = nB; ++ui;
        if constexpr (ALIGN_EPI) { if (wr == 1) PG8_BAR; }
    }
    PG8_WAIT_V(0);
    if constexpr (!ALIGN_EPI) { if (wr == 0) PG8_BAR; }
    PG8_BAR;
    if constexpr (Epi::AFTER_DRAIN) { E.fused(acc, cur, wr, wc, fr, fq, lds, wid, lane); S.done(cur); }
#undef PG8_SA
#undef PG8_SB
#undef PG8_STAGE
#undef PG8_LDA
#undef PG8_LDB
#undef PG8_MMA
#undef PG8_WAIT_V
#undef PG8_WAIT_L
#undef PG8_BAR
#undef PG8_SCHED
}
}
#define GAS __attribute__((address_space(1)))
#define LAS __attribute__((address_space(3)))
typedef unsigned short bf16;
typedef unsigned v4u __attribute__((ext_vector_type(4)));
typedef float f32x4 __attribute__((ext_vector_type(4)));
typedef short bf16x8 __attribute__((ext_vector_type(8)));
typedef GAS unsigned gu32;
typedef GAS unsigned long long gu64;
#define RLX_AGENT __ATOMIC_RELAXED, __HIP_MEMORY_SCOPE_AGENT
#define LDS_WAIT() asm volatile("s_waitcnt lgkmcnt(0)" ::: "memory")
#define VM_WAIT() asm volatile("s_waitcnt vmcnt(0)" ::: "memory")
__device__ __forceinline__ unsigned long long rt() { return __builtin_amdgcn_s_memrealtime(); }
__device__ __forceinline__ unsigned f2bf(float f) { unsigned u = __builtin_bit_cast(unsigned, f); return (u + 0x7fffu + ((u >> 16) & 1u)) >> 16; }
__device__ __forceinline__ unsigned pk2(float lo, float hi) { return f2bf(lo) | (f2bf(hi) << 16); }

#define XB_TMO      128
#define XB_XCNT(j)  (256  + 64 * (j))
#define XB_XSUB(j)  (1280 + 64 * (j))
#define XB_XGEN(j)  (2304 + 64 * (j))
#define XB_TOP      3328
#define XB_TOPGEN   3392
#define XCD_BAR_WORDS 3456
#define XB_SPIN_CAP (1u << 18)

__device__ __forceinline__ unsigned xb_ld(unsigned* p)              { return __hip_atomic_load(p, __ATOMIC_RELAXED, __HIP_MEMORY_SCOPE_AGENT); }
__device__ __forceinline__ unsigned xb_add(unsigned* p, unsigned v) { return __hip_atomic_fetch_add(p, v, __ATOMIC_RELAXED, __HIP_MEMORY_SCOPE_AGENT); }
__device__ __forceinline__ unsigned xb_xcc_id() { return (unsigned)__builtin_amdgcn_s_getreg((3 << 11) | 20) & 0xFu; }
#define XB_SPIN(cond, bar) do { unsigned _sp = 0; while (cond) { __builtin_amdgcn_s_sleep(1); \
    if ((++_sp & 255u) == 0u) { if (xb_ld(&(bar)[XB_TMO])) break; if (_sp > XB_SPIN_CAP) { atomicAdd(&(bar)[XB_TMO], 1u); break; } } } } while (0)

struct XcdBarrier {
    unsigned* bar; unsigned x;
    volatile LAS unsigned* st;
};

__device__ __forceinline__ XcdBarrier xcd_barrier_post(unsigned* bar, volatile LAS unsigned* st) {
    XcdBarrier b; b.bar = bar; b.x = xb_xcc_id(); b.st = st;
    if (threadIdx.x == 0) (void)xb_add(&bar[XB_XCNT(b.x)], 1u);
    return b;
}
__device__ __forceinline__ void xcd_barrier_complete(unsigned* bar, unsigned x, unsigned& nloc, unsigned& nx) {
    const unsigned G = gridDim.x * gridDim.y * gridDim.z;
    unsigned sum, cnt, mine, sp = 0u;
    for (;;) {
        sum = 0u; cnt = 0u; mine = 0u;
#pragma unroll
        for (unsigned j = 0; j < 16; ++j) { const unsigned c = xb_ld(&bar[XB_XCNT(j)]); sum += c; cnt += (c > 0u) ? 1u : 0u; mine = (j == x) ? c : mine; }
        if (sum == G) break;
        __builtin_amdgcn_s_sleep(1);
        if ((++sp & 255u) == 0u) { if (xb_ld(&bar[XB_TMO])) break; if (sp > XB_SPIN_CAP) { atomicAdd(&bar[XB_TMO], 1u); break; } }
    }
    nloc = mine > 0u ? mine : 1u; nx = cnt > 0u ? cnt : 1u;
}

__device__ __forceinline__ void xcd_barrier(const XcdBarrier& b) {
    asm volatile("s_waitcnt vmcnt(0)" ::: "memory");
    __syncthreads();
    if (threadIdx.x == 0) {
        unsigned* bar = b.bar;
        __builtin_amdgcn_s_waitcnt(0);
        unsigned nloc = b.st[0], nx = b.st[1];
        if (nloc == 0u) { xcd_barrier_complete(bar, b.x, nloc, nx); b.st[0] = nloc; b.st[1] = nx; }
        const unsigned old = xb_add(&bar[XB_XSUB(b.x)], 1u);
        const unsigned gen = old / nloc;
        if (old + 1u == (gen + 1u) * nloc) {
            __builtin_amdgcn_fence(__ATOMIC_RELEASE, "agent");
            asm volatile("s_waitcnt vmcnt(0)" ::: "memory");
            const unsigned og = xb_add(&bar[XB_TOP], 1u);
            const unsigned tg = og / nx;
            if (og + 1u == (tg + 1u) * nx) xb_add(&bar[XB_TOPGEN], 1u);
            else XB_SPIN(xb_ld(&bar[XB_TOPGEN]) == tg, bar);
            __builtin_amdgcn_fence(__ATOMIC_ACQUIRE, "agent");
            xb_add(&bar[XB_XGEN(b.x)], 1u);
            asm volatile("s_waitcnt vmcnt(0)" ::: "memory");
        } else {
            XB_SPIN(xb_ld(&bar[XB_XGEN(b.x)]) == gen, bar);
            __builtin_amdgcn_fence(__ATOMIC_ACQUIRE, "agent");
            asm volatile("s_waitcnt vmcnt(0)" ::: "memory");
        }
    }
    __syncthreads();
}

typedef float f32x2 __attribute__((ext_vector_type(2)));
typedef unsigned v2u __attribute__((ext_vector_type(2)));
__device__ __forceinline__ unsigned pkc(float lo, float hi) { return pg8::pk2c(lo, hi); }
__device__ __forceinline__ float bf_lo(unsigned w) { return __uint_as_float(w << 16); }
__device__ __forceinline__ float bf_hi(unsigned w) { return __uint_as_float(w & 0xffff0000u); }
__device__ __forceinline__ float wave_sum(float v) {
#pragma unroll
    for (int o = 1; o < 64; o <<= 1) v += __shfl_xor(v, o);
    return v;
}
__device__ __forceinline__ f32x4 mfma16(bf16x8 a, bf16x8 b, f32x4 c) { return __builtin_amdgcn_mfma_f32_16x16x32_bf16(a, b, c, 0, 0, 0); }
__device__ __forceinline__ float ex2(float x) { return __builtin_amdgcn_exp2f(x); }
__device__ __forceinline__ bf16x8 pack8(const f32x4& a, const f32x4& b) { v4u w; w.x = pkc(a[0], a[1]); w.y = pkc(a[2], a[3]); w.z = pkc(b[0], b[1]); w.w = pkc(b[2], b[3]); return __builtin_bit_cast(bf16x8, w); }

__device__ __forceinline__ void tr_item(const float* W, int ldw, int col0, int nvalid, const float* gain, bf16* WT, int ldt, int drow0, LAS float* scr, int kb, int n0, int lane) {
    const int k0 = 64 * kb;
#pragma unroll 8
    for (int i = 0; i < 32; ++i) { const int kk = 2 * i + (lane >> 5), n = n0 + (lane & 31);
        float v = (n < nvalid) ? W[(size_t)(k0 + kk) * ldw + col0 + n] : 0.f; if (gain) v *= gain[k0 + kk];
        scr[kk * 33 + (lane & 31)] = v; }
    LDS_WAIT(); asm volatile("" ::: "memory");
    const int c = lane & 7;
#pragma unroll
    for (int j = 0; j < 4; ++j) { const int n = (lane >> 3) + 8 * j; const LAS float* s = scr + (8 * c) * 33 + n;
        v4u o; o.x = pkc(s[0 * 33], s[1 * 33]); o.y = pkc(s[2 * 33], s[3 * 33]); o.z = pkc(s[4 * 33], s[5 * 33]); o.w = pkc(s[6 * 33], s[7 * 33]);
        *(GAS v4u*)(WT + (size_t)(drow0 + n) * ldt + k0 + 8 * c) = o; }
    LDS_WAIT(); asm volatile("" ::: "memory");
}

struct In {
    const float *x; const int* pos;
    const float *f1_pre, *f1_wg, *f1_wu, *f1_wd, *f1_post, *mix_pre, *w_in, *pe_k, *w1_k, *w2_k, *pe_v, *w1_v, *w2_v, *conv_w, *aon, *con, *w_out, *mix_post, *f2_pre, *f2_wg, *f2_wu, *f2_wd, *f2_post;
};

__device__ __forceinline__ void pro_weights(const In& I, unsigned char* ws, LAS float* scr, int gw, int NGW, int lane) {
    constexpr int I_GU = 16 * 88, I_D = 44 * 32, I_INM = 16 * 40, I_ING = 16, I_INC = 16 * 16, I_O = 16 * 32, I_W1 = 32 * 8;
    constexpr int PER_LAYER = 4 * I_GU + 2 * I_D + I_INM + I_ING + 3 * I_INC + I_O + 2 * I_W1;
    for (int it = gw; it < NLAYER * PER_LAYER; it += NGW) {
        const int l = it / PER_LAYER; int r = it % PER_LAYER;
        unsigned char* wl = ws + WS_W + (size_t)l * W_LAYER;
        if (r < I_GU) { const int kb = r / 88, n0 = 32 * (r % 88); tr_item(I.f1_wg + (size_t)l * DM * DFF, DFF, 0, DFF, I.f1_pre + (size_t)l * DM, (bf16*)(wl + WO_GU1), DM, (n0 >> 7) * 256 + (n0 & 127), scr, kb, n0, lane); continue; } r -= I_GU;
        if (r < I_GU) { const int kb = r / 88, n0 = 32 * (r % 88); tr_item(I.f1_wu + (size_t)l * DM * DFF, DFF, 0, DFF, I.f1_pre + (size_t)l * DM, (bf16*)(wl + WO_GU1), DM, (n0 >> 7) * 256 + (n0 & 127) + 128, scr, kb, n0, lane); continue; } r -= I_GU;
        if (r < I_D) { const int kb = r / 32, n0 = 32 * (r % 32); tr_item(I.f1_wd + (size_t)l * DFF * DM, DM, 0, DM, nullptr, (bf16*)(wl + WO_D1), DFF, n0, scr, kb, n0, lane); continue; } r -= I_D;
        if (r < I_GU) { const int kb = r / 88, n0 = 32 * (r % 88); tr_item(I.f2_wg + (size_t)l * DM * DFF, DFF, 0, DFF, I.f2_pre + (size_t)l * DM, (bf16*)(wl + WO_GU2), DM, (n0 >> 7) * 256 + (n0 & 127), scr, kb, n0, lane); continue; } r -= I_GU;
        if (r < I_GU) { const int kb = r / 88, n0 = 32 * (r % 88); tr_item(I.f2_wu + (size_t)l * DM * DFF, DFF, 0, DFF, I.f2_pre + (size_t)l * DM, (bf16*)(wl + WO_GU2), DM, (n0 >> 7) * 256 + (n0 & 127) + 128, scr, kb, n0, lane); continue; } r -= I_GU;
        if (r < I_D) { const int kb = r / 32, n0 = 32 * (r % 32); tr_item(I.f2_wd + (size_t)l * DFF * DM, DM, 0, DM, nullptr, (bf16*)(wl + WO_D2), DFF, n0, scr, kb, n0, lane); continue; } r -= I_D;
        const float* Win = I.w_in + (size_t)l * DM * 2840; const float* mpre = I.mix_pre + (size_t)l * DM; bf16* WI = (bf16*)(wl + WO_IN);
        if (r < I_INM) { const int kb = r / 40, n0 = 32 * (r % 40); tr_item(Win, 2840, 0, 1280, mpre, WI, DM, n0, scr, kb, n0, lane); continue; } r -= I_INM;
        if (r < I_ING) { tr_item(Win, 2840, 1280, 24, mpre, WI, DM, 2816, scr, r, 0, lane); continue; } r -= I_ING;
        if (r < I_INC) { const int kb = r / 16, n0 = 32 * (r % 16); tr_item(Win, 2840, 1304, 512, mpre, WI, DM, 1280 + n0, scr, kb, n0, lane); continue; } r -= I_INC;
        if (r < I_INC) { const int kb = r / 16, n0 = 32 * (r % 16); tr_item(Win, 2840, 1816, 512, mpre, WI, DM, 1792 + n0, scr, kb, n0, lane); continue; } r -= I_INC;
        if (r < I_INC) { const int kb = r / 16, n0 = 32 * (r % 16); tr_item(Win, 2840, 2328, 512, mpre, WI, DM, 2304 + n0, scr, kb, n0, lane); continue; } r -= I_INC;
        if (r < I_O) { const int kb = r / 32, n0 = 32 * (r % 32);
            const float* gn = (kb < 8) ? (I.aon + (size_t)l * 512) : (I.con + (size_t)l * 512 - 512);
            tr_item(I.w_out + (size_t)l * DM * DM, DM, 0, DM, gn, (bf16*)(wl + WO_O), DM, n0, scr, kb, n0, lane); continue; } r -= I_O;
        if (r < I_W1) { const int kb = r / 8, n0 = 32 * (r % 8); tr_item(I.w1_k + (size_t)l * 2048 * 256, 256, 0, 256, nullptr, (bf16*)(wl + WO_W1), 2048, n0, scr, kb, n0, lane); continue; } r -= I_W1;
        { const int kb = r / 8, n0 = 32 * (r % 8); tr_item(I.w1_v + (size_t)l * 2048 * 256, 256, 0, 256, nullptr, (bf16*)(wl + WO_W1), 2048, 256 + n0, scr, kb, n0, lane); }
    }
    for (int i = gw * 64 + lane; i < NLAYER * 28672; i += NGW * 64) { const int l = i / 28672, q = i % 28672;
        *(GAS v4u*)(ws + WS_W + (size_t)l * W_LAYER + WO_IN + (size_t)2848 * DM * 2 + (size_t)q * 16) = (v4u){0u, 0u, 0u, 0u}; }
    for (int j = gw; j < NLAYER * 2 * 4; j += NGW) { const int l = j >> 3, kv = (j >> 2) & 1, c = (j & 3) * 64 + lane;
        const float* pe = (kv == 0 ? I.pe_k : I.pe_v) + (size_t)l * 2048; const float* w1 = (kv == 0 ? I.w1_k : I.w1_v) + (size_t)l * 2048 * 256;
        float s = 0.f;
        for (int k = 0; k < 2048; ++k) s += pe[k] * w1[(size_t)k * 256 + c];
        ((float*)(ws + WS_BIAS))[(l * 2 + kv) * 256 + c] = s; }
}

__device__ __forceinline__ void pro_rope(const int* pos, float* rope, int gtid, int nthreads) {
    const double invf[8] = {1.0, 0.19392274474868576, 0.03760603093086393, 0.007292664737217109, 0.001414213562373095, 0.0002742481756762073, 5.318295896944988e-05, 1.031338537721246e-05};
    for (int e = gtid; e < M * 8; e += nthreads) { const int row = e >> 3, i = e & 7;
        double f = 1.0;
#pragma unroll
        for (int q = 0; q < 8; ++q) f = (i == q) ? invf[q] : f;
        const double ang = (double)pos[row] * f;
        const double k = __builtin_rint(ang * 0.15915494309189535);
        const double red = __builtin_fma(-k, 1.2246467991473532e-16 * 2.0, __builtin_fma(-k, 6.283185307179586, ang));
        const float rf = (float)red;
        rope[(size_t)row * 16 + i] = cosf(rf); rope[(size_t)row * 16 + 8 + i] = sinf(rf); }
}

__device__ __forceinline__ void pro_xrow(const float* xrow, bf16* xbrow, float* rstd_out, int lane) {
    const GAS f32x4* xr = (const GAS f32x4*)xrow + lane;
    f32x4 v[4]; float s = 0.f;
#pragma unroll
    for (int j = 0; j < 4; ++j) { v[j] = xr[64 * j]; s += (v[j].x * v[j].x + v[j].y * v[j].y) + (v[j].z * v[j].z + v[j].w * v[j].w); }
    s = wave_sum(s);
    GAS v2u* o8 = (GAS v2u*)xbrow + lane;
#pragma unroll
    for (int j = 0; j < 4; ++j) o8[64 * j] = (v2u){pkc(v[j].x, v[j].y), pkc(v[j].z, v[j].w)};
    if (lane == 0) *rstd_out = 1.0f / sqrtf(s * (1.0f / DM) + EPS);
}

__device__ __forceinline__ void rowpass(const float* xin, float* xout, const bf16* h, const float* gpost, float scale, bf16* xb, float* rstd, int gw, int NGW, int lane) {
    constexpr int R = 4;
    f32x4 gv[4];
#pragma unroll
    for (int j = 0; j < 4; ++j) gv[j] = *((const GAS f32x4*)gpost + lane + 64 * j);
    for (int row0 = gw * R; row0 < M; row0 += NGW * R) {
        f32x4 xv[R][4]; v2u hw[R][4];
#pragma unroll
        for (int r = 0; r < R; ++r) { const GAS v2u* hr = (const GAS v2u*)(h + (size_t)(row0 + r) * DM) + lane; const GAS f32x4* xr = (const GAS f32x4*)(xin + (size_t)(row0 + r) * DM) + lane;
#pragma unroll
            for (int j = 0; j < 4; ++j) { hw[r][j] = hr[64 * j]; xv[r][j] = xr[64 * j]; } }
        float s[R];
#pragma unroll
        for (int r = 0; r < R; ++r) { s[r] = 0.f;
#pragma unroll
            for (int j = 0; j < 4; ++j) { const float a = bf_lo(hw[r][j].x), b = bf_hi(hw[r][j].x), c = bf_lo(hw[r][j].y), d = bf_hi(hw[r][j].y); s[r] += (a * a + b * b) + (c * c + d * d); } }
#pragma unroll
        for (int o = 1; o < 64; o <<= 1) {
#pragma unroll
            for (int r = 0; r < R; ++r) s[r] += __shfl_xor(s[r], o); }
        float s2[R];
#pragma unroll
        for (int r = 0; r < R; ++r) { const float rh = scale / sqrtf(s[r] * (1.0f / DM) + EPS); s2[r] = 0.f;
#pragma unroll
            for (int j = 0; j < 4; ++j) { const f32x4 hv = {bf_lo(hw[r][j].x), bf_hi(hw[r][j].x), bf_lo(hw[r][j].y), bf_hi(hw[r][j].y)};
                xv[r][j] = xv[r][j] + hv * gv[j] * rh; s2[r] += (xv[r][j].x * xv[r][j].x + xv[r][j].y * xv[r][j].y) + (xv[r][j].z * xv[r][j].z + xv[r][j].w * xv[r][j].w); } }
#pragma unroll
        for (int r = 0; r < R; ++r) { GAS f32x4* xo = (GAS f32x4*)(xout + (size_t)(row0 + r) * DM) + lane; GAS v2u* o8 = (GAS v2u*)(xb + (size_t)(row0 + r) * DM) + lane;
#pragma unroll
            for (int j = 0; j < 4; ++j) { xo[64 * j] = xv[r][j]; o8[64 * j] = (v2u){pkc(xv[r][j].x, xv[r][j].y), pkc(xv[r][j].z, xv[r][j].w)}; } }
#pragma unroll
        for (int o = 1; o < 64; o <<= 1) {
#pragma unroll
            for (int r = 0; r < R; ++r) s2[r] += __shfl_xor(s2[r], o); }
        if (lane < R) { float v = s2[0];
#pragma unroll
            for (int r = 1; r < R; ++r) v = (lane == r) ? s2[r] : v;
            rstd[row0 + lane] = 1.0f / sqrtf(v * (1.0f / DM) + EPS); }
    }
}

__device__ __forceinline__ float gelu_tanh(float x) {
    const float u = 0.7978845608028654f * (x + 0.044715f * x * x * x);
    const float e = ex2(2.0f * 1.4426950408889634f * u);
    const float th = 1.0f - 2.0f * __builtin_amdgcn_rcpf(e + 1.0f);
    return 0.5f * x * (1.0f + th);
}
__device__ __forceinline__ int kt_off(int key, int d) { return (((key >> 4) * 2 + (d >> 5)) * 64 + ((d & 31) >> 3) * 16 + (key & 15)) * 8 + (d & 7); }
__device__ __forceinline__ int vt_off(int key, int d) { return ((((key >> 5) * 4 + (d >> 4)) * 64) + ((key & 15) >> 2) * 16 + (d & 15)) * 8 + (key & 3) + 4 * ((key >> 4) & 1); }

__device__ __forceinline__ void cmp2_phase(const float* hidp, const float* bias, const float* w2k, const float* w2v, bf16* kc_t, bf16* vc_t, unsigned* kcmax, int gw, int NGW, int lane) {
    const int col = lane & 15, g4 = lane >> 4;
    for (int task = gw; task < 512; task += NGW) {
        const int m0 = 16 * task, kv = m0 >> 12, bg = (m0 >> 10) & 3;
        const float* bs = bias + kv * 256; const float* w2 = kv == 0 ? w2k : w2v;
        f32x4 acc[4] = {{0.f, 0.f, 0.f, 0.f}, {0.f, 0.f, 0.f, 0.f}, {0.f, 0.f, 0.f, 0.f}, {0.f, 0.f, 0.f, 0.f}};
        const float* hrow = hidp + (size_t)(m0 + col) * 256 + 4 * g4;
#pragma unroll 2
        for (int kk = 0; kk < 16; ++kk) {
            f32x4 hv = *(const GAS f32x4*)(hrow + 16 * kk);
#pragma unroll
            for (int p = 1; p < 4; ++p) hv = hv + *(const GAS f32x4*)(hrow + (size_t)p * 8192 * 256 + 16 * kk);
            const f32x4 bv = *(const GAS f32x4*)(bs + 16 * kk + 4 * g4);
#pragma unroll
            for (int j = 0; j < 4; ++j) { const float av = gelu_tanh(hv[j] + bv[j]); const float* wr = w2 + (size_t)(16 * kk + 4 * g4 + j) * 64 + col;
#pragma unroll
                for (int nt = 0; nt < 4; ++nt) acc[nt] = __builtin_amdgcn_mfma_f32_16x16x4f32(av, wr[16 * nt], acc[nt], 0, 0, 0); }
        }
        float nmax = 0.f;
#pragma unroll
        for (int r = 0; r < 4; ++r) { const int n = (m0 + 4 * g4 + r) & 1023; float sq = 0.f;
#pragma unroll
            for (int nt = 0; nt < 4; ++nt) { const float o = (n == 1023) ? 0.f : acc[nt][r]; sq += o * o; const int d = 16 * nt + col;
                const unsigned short ob = (unsigned short)(pkc(o, 0.f) & 0xffffu);
                if (kv == 0) kc_t[(size_t)bg * 65536 + kt_off(n, d)] = ob; else vc_t[(size_t)bg * 65536 + vt_off(n, d)] = ob; }
#pragma unroll
            for (int o = 1; o < 16; o <<= 1) sq += __shfl_xor(sq, o);
            nmax = fmaxf(nmax, sq); }
        nmax = fmaxf(nmax, __shfl_xor(nmax, 16)); nmax = fmaxf(nmax, __shfl_xor(nmax, 32));
        if (kv == 0 && lane == 0) atomicMax(kcmax + bg, __float_as_uint(nmax));
    }
}
__device__ __forceinline__ void vretile(const bf16* vrm, bf16* vt, int gw, int NGW, int lane) {
    for (int it = gw; it < 4 * (SEQ / 32); it += NGW) {
        const int bg = it / (SEQ / 32), kg = it % (SEQ / 32);
        const bf16* src = vrm + ((size_t)bg * SEQ + kg * 32) * 64; bf16* dst = vt + (size_t)bg * SEQ * 64;
#pragma unroll
        for (int g4 = 0; g4 < 4; ++g4) { unsigned short e[8];
#pragma unroll
            for (int j = 0; j < 8; ++j) { const int key = 4 * g4 + (j & 3) + 16 * (j >> 2); e[j] = src[key * 64 + lane]; }
            v4u w; w.x = e[0] | ((unsigned)e[1] << 16); w.y = e[2] | ((unsigned)e[3] << 16); w.z = e[4] | ((unsigned)e[5] << 16); w.w = e[6] | ((unsigned)e[7] << 16);
            *(GAS v4u*)(dst + (size_t)((kg * 4 + (lane >> 4)) * 64 + g4 * 16 + (lane & 15)) * 8) = w; }
    }
}

__device__ __forceinline__ void unpack8(const v4u w, float (&f)[8]) { f[0] = bf_lo(w.x); f[1] = bf_hi(w.x); f[2] = bf_lo(w.y); f[3] = bf_hi(w.y); f[4] = bf_lo(w.z); f[5] = bf_hi(w.z); f[6] = bf_lo(w.w); f[7] = bf_hi(w.w); }

__device__ __forceinline__ void knorm_pass(const bf16* k_t, unsigned* kmax, int gw, int NGW, int lane) {
    for (int it = gw; it < 4 * (SEQ / 16); it += NGW) {
        const int bg = it / (SEQ / 16), tile = it % (SEQ / 16);
        const bf16* p = k_t + (size_t)bg * SEQ * 64 + (size_t)tile * 1024 + lane * 8;
        const v4u a = *(const GAS v4u*)p, b = *(const GAS v4u*)(p + 512);
        float f[8], s = 0.f;
        unpack8(a, f);
#pragma unroll
        for (int j = 0; j < 8; ++j) s += f[j] * f[j];
        unpack8(b, f);
#pragma unroll
        for (int j = 0; j < 8; ++j) s += f[j] * f[j];
        s += __shfl_xor(s, 16); s += __shfl_xor(s, 32);
#pragma unroll
        for (int o = 1; o < 16; o <<= 1) s = fmaxf(s, __shfl_xor(s, o));
        if (lane == 0) atomicMax(kmax + bg, __float_as_uint(s));
    }
}

__device__ __forceinline__ int mbcnt64(unsigned long long m) { return (int)__builtin_amdgcn_mbcnt_hi((unsigned)(m >> 32), __builtin_amdgcn_mbcnt_lo((unsigned)m, 0u)); }
__device__ __forceinline__ void sel_one(const f32x4 sv, int t, int* dst, int lane) {
    const int cur = t >> 6;
    unsigned u[4]; bool ok[4];
#pragma unroll
    for (int k = 0; k < 4; ++k) { const int j = 4 * lane + k; ok[k] = j <= cur; const bool forced = (j == 0) || (j == cur) || (j == cur - 1);
        const float v = forced ? 1e9f : fmaxf(sv[k], 0.f); u[k] = ok[k] ? __float_as_uint(v) : 0u; }
    bool sel[4];
    if (cur + 1 <= KTOP) {
#pragma unroll
        for (int k = 0; k < 4; ++k) sel[k] = ok[k];
    } else {
        unsigned tau = 0u;
#pragma unroll 1
        for (int bit = 30; bit >= 0; --bit) { const unsigned cand = tau | (1u << bit);
            const int cnt = __builtin_popcountll(__ballot(ok[0] && u[0] >= cand)) + __builtin_popcountll(__ballot(ok[1] && u[1] >= cand)) + __builtin_popcountll(__ballot(ok[2] && u[2] >= cand)) + __builtin_popcountll(__ballot(ok[3] && u[3] >= cand));
            if (cnt >= KTOP) tau = cand; }
        bool gt[4], eq[4]; unsigned long long em[4]; int ngt = 0;
#pragma unroll
        for (int k = 0; k < 4; ++k) { gt[k] = ok[k] && u[k] > tau; eq[k] = ok[k] && u[k] == tau; ngt += __builtin_popcountll(__ballot(gt[k])); em[k] = __ballot(eq[k]); }
        const int need = KTOP - ngt;
        int rank = mbcnt64(em[0]) + mbcnt64(em[1]) + mbcnt64(em[2]) + mbcnt64(em[3]);
#pragma unroll
        for (int k = 0; k < 4; ++k) { sel[k] = gt[k] || (eq[k] && rank < need); rank += eq[k] ? 1 : 0; }
    }
    unsigned long long sm[4];
#pragma unroll
    for (int k = 0; k < 4; ++k) sm[k] = __ballot(sel[k]);
    int pos = mbcnt64(sm[0]) + mbcnt64(sm[1]) + mbcnt64(sm[2]) + mbcnt64(sm[3]);
    const int total = __builtin_popcountll(sm[0]) + __builtin_popcountll(sm[1]) + __builtin_popcountll(sm[2]) + __builtin_popcountll(sm[3]);
#pragma unroll
    for (int k = 0; k < 4; ++k) { if (sel[k] && pos < KTOP) dst[pos] = 4 * lane + k; pos += sel[k] ? 1 : 0; }
    if (lane >= total && lane < KTOP) dst[lane] = -1;
}

__device__ __forceinline__ void acmp_item(const bf16* qraw, bf16* ocmp, const bf16* kc_t, const bf16* vc_t, int* idx, const unsigned* kcmax, LAS float* sw, int bg, int qt, int lane) {
    const int col = lane & 15, g4 = lane >> 4, b = bg >> 1, g = bg & 1;
    const int t = 16 * qt + col; const size_t row = (size_t)b * SEQ + t;
    const int nmax = (t - 31) >> 4;
    const int ntiles = (qt + 15) >> 4;
    bf16x8 qf[4][2]; float shift[4];
    const float kmx = __uint_as_float(kcmax[bg]);
#pragma unroll
    for (int hh = 0; hh < 4; ++hh) { float qn = 0.f;
#pragma unroll
        for (int s = 0; s < 2; ++s) { qf[hh][s] = *(const bf16x8*)(qraw + row * 512 + (4 * g + hh) * 64 + 32 * s + 8 * g4); float f[8]; unpack8(__builtin_bit_cast(v4u, qf[hh][s]), f);
#pragma unroll
            for (int j = 0; j < 8; ++j) qn += f[j] * f[j]; }
        qn += __shfl_xor(qn, 16); qn += __shfl_xor(qn, 32);
        shift[hh] = C2 * sqrtf(qn * kmx) * 1.01f + 1e-6f; }
    const bf16* kb = kc_t + (size_t)bg * 65536 + lane * 8; const bf16* vb = vc_t + (size_t)bg * 65536 + lane * 8;
    const f32x4 zero = {0.f, 0.f, 0.f, 0.f};
    if (__any(shift[0] > 60.f || shift[1] > 60.f || shift[2] > 60.f || shift[3] > 60.f)) {
        float mx[4] = {-1e30f, -1e30f, -1e30f, -1e30f};
        for (int T = 0; T < ntiles; ++T) { const bf16x8 k0 = *(const bf16x8*)(kb + (T * 2 + 0) * 512), k1 = *(const bf16x8*)(kb + (T * 2 + 1) * 512);
#pragma unroll
            for (int hh = 0; hh < 4; ++hh) { f32x4 s = mfma16(k0, qf[hh][0], zero); s = mfma16(k1, qf[hh][1], s);
#pragma unroll
                for (int r = 0; r < 4; ++r) mx[hh] = ((16 * T + 4 * g4 + r) <= nmax) ? fmaxf(mx[hh], s[r] * C2) : mx[hh]; } }
#pragma unroll
        for (int hh = 0; hh < 4; ++hh) { float m = fmaxf(mx[hh], __shfl_xor(mx[hh], 16)); m = fmaxf(m, __shfl_xor(m, 32)); shift[hh] = m; }
    }
    float ls[4] = {0.f, 0.f, 0.f, 0.f};
    if (ntiles > 0) {
        bf16x8 k0 = *(const bf16x8*)(kb), k1 = *(const bf16x8*)(kb + 512);
        for (int T = 0; T < ntiles; ++T) {
            const int Tn = (T + 1 < ntiles) ? T + 1 : T;
            const bf16x8 n0 = *(const bf16x8*)(kb + (Tn * 2 + 0) * 512), n1 = *(const bf16x8*)(kb + (Tn * 2 + 1) * 512);
#pragma unroll
            for (int hh = 0; hh < 4; ++hh) { f32x4 s = mfma16(k0, qf[hh][0], zero); s = mfma16(k1, qf[hh][1], s);
#pragma unroll
                for (int r = 0; r < 4; ++r) ls[hh] += ((16 * T + 4 * g4 + r) <= nmax) ? ex2(__builtin_fmaf(s[r], C2, -shift[hh])) : 0.f; }
            k0 = n0; k1 = n1;
        }
    }
#pragma unroll
    for (int hh = 0; hh < 4; ++hh) { float l = ls[hh]; l += __shfl_xor(l, 16); l += __shfl_xor(l, 32); ls[hh] = l > 0.f ? 1.0f / l : 0.f; }
    f32x4 O[4][4];
#pragma unroll
    for (int hh = 0; hh < 4; ++hh)
#pragma unroll
        for (int dt = 0; dt < 4; ++dt) O[hh][dt] = zero;
    float carry = 0.f;
    const int npairs = (ntiles + 1) >> 1;
    LAS float* srow = sw + col * 256;
    for (int kg = 0; kg < npairs; ++kg) {
        bf16x8 vf[4], kf[2][2];
#pragma unroll
        for (int dt = 0; dt < 4; ++dt) vf[dt] = *(const bf16x8*)(vb + (kg * 4 + dt) * 512);
#pragma unroll
        for (int tt = 0; tt < 2; ++tt)
#pragma unroll
            for (int s = 0; s < 2; ++s) kf[tt][s] = *(const bf16x8*)(kb + ((2 * kg + tt) * 2 + s) * 512);
        f32x4 p[2][4]; float aa[2], bb[2];
#pragma unroll
        for (int tt = 0; tt < 2; ++tt) {
            const int T = 2 * kg + tt;
            aa[tt] = 0.f; bb[tt] = 0.f;
#pragma unroll
            for (int hh = 0; hh < 4; ++hh) {
                f32x4 s = mfma16(kf[tt][0], qf[hh][0], zero); s = mfma16(kf[tt][1], qf[hh][1], s);
#pragma unroll
                for (int r = 0; r < 4; ++r) p[tt][hh][r] = ((16 * T + 4 * g4 + r) <= nmax) ? ex2(__builtin_fmaf(s[r], C2, -shift[hh])) * ls[hh] : 0.f;
                aa[tt] += 2.0f * (p[tt][hh][0] + p[tt][hh][1] + p[tt][hh][2]) + p[tt][hh][3]; bb[tt] += p[tt][hh][3];
            }
        }
#pragma unroll
        for (int hh = 0; hh < 4; ++hh) { const bf16x8 pf = pack8(p[0][hh], p[1][hh]);
#pragma unroll
            for (int dt = 0; dt < 4; ++dt) O[hh][dt] = mfma16(vf[dt], pf, O[hh][dt]); }
#pragma unroll
        for (int tt = 0; tt < 2; ++tt) {
            const int T = 2 * kg + tt;
            const float bsh = __shfl(bb[tt], (lane + 48) & 63);
            const float val = aa[tt] + (g4 == 0 ? carry : bsh);
            carry = bsh;
            srow[4 * T + g4] = val;
        }
    }
    for (int j = 8 * npairs + g4; j < NSELB; j += 4) srow[j] = (j == 8 * npairs) ? carry : 0.f;
#pragma unroll
    for (int hh = 0; hh < 4; ++hh)
#pragma unroll
        for (int dt = 0; dt < 4; ++dt) { const f32x4 o = O[hh][dt];
            *(GAS v2u*)(ocmp + row * 512 + (4 * g + hh) * 64 + 16 * dt + 4 * g4) = (v2u){pkc(o[0], o[1]), pkc(o[2], o[3])}; }
    asm volatile("s_waitcnt lgkmcnt(0)" ::: "memory");
    for (int qi = 0; qi < 16; ++qi) {
        const f32x4 sv = *((const LAS f32x4*)(sw + qi * 256) + lane);
        const int tq = 16 * qt + qi;
        sel_one(sv, tq, idx + (((size_t)b * SEQ + tq) * 2 + g) * KTOP, lane);
    }
    asm volatile("s_waitcnt lgkmcnt(0)" ::: "memory");
}

struct SlcFrags { bf16x8 kf[4][2], vf[2][4]; };
__device__ __forceinline__ void slc_load(SlcFrags& f, const bf16* kb, const bf16* vb, int blk) {
#pragma unroll
    for (int T = 0; T < 4; ++T)
#pragma unroll
        for (int s = 0; s < 2; ++s) f.kf[T][s] = *(const bf16x8*)(kb + (size_t)((blk * 4 + T) * 2 + s) * 512);
#pragma unroll
    for (int ks = 0; ks < 2; ++ks)
#pragma unroll
        for (int dt = 0; dt < 4; ++dt) f.vf[ks][dt] = *(const bf16x8*)(vb + (size_t)((blk * 2 + ks) * 4 + dt) * 512);
}
__device__ __forceinline__ void slc_compute(const SlcFrags& f, const bf16x8 (&qf)[2], f32x4 (&O)[4], float& Mx, float& l, int blk, int cur, int t, int g4) {
    const f32x4 zero = {0.f, 0.f, 0.f, 0.f};
    f32x4 e[4]; float mt = -1e30f;
    const bool diag = (blk == cur);
#pragma unroll
    for (int T = 0; T < 4; ++T) { f32x4 s = mfma16(f.kf[T][0], qf[0], zero); s = mfma16(f.kf[T][1], qf[1], s);
#pragma unroll
        for (int r = 0; r < 4; ++r) { const bool valid = !diag || (64 * blk + 16 * T + 4 * g4 + r) <= t; e[T][r] = valid ? s[r] * C2 : -1e30f; mt = fmaxf(mt, e[T][r]); } }
    mt = fmaxf(mt, __shfl_xor(mt, 16)); mt = fmaxf(mt, __shfl_xor(mt, 32));
    const float Mn = fmaxf(Mx, mt), alpha = ex2(Mx - Mn); Mx = Mn;
    float add = 0.f;
#pragma unroll
    for (int T = 0; T < 4; ++T)
#pragma unroll
        for (int r = 0; r < 4; ++r) { const float pv = (e[T][r] > -1e29f) ? ex2(e[T][r] - Mn) : 0.f; e[T][r] = pv; add += pv; }
    l = l * alpha + add;
#pragma unroll
    for (int dt = 0; dt < 4; ++dt) O[dt] = O[dt] * alpha;
#pragma unroll
    for (int ks = 0; ks < 2; ++ks) { const bf16x8 pf = pack8(e[2 * ks], e[2 * ks + 1]);
#pragma unroll
        for (int dt = 0; dt < 4; ++dt) O[dt] = mfma16(f.vf[ks][dt], pf, O[dt]); }
}
__device__ __forceinline__ void slc_compute_fs(const SlcFrags& f, const bf16x8 (&qf)[2], f32x4 (&O)[4], float shift, float& l, int blk, int cur, int t, int g4) {
    const f32x4 zero = {0.f, 0.f, 0.f, 0.f};
    f32x4 e[4];
#pragma unroll
    for (int T = 0; T < 4; ++T) { f32x4 s = mfma16(f.kf[T][0], qf[0], zero); s = mfma16(f.kf[T][1], qf[1], s);
#pragma unroll
        for (int r = 0; r < 4; ++r) e[T][r] = ex2(__builtin_fmaf(s[r], C2, -shift)); }
    if (blk == cur) {
#pragma unroll
        for (int T = 0; T < 4; ++T)
#pragma unroll
            for (int r = 0; r < 4; ++r) e[T][r] = ((64 * blk + 16 * T + 4 * g4 + r) <= t) ? e[T][r] : 0.f;
    }
    float add = 0.f;
#pragma unroll
    for (int T = 0; T < 4; ++T) add += (e[T][0] + e[T][1]) + (e[T][2] + e[T][3]);
    l += add;
#pragma unroll
    for (int ks = 0; ks < 2; ++ks) { const bf16x8 pf = pack8(e[2 * ks], e[2 * ks + 1]);
#pragma unroll
        for (int dt = 0; dt < 4; ++dt) O[dt] = mfma16(f.vf[ks][dt], pf, O[dt]); }
}
__device__ __forceinline__ void aslc_item(const bf16* qrot, const bf16* ks_t, const bf16* vs_t, const int* idx, bf16* oslc, const unsigned* kmax, int row, int g, int lane) {
    const int col = lane & 15, g4 = lane >> 4, b = row >> 14, t = row & (SEQ - 1), bg = b * 2 + g, cur = t >> 6;
    const int myidx = (lane < KTOP) ? idx[((size_t)row * 2 + g) * KTOP + lane] : -1;
    const int nsel = __builtin_popcountll(__ballot(myidx >= 0));
    bf16x8 qf[2];
#pragma unroll
    for (int s = 0; s < 2; ++s) { if (col < 4) qf[s] = *(const bf16x8*)(qrot + (size_t)row * 512 + (4 * g + col) * 64 + 32 * s + 8 * g4); else qf[s] = (bf16x8){0, 0, 0, 0, 0, 0, 0, 0}; }
    const bf16* kb = ks_t + (size_t)bg * SEQ * 64 + lane * 8; const bf16* vb = vs_t + (size_t)bg * SEQ * 64 + lane * 8;
    const f32x4 zero = {0.f, 0.f, 0.f, 0.f};
    f32x4 O[4] = {zero, zero, zero, zero}; float Mx = -1e30f, l = 0.f;
    SlcFrags fa, fb;
    slc_load(fa, kb, vb, __builtin_amdgcn_readlane(myidx, 0));
    float qn = 0.f;
    { float f[8]; unpack8(__builtin_bit_cast(v4u, qf[0]), f);
#pragma unroll
      for (int j = 0; j < 8; ++j) qn += f[j] * f[j];
      unpack8(__builtin_bit_cast(v4u, qf[1]), f);
#pragma unroll
      for (int j = 0; j < 8; ++j) qn += f[j] * f[j]; }
    qn += __shfl_xor(qn, 16); qn += __shfl_xor(qn, 32);
    const float shift = C2 * sqrtf(qn * __uint_as_float(kmax[bg])) * 1.0001f + 1e-6f;
    if (!__any(shift > 60.0f)) {
        for (int k = 0; k < nsel; k += 2) {
            const int b0 = __builtin_amdgcn_readlane(myidx, k);
            const bool has1 = (k + 1 < nsel);
            const int b1 = has1 ? __builtin_amdgcn_readlane(myidx, k + 1) : 0;
            if (has1) slc_load(fb, kb, vb, b1);
            slc_compute_fs(fa, qf, O, shift, l, b0, cur, t, g4);
            if (has1) {
                if (k + 2 < nsel) slc_load(fa, kb, vb, __builtin_amdgcn_readlane(myidx, k + 2));
                slc_compute_fs(fb, qf, O, shift, l, b1, cur, t, g4);
            }
        }
    } else {
        for (int k = 0; k < nsel; ++k) { const int b0 = __builtin_amdgcn_readlane(myidx, k); if (k > 0) slc_load(fa, kb, vb, b0); slc_compute(fa, qf, O, Mx, l, b0, cur, t, g4); }
    }
    l += __shfl_xor(l, 16); l += __shfl_xor(l, 32);
    const float inv = l > 0.f ? 1.0f / l : 0.f;
    if (col < 4) {
#pragma unroll
        for (int dt = 0; dt < 4; ++dt) { const f32x4 o = O[dt] * inv;
            *(GAS v2u*)(oslc + (size_t)row * 512 + (4 * g + col) * 64 + 16 * dt + 4 * g4) = (v2u){pkc(o[0], o[1]), pkc(o[2], o[3])}; }
    }
}

struct WinFrags { bf16x8 kf[2][2], vf[4]; };
__device__ __forceinline__ void win_load(WinFrags& f, const bf16* kb, const bf16* vb, int kg) {
#pragma unroll
    for (int tt = 0; tt < 2; ++tt)
#pragma unroll
        for (int s = 0; s < 2; ++s) f.kf[tt][s] = *(const bf16x8*)(kb + (size_t)((2 * kg + tt) * 2 + s) * 512);
#pragma unroll
    for (int dt = 0; dt < 4; ++dt) f.vf[dt] = *(const bf16x8*)(vb + (size_t)(kg * 4 + dt) * 512);
}
__device__ __forceinline__ void win_compute_fs(const WinFrags& f, const bf16x8 (&qf)[2], f32x4 (&O)[4], float shift, float& l, int kg, int t, int g4, bool edge) {
    const f32x4 zero = {0.f, 0.f, 0.f, 0.f};
    f32x4 e[2];
#pragma unroll
    for (int tt = 0; tt < 2; ++tt) { f32x4 s = mfma16(f.kf[tt][0], qf[0], zero); s = mfma16(f.kf[tt][1], qf[1], s);
#pragma unroll
        for (int r = 0; r < 4; ++r) e[tt][r] = ex2(__builtin_fmaf(s[r], C2, -shift)); }
    if (edge) {
#pragma unroll
        for (int tt = 0; tt < 2; ++tt)
#pragma unroll
            for (int r = 0; r < 4; ++r) { const int df = t - (32 * kg + 16 * tt + 4 * g4 + r); e[tt][r] = (df >= 0 && df < 512) ? e[tt][r] : 0.f; }
    }
    l += ((e[0][0] + e[0][1]) + (e[0][2] + e[0][3])) + ((e[1][0] + e[1][1]) + (e[1][2] + e[1][3]));
    const bf16x8 pf = pack8(e[0], e[1]);
#pragma unroll
    for (int dt = 0; dt < 4; ++dt) O[dt] = mfma16(f.vf[dt], pf, O[dt]);
}
__device__ __forceinline__ void awin_item(const bf16* qrot, bf16* owin, const bf16* kw_t, const bf16* vw_t, const unsigned* kwmax, int b, int h, int qt, int lane) {
    const int col = lane & 15, g4 = lane >> 4, g = h >> 2, bg = b * 2 + g;
    const int t = 16 * qt + col; const size_t row = (size_t)b * SEQ + t;
    bf16x8 qf[2]; float qn = 0.f;
#pragma unroll
    for (int s = 0; s < 2; ++s) { qf[s] = *(const bf16x8*)(qrot + row * 512 + h * 64 + 32 * s + 8 * g4); float f[8]; unpack8(__builtin_bit_cast(v4u, qf[s]), f);
#pragma unroll
        for (int j = 0; j < 8; ++j) qn += f[j] * f[j]; }
    qn += __shfl_xor(qn, 16); qn += __shfl_xor(qn, 32);
    const float shift = C2 * sqrtf(qn * __uint_as_float(kwmax[bg])) * 1.0001f + 1e-6f;
    const bf16* kb = kw_t + (size_t)bg * SEQ * 64 + lane * 8; const bf16* vb = vw_t + (size_t)bg * SEQ * 64 + lane * 8;
    const f32x4 zero = {0.f, 0.f, 0.f, 0.f};
    f32x4 O[4] = {zero, zero, zero, zero}; float Mx = -1e30f, l = 0.f;
    const int tlo = qt - 32 > 0 ? qt - 32 : 0, kg0 = tlo >> 1, kg1 = qt >> 1;
    if (!__any(shift > 60.0f)) {
        WinFrags fa, fb;
        win_load(fa, kb, vb, kg0);
        for (int kg = kg0; kg <= kg1; kg += 2) {
            const bool has1 = kg + 1 <= kg1;
            if (has1) win_load(fb, kb, vb, kg + 1);
            win_compute_fs(fa, qf, O, shift, l, kg, t, g4, (kg <= kg0 + 1) || (kg >= kg1 - 1));
            if (has1) { if (kg + 2 <= kg1) win_load(fa, kb, vb, kg + 2);
                win_compute_fs(fb, qf, O, shift, l, kg + 1, t, g4, (kg + 1 <= kg0 + 1) || (kg + 1 >= kg1 - 1)); }
        }
    } else {
    for (int kg = kg0; kg <= kg1; ++kg) {
        bf16x8 kf[2][2], vf[4];
#pragma unroll
        for (int tt = 0; tt < 2; ++tt)
#pragma unroll
            for (int s = 0; s < 2; ++s) kf[tt][s] = *(const bf16x8*)(kb + (size_t)((2 * kg + tt) * 2 + s) * 512);
#pragma unroll
        for (int dt = 0; dt < 4; ++dt) vf[dt] = *(const bf16x8*)(vb + (size_t)(kg * 4 + dt) * 512);
        f32x4 e[2]; float mt = -1e30f;
#pragma unroll
        for (int tt = 0; tt < 2; ++tt) { f32x4 s = mfma16(kf[tt][0], qf[0], zero); s = mfma16(kf[tt][1], qf[1], s);
#pragma unroll
            for (int r = 0; r < 4; ++r) { const int df = t - (32 * kg + 16 * tt + 4 * g4 + r); const bool valid = df >= 0 && df < 512; e[tt][r] = valid ? s[r] * C2 : -1e30f; mt = fmaxf(mt, e[tt][r]); } }
        mt = fmaxf(mt, __shfl_xor(mt, 16)); mt = fmaxf(mt, __shfl_xor(mt, 32));
        const float Mn = fmaxf(Mx, mt), alpha = ex2(Mx - Mn); Mx = Mn;
        float add = 0.f;
#pragma unroll
        for (int tt = 0; tt < 2; ++tt)
#pragma unroll
            for (int r = 0; r < 4; ++r) { const float pv = (e[tt][r] > -1e29f) ? ex2(e[tt][r] - Mn) : 0.f; e[tt][r] = pv; add += pv; }
        l = l * alpha + add;
        const bf16x8 pf = pack8(e[0], e[1]);
#pragma unroll
        for (int dt = 0; dt < 4; ++dt) O[dt] = mfma16(vf[dt], pf, O[dt] * alpha);
    }
    }
    l += __shfl_xor(l, 16); l += __shfl_xor(l, 32);
    const float inv = l > 0.f ? 1.0f / l : 0.f;
#pragma unroll
    for (int dt = 0; dt < 4; ++dt) { const f32x4 o = O[dt] * inv;
        *(GAS v2u*)(owin + row * 512 + h * 64 + 16 * dt + 4 * g4) = (v2u){pkc(o[0], o[1]), pkc(o[2], o[3])}; }
}

__device__ __forceinline__ void mrg_phase(const bf16* ocmp, const bf16* oslc, const bf16* owin, const float* gates, const bf16* bgp, const bf16* cgp, const bf16* xcp, const float* convw, bf16* merged, int gw, int NGW, int lane) {
    float w0[8], w1[8], w2[8];
#pragma unroll
    for (int j = 0; j < 8; ++j) { w0[j] = convw[8 * lane + j]; w1[j] = convw[512 + 8 * lane + j]; w2[j] = convw[1024 + 8 * lane + j]; }
    for (int row = gw; row < M; row += NGW) {
        const int t = row & (SEQ - 1); const size_t o = (size_t)row * 512 + 8 * lane;
        float a[8], c[8], d[8], att[8];
        unpack8(*(const GAS v4u*)(ocmp + o), a); unpack8(*(const GAS v4u*)(oslc + o), c); unpack8(*(const GAS v4u*)(owin + o), d);
        const float* gr = gates + (size_t)row * NGATE + (lane >> 3) * 3; const float g0 = gr[0], g1 = gr[1], g2 = gr[2];
        float sa = 0.f;
#pragma unroll
        for (int j = 0; j < 8; ++j) { att[j] = g0 * a[j] + g1 * c[j] + g2 * d[j]; sa += att[j] * att[j]; }
        float bgv[8], u0[8], u1[8], u2[8], tmp[8];
        unpack8(*(const GAS v4u*)(bgp + o), bgv);
        unpack8(*(const GAS v4u*)(cgp + o), u2); unpack8(*(const GAS v4u*)(xcp + o), tmp);
#pragma unroll
        for (int j = 0; j < 8; ++j) u2[j] *= tmp[j];
        if (t >= 1) { unpack8(*(const GAS v4u*)(cgp + o - 512), u1); unpack8(*(const GAS v4u*)(xcp + o - 512), tmp);
#pragma unroll
            for (int j = 0; j < 8; ++j) u1[j] *= tmp[j]; }
        else {
#pragma unroll
            for (int j = 0; j < 8; ++j) u1[j] = 0.f; }
        if (t >= 2) { unpack8(*(const GAS v4u*)(cgp + o - 1024), u0); unpack8(*(const GAS v4u*)(xcp + o - 1024), tmp);
#pragma unroll
            for (int j = 0; j < 8; ++j) u0[j] *= tmp[j]; }
        else {
#pragma unroll
            for (int j = 0; j < 8; ++j) u0[j] = 0.f; }
        float y[8]; float sc = 0.f;
#pragma unroll
        for (int j = 0; j < 8; ++j) { y[j] = bgv[j] * (w0[j] * u0[j] + w1[j] * u1[j] + w2[j] * u2[j]); sc += y[j] * y[j]; }
        sa = wave_sum(sa); sc = wave_sum(sc);
        const float ra = 1.0f / sqrtf(sa * (1.0f / 512.0f) + EPS), rc = 1.0f / sqrtf(sc * (1.0f / 512.0f) + EPS);
        v4u wa, wc;
        wa.x = pkc(att[0] * ra, att[1] * ra); wa.y = pkc(att[2] * ra, att[3] * ra); wa.z = pkc(att[4] * ra, att[5] * ra); wa.w = pkc(att[6] * ra, att[7] * ra);
        wc.x = pkc(y[0] * rc, y[1] * rc); wc.y = pkc(y[2] * rc, y[3] * rc); wc.z = pkc(y[4] * rc, y[5] * rc); wc.w = pkc(y[6] * rc, y[7] * rc);
        *(GAS v4u*)(merged + (size_t)row * DM + 8 * lane) = wa; *(GAS v4u*)(merged + (size_t)row * DM + 512 + 8 * lane) = wc;
    }
}

struct Args { const void* in[25]; float* out; unsigned char* ws; int ph_lo, ph_hi, probe, pad; };
__device__ __forceinline__ unsigned char* opaque_ptr(unsigned char* p) { GAS unsigned char* g = (GAS unsigned char*)p; asm volatile("" : "+s"(g)); return (unsigned char*)g; }
__device__ __forceinline__ int opaque_v(int v) { asm volatile("" : "+v"(v)); return v; }
#define PH_LOCALS \
    unsigned char* ws = opaque_ptr(args.ws); \
    const int tid = opaque_v((int)threadIdx.x), lane = tid & 63, wave = __builtin_amdgcn_readfirstlane(tid >> 6); \
    const int G = gridDim.x, bx = blockIdx.x, vcu = (G % 8 == 0) ? (bx % 8) * (G / 8) + bx / 8 : bx, gw = vcu * NWAVES + wave, NGW = G * NWAVES; \
    (void)lane; (void)gw; (void)NGW; (void)ws; (void)bx;
#define INF(k) ((const float*)args.in[k])
#define WSP(T, off) ((T*)(ws + (off)))

__global__ void __launch_bounds__(NWAVES * 64, 2) mk_fwd(Args args) {
    extern __shared__ __attribute__((aligned(16))) unsigned char lds_raw[];
    LAS unsigned char* lds = (LAS unsigned char*)lds_raw;
    const int lo = args.ph_lo, hi = args.ph_hi;
    XcdBarrier bar; bar.bar = (unsigned*)(args.ws + WS_CTL) + CW_BAR; bar.x = 0; bar.st = nullptr;
    {
        const int tid0 = threadIdx.x;
        for (int u = tid0; u < (LDS_BYTES - RING_BYTES) / 4; u += NWAVES * 64) ((LAS unsigned*)(lds + RING_BYTES))[u] = 0u;
        __syncthreads();
        if (hi - lo > 1) bar = xcd_barrier_post((unsigned*)(args.ws + WS_CTL) + CW_BAR, (volatile LAS unsigned*)(lds + MISC_OFF) + 8);
    }
#define IN(k) (lo <= (k) && (k) < hi)
#define SEAM(k) do { if (IN(k) && IN((k) + 1)) xcd_barrier(bar); } while (0)

    if (EN(0) && IN(0)) {
        PH_LOCALS
        In I;
        I.x = INF(0); I.pos = (const int*)args.in[1]; I.f1_pre = INF(2); I.f1_wg = INF(3); I.f1_wu = INF(4); I.f1_wd = INF(5);
        I.f1_post = INF(6); I.mix_pre = INF(7); I.w_in = INF(8); I.pe_k = INF(9); I.w1_k = INF(10); I.w2_k = INF(11);
        I.pe_v = INF(12); I.w1_v = INF(13); I.w2_v = INF(14); I.conv_w = INF(15); I.aon = INF(16); I.con = INF(17);
        I.w_out = INF(18); I.mix_post = INF(19); I.f2_pre = INF(20); I.f2_wg = INF(21); I.f2_wu = INF(22); I.f2_wd = INF(23); I.f2_post = INF(24);
        pro_weights(I, ws, (LAS float*)(lds + wave * 16384), gw, NGW, lane);
        pro_rope(I.pos, WSP(float, WS_ROPE), vcu * NWAVES * 64 + tid, G * NWAVES * 64);
        for (int m = gw; m < M; m += NGW) pro_xrow(I.x + (size_t)m * DM, WSP(bf16, WS_XB) + (size_t)m * DM, WSP(float, WS_RSTD) + m, lane);
    }
    SEAM(0);

    for (int l = 0; l < NLAYER; ++l) {
        const int P = 1 + l * PH_PER_LAYER;
        if (hi <= P || lo >= P + PH_PER_LAYER) continue;
        if (EN(1) && IN(P + 0)) {
            PH_LOCALS
            pg8::Gemm g{WSP(bf16, WS_XB), WSP(const bf16, WS_W + (size_t)l * W_LAYER + WO_GU1), M, 2 * DFF, DM, DM, DM}; pg8::StaticOrder S; S.init(M, 2 * DFF, G, bx);
            pg8::EpiSwiGLU E{WSP(bf16, WS_BIG), DFF, WSP(float, WS_RSTD)};
            pg8::gemm_phase<pg8::EpiSwiGLU, pg8::StaticOrder, true, true>(lds, g, S, E);
        }
        SEAM(P + 0);
        if (EN(2) && IN(P + 1)) {
            PH_LOCALS
            pg8::Gemm g{WSP(bf16, WS_BIG), WSP(const bf16, WS_W + (size_t)l * W_LAYER + WO_D1), M, DM, DFF, DFF, DFF}; pg8::StaticOrder S; S.init(M, DM, G, bx);
            pg8::EpiBf16<0> E{WSP(bf16, WS_H), DM, nullptr, 0, 0, 1.f};
            pg8::gemm_phase<pg8::EpiBf16<0>, pg8::StaticOrder, true, true>(lds, g, S, E);
        }
        SEAM(P + 1);
        if (EN(3) && IN(P + 2)) { PH_LOCALS rowpass(l == 0 ? INF(0) : args.out, args.probe ? WSP(float, WS_BIG) : args.out, WSP(bf16, WS_H), INF(6) + (size_t)l * DM, 0.5f, args.probe ? WSP(bf16, WS_BIG + 128 * MiB) : WSP(bf16, WS_XB), args.probe ? WSP(float, WS_BIG + 170 * MiB) : WSP(float, WS_RSTD), gw, NGW, lane); }
        SEAM(P + 2);
        if (EN(4) && IN(P + 3)) {
            PH_LOCALS
            pg8::Gemm g{WSP(bf16, WS_XB), WSP(const bf16, WS_W + (size_t)l * W_LAYER + WO_IN), M, NIN, DM, DM, DM}; pg8::StaticOrder S; S.init(M, NIN, G, bx);
            pg8::EpiInProj E{ws};
            pg8::gemm_phase<pg8::EpiInProj, pg8::StaticOrder, true, true>(lds, g, S, E);
        }
        SEAM(P + 3);
        if (EN(5) && IN(P + 4)) {
            PH_LOCALS
            vretile(WSP(bf16, WS_VS_RM), WSP(bf16, WS_VS_T), gw, NGW, lane); vretile(WSP(bf16, WS_VW_RM), WSP(bf16, WS_VW_T), gw, NGW, lane);
            knorm_pass(WSP(bf16, WS_KS_T), WSP(unsigned, WS_CTL) + CW_KMAX + l * 16, gw, NGW, lane); knorm_pass(WSP(bf16, WS_KW_T), WSP(unsigned, WS_CTL) + CW_KMAX + l * 16 + 4, gw, NGW, lane);
            const int ks = (bx >> 5) & 3;
            pg8::Gemm g{WSP(bf16, WS_KRAW) + ks * 512, WSP(const bf16, WS_W + (size_t)l * W_LAYER + WO_W1) + ks * 512, 8192, 512, 512, 1024, 2048}; pg8::CmpOrder S{G, bx < 128 ? (bx & 31) : (1 << 20)};
            pg8::EpiHid E{WSP(float, WS_HIDP) + (size_t)ks * 8192 * 256};
            pg8::gemm_phase<pg8::EpiHid, pg8::CmpOrder, true, true>(lds, g, S, E);
        }
        SEAM(P + 4);
        if (EN(6) && IN(P + 5)) { PH_LOCALS cmp2_phase(WSP(float, WS_HIDP), WSP(float, WS_BIAS) + l * 512, INF(11) + (size_t)l * 256 * 64, INF(14) + (size_t)l * 256 * 64, WSP(bf16, WS_KC_T), WSP(bf16, WS_VC_T), WSP(unsigned, WS_CTL) + CW_KMAX + l * 16 + 8, gw, NGW, lane); }
        SEAM(P + 5);
        if (EN(7) && IN(P + 6)) {
            PH_LOCALS
            for (int p = gw; p < 2048; p += NGW) { const int bg = p >> 9, i = p & 511;
                bf16* od = args.probe ? WSP(bf16, WS_HIDP) : WSP(bf16, WS_QRAW); int* id = args.probe ? WSP(int, WS_XB) : WSP(int, WS_IDX);
                acmp_item(WSP(bf16, WS_QRAW), od, WSP(bf16, WS_KC_T), WSP(bf16, WS_VC_T), id, WSP(unsigned, WS_CTL) + CW_KMAX + l * 16 + 8, (LAS float*)(lds + wave * 16384), bg, i, lane);
                acmp_item(WSP(bf16, WS_QRAW), od, WSP(bf16, WS_KC_T), WSP(bf16, WS_VC_T), id, WSP(unsigned, WS_CTL) + CW_KMAX + l * 16 + 8, (LAS float*)(lds + wave * 16384), bg, 1023 - i, lane); }
        }
        SEAM(P + 6);
        if (EN(9) && IN(P + 8)) { PH_LOCALS
            if (G % 8 == 0) { const int per = G / 8, xg = vcu / per, pair = xg >> 1, half = xg & 1, wloc = (vcu % per) * NWAVES + wave, nw = per * NWAVES;
                for (int t = 2 * wloc + half; t < SEQ; t += 2 * nw) aslc_item(WSP(bf16, WS_QROT), WSP(bf16, WS_KS_T), WSP(bf16, WS_VS_T), WSP(int, WS_IDX), WSP(bf16, WS_OSLC), WSP(unsigned, WS_CTL) + CW_KMAX + l * 16, (pair >> 1) * SEQ + t, pair & 1, lane); }
            else { for (int it = gw; it < M * 2; it += NGW) aslc_item(WSP(bf16, WS_QROT), WSP(bf16, WS_KS_T), WSP(bf16, WS_VS_T), WSP(int, WS_IDX), WSP(bf16, WS_OSLC), WSP(unsigned, WS_CTL) + CW_KMAX + l * 16, it >> 1, it & 1, lane); }
        }
        SEAM(P + 8);
        if (EN(10) && IN(P + 9)) { PH_LOCALS for (int it = gw; it < BATCH * 8 * (SEQ / 16); it += NGW) { const int qt = it & 1023, h = (it >> 10) & 7, b = it >> 13; awin_item(WSP(bf16, WS_QROT), args.probe ? WSP(bf16, WS_HIDP) : WSP(bf16, WS_QROT), WSP(bf16, WS_KW_T), WSP(bf16, WS_VW_T), WSP(unsigned, WS_CTL) + CW_KMAX + l * 16 + 4, b, h, qt, lane); } }
        SEAM(P + 9);
        if (EN(11) && IN(P + 10)) { PH_LOCALS mrg_phase(WSP(bf16, WS_QRAW), WSP(bf16, WS_OSLC), WSP(bf16, WS_QROT), WSP(float, WS_GATES), WSP(bf16, WS_BG), WSP(bf16, WS_CG), WSP(bf16, WS_XC), INF(15) + (size_t)l * 3 * 512, WSP(bf16, WS_MERGED), gw, NGW, lane); }
        SEAM(P + 10);
        if (EN(12) && IN(P + 11)) {
            PH_LOCALS
            pg8::Gemm g{WSP(bf16, WS_MERGED), WSP(const bf16, WS_W + (size_t)l * W_LAYER + WO_O), M, DM, DM, DM, DM}; pg8::StaticOrder S; S.init(M, DM, G, bx);
            pg8::EpiBf16<0> E{WSP(bf16, WS_H), DM, nullptr, 0, 0, 1.f};
            pg8::gemm_phase<pg8::EpiBf16<0>, pg8::StaticOrder, true, true>(lds, g, S, E);
        }
        SEAM(P + 11);
        if (EN(13) && IN(P + 12)) { PH_LOCALS rowpass(args.out, args.probe ? WSP(float, WS_BIG) : args.out, WSP(bf16, WS_H), INF(19) + (size_t)l * DM, 1.0f, args.probe ? WSP(bf16, WS_BIG + 128 * MiB) : WSP(bf16, WS_XB), args.probe ? WSP(float, WS_BIG + 170 * MiB) : WSP(float, WS_RSTD), gw, NGW, lane); }
        SEAM(P + 12);
        if (EN(14) && IN(P + 13)) {
            PH_LOCALS
            pg8::Gemm g{WSP(bf16, WS_XB), WSP(const bf16, WS_W + (size_t)l * W_LAYER + WO_GU2), M, 2 * DFF, DM, DM, DM}; pg8::StaticOrder S; S.init(M, 2 * DFF, G, bx);
            pg8::EpiSwiGLU E{WSP(bf16, WS_BIG), DFF, WSP(float, WS_RSTD)};
            pg8::gemm_phase<pg8::EpiSwiGLU, pg8::StaticOrder, true, true>(lds, g, S, E);
        }
        SEAM(P + 13);
        if (EN(15) && IN(P + 14)) {
            PH_LOCALS
            pg8::Gemm g{WSP(bf16, WS_BIG), WSP(const bf16, WS_W + (size_t)l * W_LAYER + WO_D2), M, DM, DFF, DFF, DFF}; pg8::StaticOrder S; S.init(M, DM, G, bx);
            pg8::EpiBf16<0> E{WSP(bf16, WS_H), DM, nullptr, 0, 0, 1.f};
            pg8::gemm_phase<pg8::EpiBf16<0>, pg8::StaticOrder, true, true>(lds, g, S, E);
        }
        SEAM(P + 14);
        if (EN(16) && IN(P + 15)) { PH_LOCALS rowpass(args.out, args.probe ? WSP(float, WS_BIG) : args.out, WSP(bf16, WS_H), INF(24) + (size_t)l * DM, 0.5f, args.probe ? WSP(bf16, WS_BIG + 128 * MiB) : WSP(bf16, WS_XB), args.probe ? WSP(float, WS_BIG + 170 * MiB) : WSP(float, WS_RSTD), gw, NGW, lane); }
        if (l != NLAYER - 1) SEAM(P + 15);
    }
#undef IN
#undef SEAM
}

extern "C" void kernel_launch(void* const* d_in, const int* in_sizes, int n_in, void* d_out, int out_size, void* d_ws, size_t ws_size, hipStream_t stream) {
    static int grid = 0;
    if (grid == 0) {
        if (n_in != 25 || out_size != M * DM || ws_size < WS_END) { fprintf(stderr, "kernel_launch: unexpected shapes (n_in %d out %d ws %zu)\n", n_in, out_size, ws_size); grid = -1; return; }
        int dev = 0, cus = 0, per_cu = 0;
        if (hipGetDevice(&dev) != hipSuccess || hipDeviceGetAttribute(&cus, hipDeviceAttributeMultiprocessorCount, dev) != hipSuccess) { grid = -1; return; }
        if (hipFuncSetAttribute((const void*)mk_fwd, hipFuncAttributeMaxDynamicSharedMemorySize, LDS_BYTES) != hipSuccess) { fprintf(stderr, "kernel_launch: hipFuncSetAttribute failed\n"); grid = -1; return; }
        if (hipOccupancyMaxActiveBlocksPerMultiprocessor(&per_cu, (const void*)mk_fwd, NWAVES * 64, LDS_BYTES) != hipSuccess || per_cu < 1) fprintf(stderr, "kernel_launch: occupancy query reports %d\n", per_cu);
        (void)hipGetLastError();
        grid = cus;
    }
    if (grid < 0) return;
    if (hipMemsetAsync((char*)d_ws + WS_CTL, 0, CTL_ZERO_BYTES, stream) != hipSuccess) return;
    Args a{};
    for (int i = 0; i < 25; ++i) a.in[i] = d_in[i];
    a.out = (float*)d_out; a.ws = (unsigned char*)d_ws;
#if MK_ONE_LAUNCH
    a.ph_lo = 0; a.ph_hi = N_PHASES;
    hipLaunchKernelGGL(mk_fwd, dim3(grid), dim3(NWAVES * 64), LDS_BYTES, stream, a);
#else
    for (int p = 0; p < N_PHASES; ++p) { a.ph_lo = p; a.ph_hi = p + 1;
#ifdef REP_MASK
        { const int k = p == 0 ? 0 : 1 + (p - 1) % PH_PER_LAYER; if (((REP_MASK) >> k) & 1) { a.probe = 1; hipLaunchKernelGGL(mk_fwd, dim3(grid), dim3(NWAVES * 64), LDS_BYTES, stream, a); a.probe = 0; } }
#endif
        hipLaunchKernelGGL(mk_fwd, dim3(grid), dim3(NWAVES * 64), LDS_BYTES, stream, a);
    }
#endif
}
```

```cpp
#include <hip/hip_runtime.h>
#include <cstdio>
#include <cstdint>

constexpr int NWAVES = 8;
constexpr int BATCH = 2, SEQ = 16384, DM = 1024, M = BATCH * SEQ, DFF = 2816, NIN = 3072, NLAYER = 2;
constexpr int DATT = 512, NGATE = 24, NSELB = 256, KTOP = 16;
constexpr float EPS = 1e-6f;
constexpr float C2 = 0.125f * 1.4426950408889634f;
constexpr size_t MiB = 1u << 20;
constexpr size_t WS_CTL = 0, CTL_ZERO_BYTES = 1 * MiB;
constexpr size_t WS_W = 2 * MiB, W_LAYER = 43 * MiB;
constexpr size_t WO_GU1 = 0, WO_D1 = 11 * MiB, WO_IN = 11 * MiB + 5632 * 1024, WO_O = WO_IN + 6 * MiB, WO_GU2 = WO_O + 2 * MiB, WO_D2 = WO_GU2 + 11 * MiB, WO_W1 = WO_D2 + 5632 * 1024;
static_assert(WO_W1 + 2 * MiB == W_LAYER, "weight map");
constexpr size_t WS_XB = 88 * MiB;
constexpr size_t WS_H = 152 * MiB;
constexpr size_t WS_BIG = 216 * MiB;
constexpr size_t WS_QRAW = WS_BIG, WS_QROT = WS_BIG + 32 * MiB, WS_OSLC = WS_BIG + 64 * MiB, WS_BG = WS_BIG + 96 * MiB, WS_CG = WS_BIG + 128 * MiB, WS_KRAW = WS_BIG + 160 * MiB, WS_VRAW = WS_KRAW + 8 * MiB;
constexpr size_t WS_XC = 392 * MiB, WS_KS_T = 424 * MiB, WS_KW_T = 432 * MiB, WS_VS_T = 440 * MiB, WS_VW_T = 448 * MiB, WS_GATES = 456 * MiB, WS_IDX = 460 * MiB, WS_HID = 464 * MiB;
constexpr size_t WS_KC_T = 472 * MiB, WS_VC_T = WS_KC_T + 512 * 1024, WS_ROPE = 473 * MiB, WS_RSTD = 475 * MiB, WS_BIAS = 476 * MiB, WS_BIASP = WS_BIAS + 64 * 1024, WS_KSN = WS_BIAS + 256 * 1024, WS_KWN = WS_KSN + 16 * 1024, WS_KCN = WS_KWN + 16 * 1024, WS_HIDP = 477 * MiB, WS_END = 509 * MiB;
constexpr size_t WS_VS_RM = WS_H, WS_VW_RM = WS_H + 8 * MiB, WS_SCORES = WS_H;
constexpr int CW_BAR = 4096;
constexpr int CW_KMAX = 64;

constexpr int RING_BYTES = 131072, MISC_OFF = RING_BYTES + 320, LDS_BYTES = 147456;

constexpr int PH_PER_LAYER = 16, N_PHASES = 1 + NLAYER * PH_PER_LAYER;
#ifndef PH_MASK
#define PH_MASK 0x1ffff
#endif
#define EN(k) (((PH_MASK) >> (k)) & 1)
#ifndef MK_ONE_LAUNCH
#define MK_ONE_LAUNCH 1
#endif

namespace pg8 {
#define PG8_LAS __attribute__((address_space(3)))
typedef unsigned short bf16_t;
typedef short bf16x8 __attribute__((ext_vector_type(8)));
typedef float f32x4 __attribute__((ext_vector_type(4)));
typedef unsigned u32x4 __attribute__((ext_vector_type(4)));
constexpr int BM = 256, BK = 64, HALF = 128, HTB = HALF * BK * 2  , STAGE_BYTES = 8 * HTB, NXCD = 8, WGM = 8;

__host__ __device__ __forceinline__ int lds_byte(int r, int c) { const int st = (r >> 4) * 2 + (c >> 5), rr = r & 15, cc = c & 31, ob = rr * 64 + cc * 2; return st * 1024 + (ob ^ (((ob >> 9) & 1) << 5)); }
__host__ __device__ __forceinline__ void stage_rc(int b, int& R, int& C) { const int st = b / 1024, sb = b % 1024, swz = sb ^ (((sb >> 9) & 1) << 5); R = (st >> 1) * 16 + swz / 64; C = (st & 1) * 32 + (swz % 64) / 2; }
__host__ __device__ __forceinline__ int perm32(int rho) { const int n = rho >> 4, i = rho & 15; return 8 * (i >> 2) + 4 * n + (i & 3); }

struct Unit { int pm, pn; };
struct Gemm { const bf16_t* A; const bf16_t* Bt; int M, N, K, lda, ldb; };

struct StaticOrder {
    int nM, nN, nwg, G, c;
    __host__ __device__ void init(int M, int N, int G_, int c_) { nM = M / BM; nN = N / BM; nwg = nM * nN; G = G_; c = c_; }
    __host__ __device__ bool next(int i, Unit& u) const {
        const long L = (long)i * G + c; if (L >= nwg) return false;
        int wgid = (int)L; { const int q = nwg / NXCD, r = nwg % NXCD, xcd = wgid % NXCD, off = wgid / NXCD; wgid = (xcd < r ? xcd * (q + 1) : r * (q + 1) + (xcd - r) * q) + off; }
        const int nig = WGM * nN, gid = wgid / nig, fm = gid * WGM, gsz = (nM - fm) < WGM ? (nM - fm) : WGM;
        u.pm = fm + ((wgid % nig) % gsz); u.pn = (wgid % nig) / gsz; return true;
    }
    __device__ __forceinline__ void a_ready(const Unit&) const {}
    __device__ __forceinline__ void done(const Unit&) const {}
};

__device__ __forceinline__ unsigned cvt_pk_bf16(float lo, float hi) { unsigned r; asm volatile("v_cvt_pk_bf16_f32 %0, %1, %2" : "=v"(r) : "v"(lo), "v"(hi)); return r; }
typedef float f32x2 __attribute__((ext_vector_type(2)));
__device__ __forceinline__ f32x2 gelu_pk(f32x2 v) {
    const f32x2 av = __builtin_elementwise_abs(v), d = av * 0.2316418882f + 1.0f;
    f32x2 t; t.x = __builtin_amdgcn_rcpf(d.x); t.y = __builtin_amdgcn_rcpf(d.y);
    f32x2 q = t * 0.5307027145f + (-0.7265760135f); q = q * t + 0.7107068705f; q = q * t + (-0.142248368f); q = q * t + 0.127414796f; q = q * t;
    const f32x2 s = (v * v) * (-0.72134752044f);
    f32x2 e; e.x = __builtin_amdgcn_exp2f(s.x); e.y = __builtin_amdgcn_exp2f(s.y);
    const f32x2 m = v * (q * e), r = v - m;
    f32x2 o; o.x = v.x < 0.f ? m.x : r.x; o.y = v.y < 0.f ? m.y : r.y; return o;
}

template <int ACT  > struct EpiBf16 {
    static constexpr bool PERM = true, AFTER_DRAIN = false; static_assert(ACT == 0 || ACT == 1, "EpiBf16: ACT is 0 (none) or 1 (gelu_pk)");
    bf16_t* O; int ldc; const float* bias; int split_cols; size_t split_stride; float scale0;
    __device__ __forceinline__ void operator()(const f32x4 (&acc)[2][2][4][2], const Unit& u, int wr, int wc, int fr, int fq) const {
        const int row0 = u.pm * BM + wr * 64 + fr; int colt = u.pn * BM; bf16_t* base = O;
        float sc = 1.f; if (split_cols) { const int t = colt / split_cols; base += (size_t)t * split_stride; colt -= t * split_cols; if (t == 0) sc = scale0; }
        const int col0 = colt + wc * 32 + 8 * fq, bcol0 = u.pn * BM + wc * 32 + 8 * fq;
        f32x4 bv[2][2];
#pragma unroll
        for (int bj = 0; bj < 2; ++bj)
#pragma unroll
            for (int n = 0; n < 2; ++n) bv[bj][n] = bias ? *(const f32x4*)(bias + bcol0 + bj * HALF + 4 * n) : (f32x4){0.f, 0.f, 0.f, 0.f};
#pragma unroll
        for (int ai = 0; ai < 2; ++ai)
#pragma unroll
            for (int m = 0; m < 4; ++m) { bf16_t* rowp = base + (size_t)(row0 + ai * HALF + m * 16) * ldc + col0;
#pragma unroll
                for (int bj = 0; bj < 2; ++bj) { f32x4 v0 = acc[ai][bj][m][0] + bv[bj][0], v1 = acc[ai][bj][m][1] + bv[bj][1];
                    if (ACT == 1) { f32x2 a = gelu_pk((f32x2){v0[0], v0[1]}), b = gelu_pk((f32x2){v0[2], v0[3]}), c = gelu_pk((f32x2){v1[0], v1[1]}), d = gelu_pk((f32x2){v1[2], v1[3]});
                        v0 = (f32x4){a.x, a.y, b.x, b.y}; v1 = (f32x4){c.x, c.y, d.x, d.y}; }
                    v0 = v0 * sc; v1 = v1 * sc; u32x4 w; w.x = cvt_pk_bf16(v0[0], v0[1]); w.y = cvt_pk_bf16(v0[2], v0[3]); w.z = cvt_pk_bf16(v1[0], v1[1]); w.w = cvt_pk_bf16(v1[2], v1[3]);
                    *(u32x4*)(rowp + bj * HALF) = w; } }
    }
};

constexpr int SEQ_ = SEQ;
__device__ __forceinline__ unsigned pk2c(float lo, float hi) { typedef float f2_t __attribute__((ext_vector_type(2))); typedef __bf16 b2_t __attribute__((ext_vector_type(2))); f2_t v = {lo, hi}; b2_t b = __builtin_convertvector(v, b2_t); return __builtin_bit_cast(unsigned, b); }
__device__ __forceinline__ void store8(bf16_t* dst, const f32x4& v0, const f32x4& v1) { u32x4 w; w.x = pk2c(v0[0], v0[1]); w.y = pk2c(v0[2], v0[3]); w.z = pk2c(v1[0], v1[1]); w.w = pk2c(v1[2], v1[3]); *(u32x4*)dst = w; }
__device__ __forceinline__ float silu_f(float x) { return x * __builtin_amdgcn_rcpf(1.0f + __builtin_amdgcn_exp2f(-1.4426950408889634f * x)); }
__device__ __forceinline__ float sigmoid_f(float x) { return __builtin_amdgcn_rcpf(1.0f + __builtin_amdgcn_exp2f(-1.4426950408889634f * x)); }

struct EpiSwiGLU {
    static constexpr bool PERM = true, AFTER_DRAIN = false;
    bf16_t* O; int ldc; const float* rstd;
    __device__ __forceinline__ void operator()(const f32x4 (&acc)[2][2][4][2], const Unit& u, int wr, int wc, int fr, int fq) const {
        const int row0 = u.pm * BM + wr * 64 + fr, col0 = u.pn * 128 + wc * 32 + 8 * fq;
#pragma unroll
        for (int ai = 0; ai < 2; ++ai)
#pragma unroll
            for (int m = 0; m < 4; ++m) { const int r = row0 + ai * HALF + m * 16; const float rs = rstd[r];
                const f32x4 g0 = acc[ai][0][m][0] * rs, g1 = acc[ai][0][m][1] * rs, u0 = acc[ai][1][m][0] * rs, u1 = acc[ai][1][m][1] * rs;
                f32x4 o0, o1;
#pragma unroll
                for (int j = 0; j < 4; ++j) { o0[j] = silu_f(g0[j]) * u0[j]; o1[j] = silu_f(g1[j]) * u1[j]; }
                store8(O + (size_t)r * ldc + col0, o0, o1); }
    }
};

struct EpiHid {
    static constexpr bool PERM = false, AFTER_DRAIN = false;
    float* C;
    __device__ __forceinline__ void operator()(const f32x4 (&acc)[2][2][4][2], const Unit& u, int wr, int wc, int fr, int fq) const {
        const int row0 = u.pm * BM + wr * 64 + fr, col0 = wc * 32 + 4 * fq;
#pragma unroll
        for (int ai = 0; ai < 2; ++ai)
#pragma unroll
            for (int m = 0; m < 4; ++m) { float* rowp = C + (size_t)(row0 + ai * HALF + m * 16) * 256 + col0;
#pragma unroll
                for (int bj = 0; bj < 2; ++bj)
#pragma unroll
                    for (int n = 0; n < 2; ++n) *(f32x4*)(rowp + bj * HALF + n * 16) = acc[ai][bj][m][n]; }
    }
};

__device__ __forceinline__ void rope8(f32x4& v0, f32x4& v1, const float* rope_row, int wc, int fq) {
    if ((wc & 1) == 0) {
        f32x4 o0, o1;
#pragma unroll
        for (int j = 0; j < 4; ++j) { o0[j] = __shfl_xor(v0[j], 16); o1[j] = __shfl_xor(v1[j], 16); }
        if (fq < 2) {
            const f32x4 c0 = *(const f32x4*)(rope_row), c1 = *(const f32x4*)(rope_row + 4), s0 = *(const f32x4*)(rope_row + 8), s1 = *(const f32x4*)(rope_row + 12);
            if (fq == 0) { v0 = v0 * c0 - o0 * s0; v1 = v1 * c1 - o1 * s1; }
            else         { v0 = v0 * c0 + o0 * s0; v1 = v1 * c1 + o1 * s1; }
        }
    }
}

struct EpiInProj {
    static constexpr bool PERM = true, AFTER_DRAIN = false;
    unsigned char* ws;
    __device__ __forceinline__ void operator()(const f32x4 (&acc)[2][2][4][2], const Unit& u, int wr, int wc, int fr, int fq) const {
        const float* rstd = (const float*)(ws + WS_RSTD); const float* rope = (const float*)(ws + WS_ROPE);
        bf16_t* qraw = (bf16_t*)(ws + WS_QRAW); bf16_t* qrot = (bf16_t*)(ws + WS_QROT); bf16_t* kraw = (bf16_t*)(ws + WS_KRAW); bf16_t* vraw = (bf16_t*)(ws + WS_VRAW);
        bf16_t* ks_t = (bf16_t*)(ws + WS_KS_T); bf16_t* vs_rm = (bf16_t*)(ws + WS_VS_RM); bf16_t* kw_t = (bf16_t*)(ws + WS_KW_T); bf16_t* vw_rm = (bf16_t*)(ws + WS_VW_RM);
        bf16_t* bg = (bf16_t*)(ws + WS_BG); bf16_t* cg = (bf16_t*)(ws + WS_CG); bf16_t* xc = (bf16_t*)(ws + WS_XC); float* gates = (float*)(ws + WS_GATES);
        const int pn = u.pn, row0 = u.pm * BM + wr * 64 + fr;
#pragma unroll
        for (int ai = 0; ai < 2; ++ai)
#pragma unroll
            for (int m = 0; m < 4; ++m) {
                const int r = row0 + ai * HALF + m * 16; const float rs = rstd[r];
                const int b = r >> 14, s = r & (SEQ_ - 1);
                const float* rrow = rope + (size_t)r * 16;
#pragma unroll
                for (int bj = 0; bj < 2; ++bj) {
                    f32x4 v0 = acc[ai][bj][m][0] * rs, v1 = acc[ai][bj][m][1] * rs;
                    const int ct = bj * HALF + wc * 32 + 8 * fq;
                    const int c = wc * 32 + 8 * fq, g = c >> 6, d0 = c & 63;
                    if (pn <= 1) {
                        const size_t o = (size_t)r * 512 + pn * 256 + ct;
                        store8(qraw + o, v0, v1);
                        rope8(v0, v1, rrow, wc, fq);
                        store8(qrot + o, v0, v1);
                    } else if (pn == 2) {
                        bf16_t* dst = (bj == 0 ? kraw : vraw) + ((size_t)((b * 2 + g) * SEQ_ + s)) * 64 + d0;
                        store8(dst, v0, v1);
                    } else if (pn <= 4) {
                        if (bj == 0) {
                            rope8(v0, v1, rrow, wc, fq);
                            bf16_t* base = (pn == 3 ? ks_t : kw_t) + (size_t)(b * 2 + g) * SEQ_ * 64;
                            const int off = (((s >> 4) * 2 + (d0 >> 5)) * 64 + ((d0 & 31) >> 3) * 16 + (s & 15)) * 8;
                            store8(base + off, v0, v1);
                        } else {
                            bf16_t* dst = (pn == 3 ? vs_rm : vw_rm) + ((size_t)((b * 2 + g) * SEQ_ + s)) * 64 + d0;
                            store8(dst, v0, v1);
                        }
                    } else if (pn <= 10) {
                        bf16_t* base = pn <= 6 ? bg : (pn <= 8 ? cg : xc);
                        store8(base + (size_t)r * 512 + ((pn - 5) & 1) * 256 + ct, v0, v1);
                    } else {
                        if (bj == 0 && wc == 0 && fq < 3) {
                            f32x4 a, bb;
#pragma unroll
                            for (int j = 0; j < 4; ++j) { a[j] = sigmoid_f(v0[j]); bb[j] = sigmoid_f(v1[j]); }
                            float* dst = gates + (size_t)r * 24 + 8 * fq;
                            *(f32x4*)dst = a; *(f32x4*)(dst + 4) = bb;
                        }
                    }
                }
            }
    }
};

struct CmpOrder {
    int G, c;
    __device__ __forceinline__ bool next(int i, Unit& u) const { const int L = i * G + c; if (L >= 32) return false; u.pm = L; u.pn = L >> 4; return true; }
    __device__ __forceinline__ void a_ready(const Unit&) const {}
    __device__ __forceinline__ void done(const Unit&) const {}
};
template <class Epi, class Sched, bool ALIGN_EPI = false, bool SP2 = false>
__device__ __forceinline__ void gemm_phase(PG8_LAS unsigned char* lds, const Gemm g, const Sched& S, const Epi& E) {
    int tid_ = threadIdx.x; asm volatile("" : "+v"(tid_));
    const int tid = tid_, wid = __builtin_amdgcn_readfirstlane(tid >> 6), lane = tid & 63, wr = wid >> 2, wc = wid & 3, fr = lane & 15, fq = lane >> 4;
    const int K = g.K, nt = K / BK;
    unsigned voffA[2], voffB[2];
#pragma unroll
    for (int i = 0; i < 2; ++i) { int R, C; stage_rc(tid * 16 + i * 8192, R, C); const int Rb = Epi::PERM ? ((R & ~31) + perm32(R & 31)) : R;
        voffA[i] = (unsigned)(R * g.lda + C) * 2u; voffB[i] = (unsigned)(Rb * g.ldb + C) * 2u; }
    const size_t kstep = (size_t)(BK * 2);
    const size_t hstepA = (size_t)HALF * g.lda * 2, hstepB = (size_t)HALF * g.ldb * 2;
    const size_t tstepA = 2 * hstepA, tstepB = 2 * hstepB;
    const unsigned ldsw = (unsigned)wid * 1024u;
    const int aoff = lds_byte(wr * 64 + fr, fq * 8), boff = lds_byte(wc * 32 + fr, fq * 8);
#define PG8_SA(b, h) (((b) * 2 + (h)) * HTB)
#define PG8_SB(b, h) ((4 + (b) * 2 + (h)) * HTB)
#define PG8_STAGE(bufoff, gbase, voff) do { _Pragma("unroll") for (int _i = 0; _i < 2; ++_i) \
        __builtin_amdgcn_global_load_lds((const unsigned*)((const char*)(gbase) + (voff)[_i]), (PG8_LAS unsigned*)(lds + (bufoff) + ldsw + _i * 8192), 16, 0, 0); } while (0)
#define PG8_LDA(dst, b, h) do { _Pragma("unroll") for (int m = 0; m < 4; ++m) _Pragma("unroll") for (int k = 0; k < 2; ++k) dst[m][k] = *(const PG8_LAS bf16x8*)(lds + PG8_SA(b, h) + aoff + m * 2048 + k * 1024); } while (0)
#define PG8_LDB(dst, b, h) do { _Pragma("unroll") for (int n = 0; n < 2; ++n) _Pragma("unroll") for (int k = 0; k < 2; ++k) dst[n][k] = *(const PG8_LAS bf16x8*)(lds + PG8_SB(b, h) + boff + n * 2048 + k * 1024); } while (0)
#define PG8_MMA(ai, bj, At, Bt) do { __builtin_amdgcn_s_setprio(1); _Pragma("unroll") for (int m = 0; m < 4; ++m) _Pragma("unroll") for (int n = 0; n < 2; ++n) _Pragma("unroll") for (int k = 0; k < 2; ++k) \
        acc[ai][bj][m][n] = __builtin_amdgcn_mfma_f32_16x16x32_bf16(Bt[n][k], At[m][k], acc[ai][bj][m][n], 0, 0, 0); __builtin_amdgcn_s_setprio(0); } while (0)
#define PG8_WAIT_V(n) asm volatile("s_waitcnt vmcnt(" #n ")" ::: "memory")
#define PG8_WAIT_L(n) asm volatile("s_waitcnt lgkmcnt(" #n ")" ::: "memory")
#define PG8_BAR __builtin_amdgcn_s_barrier()
#define PG8_SCHED __builtin_amdgcn_sched_barrier(0)
    Unit cur, nxt; int ui = 0;
    if (!S.next(0, cur)) return;
    f32x4 acc[2][2][4][2];
#pragma unroll
    for (int a = 0; a < 2; ++a)
#pragma unroll
        for (int b = 0; b < 2; ++b)
#pragma unroll
            for (int m = 0; m < 4; ++m)
#pragma unroll
                for (int n = 0; n < 2; ++n) acc[a][b][m][n] = (f32x4){0.f, 0.f, 0.f, 0.f};
    bf16x8 At[4][2], B0[2][2], B1[2][2];
    const char* cA = (const char*)g.A + (size_t)cur.pm * tstepA; const char* cB = (const char*)g.Bt + (size_t)cur.pn * tstepB;
    S.a_ready(cur);
    if constexpr (SP2) {
        PG8_STAGE(PG8_SB(0, 0), cB, voffB); PG8_STAGE(PG8_SB(0, 1), cB + hstepB, voffB); PG8_STAGE(PG8_SA(0, 0), cA, voffA); PG8_STAGE(PG8_SA(0, 1), cA + hstepA, voffA);
        if (wr == 1) PG8_BAR;
        PG8_WAIT_V(2); PG8_BAR;
        PG8_STAGE(PG8_SB(1, 0), cB + kstep, voffB); PG8_STAGE(PG8_SA(1, 0), cA + kstep, voffA); PG8_STAGE(PG8_SB(1, 1), cB + hstepB + kstep, voffB);
        PG8_WAIT_V(6); PG8_BAR;
    } else {
        PG8_STAGE(PG8_SB(0, 0), cB, voffB); PG8_STAGE(PG8_SA(0, 0), cA, voffA); PG8_STAGE(PG8_SB(0, 1), cB + hstepB, voffB); PG8_STAGE(PG8_SA(0, 1), cA + hstepA, voffA);
        if (wr == 1) PG8_BAR;
        PG8_WAIT_V(4); PG8_BAR;
        PG8_STAGE(PG8_SB(1, 0), cB + kstep, voffB); PG8_STAGE(PG8_SA(1, 0), cA + kstep, voffA); PG8_STAGE(PG8_SB(1, 1), cB + hstepB + kstep, voffB);
        PG8_WAIT_V(6); PG8_BAR;
    }
    for (;;) {
        const bool has_next = S.next(ui + 1, nxt);
        const char* nA = has_next ? (const char*)g.A + (size_t)nxt.pm * tstepA : cA; const char* nB = has_next ? (const char*)g.Bt + (size_t)nxt.pn * tstepB : cB;
        for (int t = 0; t < nt; t += 2) {
            const bool last = (t == nt - 2);
            const char* a1 = cA + (size_t)(t + 1) * kstep;
            const char* a2 = last ? nA : cA + (size_t)(t + 2) * kstep; const char* b2 = last ? nB : cB + (size_t)(t + 2) * kstep;
            const char* a3 = a2 + kstep; const char* b3 = b2 + kstep;
            if (last && has_next) S.a_ready(nxt);
            if constexpr (SP2) {
            PG8_LDB(B0, 0, 0); PG8_LDB(B1, 0, 1); PG8_SCHED; PG8_LDA(At, 0, 0); PG8_STAGE(PG8_SA(1, 1), a1 + hstepA, voffA);
            PG8_WAIT_V(8); PG8_WAIT_L(0); PG8_BAR; PG8_MMA(0, 0, At, B0); PG8_MMA(0, 1, At, B1); PG8_BAR; PG8_SCHED;
            PG8_LDA(At, 0, 1); PG8_STAGE(PG8_SB(0, 0), b2, voffB); PG8_STAGE(PG8_SB(0, 1), b2 + hstepB, voffB); PG8_STAGE(PG8_SA(0, 0), a2, voffA);
            PG8_WAIT_V(8); PG8_WAIT_L(0); PG8_BAR; PG8_MMA(1, 0, At, B0); PG8_MMA(1, 1, At, B1); PG8_BAR; PG8_SCHED;
            PG8_LDB(B0, 1, 0); PG8_LDB(B1, 1, 1); PG8_SCHED; PG8_LDA(At, 1, 0); PG8_STAGE(PG8_SA(0, 1), a2 + hstepA, voffA);
            PG8_WAIT_V(8); PG8_WAIT_L(0); PG8_BAR; PG8_MMA(0, 0, At, B0); PG8_MMA(0, 1, At, B1); PG8_BAR; PG8_SCHED;
            PG8_LDA(At, 1, 1); PG8_STAGE(PG8_SB(1, 0), b3, voffB); PG8_STAGE(PG8_SB(1, 1), b3 + hstepB, voffB); PG8_STAGE(PG8_SA(1, 0), a3, voffA);
            PG8_WAIT_V(8); PG8_WAIT_L(0); PG8_BAR; PG8_MMA(1, 0, At, B0); PG8_MMA(1, 1, At, B1); PG8_BAR; PG8_SCHED;
            } else {
            PG8_LDB(B0, 0, 0); PG8_SCHED; PG8_LDA(At, 0, 0); PG8_STAGE(PG8_SA(1, 1), a1 + hstepA, voffA);
            PG8_WAIT_L(8); PG8_BAR; PG8_WAIT_L(0); PG8_MMA(0, 0, At, B0); PG8_BAR; PG8_SCHED;
            PG8_LDB(B1, 0, 1); PG8_STAGE(PG8_SB(0, 0), b2, voffB);
            PG8_BAR; PG8_WAIT_L(0); PG8_MMA(0, 1, At, B1); PG8_BAR;
            PG8_LDA(At, 0, 1); PG8_STAGE(PG8_SA(0, 0), a2, voffA);
            PG8_BAR; PG8_WAIT_L(0); PG8_MMA(1, 0, At, B0); PG8_BAR; PG8_SCHED;
            PG8_STAGE(PG8_SB(0, 1), b2 + hstepB, voffB);
            PG8_WAIT_V(6); PG8_BAR; PG8_MMA(1, 1, At, B1); PG8_BAR;
            PG8_LDB(B0, 1, 0); PG8_SCHED; PG8_LDA(At, 1, 0); PG8_STAGE(PG8_SA(0, 1), a2 + hstepA, voffA);
            PG8_WAIT_L(8); PG8_BAR; PG8_WAIT_L(0); PG8_MMA(0, 0, At, B0); PG8_BAR; PG8_SCHED;
            PG8_LDB(B1, 1, 1); PG8_STAGE(PG8_SB(1, 0), b3, voffB);
            PG8_BAR; PG8_WAIT_L(0); PG8_MMA(0, 1, At, B1); PG8_BAR;
            PG8_LDA(At, 1, 1); PG8_STAGE(PG8_SA(1, 0), a3, voffA);
            PG8_BAR; PG8_WAIT_L(0); PG8_MMA(1, 0, At, B0); PG8_BAR; PG8_SCHED;
            PG8_STAGE(PG8_SB(1, 1), b3 + hstepB, voffB);
            PG8_WAIT_V(6); PG8_BAR; PG8_MMA(1, 1, At, B1); PG8_BAR;
            }
        }
        if constexpr (ALIGN_EPI) { if (wr == 0) PG8_BAR; }
        if constexpr (!Epi::AFTER_DRAIN) { E(acc, cur, wr, wc, fr, fq); S.done(cur); }
        if (!has_next) break;
#pragma unroll
        for (int a = 0; a < 2; ++a)
#pragma unroll
            for (int b = 0; b < 2; ++b)
#pragma unroll
                for (int m = 0; m < 4; ++m)
#pragma unroll
                    for (int n = 0; n < 2; ++n) acc[a][b][m][n] = (f32x4){0.f, 0.f, 0.f, 0.f};
        cur = nxt; cA = nA; cB = nB; ++ui;
        if constexpr (ALIGN_EPI) { if (wr == 1) PG8_BAR; }
    }
    PG8_WAIT_V(0);
    if constexpr (!ALIGN_EPI) { if (wr == 0) PG8_BAR; }
    PG8_BAR;
    if constexpr (Epi::AFTER_DRAIN) { E.fused(acc, cur, wr, wc, fr, fq, lds, wid, lane); S.done(cur); }
#undef PG8_SA
#undef PG8_SB
#undef PG8_STAGE
#undef PG8_LDA
#undef PG8_LDB
#undef PG8_MMA
#undef PG8_WAIT_V
#undef PG8_WAIT_L
#undef PG8_BAR
#undef PG8_SCHED
}
}
#define GAS __attribute__((address_space(1)))
#define LAS __attribute__((address_space(3)))
typedef unsigned short bf16;
typedef unsigned v4u __attribute__((ext_vector_type(4)));
typedef float f32x4 __attribute__((ext_vector_type(4)));
typedef short bf16x8 __attribute__((ext_vector_type(8)));
typedef GAS unsigned gu32;
typedef GAS unsigned long long gu64;
#define RLX_AGENT __ATOMIC_RELAXED, __HIP_MEMORY_SCOPE_AGENT
#define LDS_WAIT() asm volatile("s_waitcnt lgkmcnt(0)" ::: "memory")
#define VM_WAIT() asm volatile("s_waitcnt vmcnt(0)" ::: "memory")
__device__ __forceinline__ unsigned long long rt() { return __builtin_amdgcn_s_memrealtime(); }
__device__ __forceinline__ unsigned f2bf(float f) { unsigned u = __builtin_bit_cast(unsigned, f); return (u + 0x7fffu + ((u >> 16) & 1u)) >> 16; }
__device__ __forceinline__ unsigned pk2(float lo, float hi) { return f2bf(lo) | (f2bf(hi) << 16); }

#define XB_TMO      128
#define XB_XCNT(j)  (256  + 64 * (j))
#define XB_XSUB(j)  (1280 + 64 * (j))
#define XB_XGEN(j)  (2304 + 64 * (j))
#define XB_TOP      3328
#define XB_TOPGEN   3392
#define XCD_BAR_WORDS 3456
#define XB_SPIN_CAP (1u << 18)

__device__ __forceinline__ unsigned xb_ld(unsigned* p)              { return __hip_atomic_load(p, __ATOMIC_RELAXED, __HIP_MEMORY_SCOPE_AGENT); }
__device__ __forceinline__ unsigned xb_add(unsigned* p, unsigned v) { return __hip_atomic_fetch_add(p, v, __ATOMIC_RELAXED, __HIP_MEMORY_SCOPE_AGENT); }
__device__ __forceinline__ unsigned xb_xcc_id() { return (unsigned)__builtin_amdgcn_s_getreg((3 << 11) | 20) & 0xFu; }
#define XB_SPIN(cond, bar) do { unsigned _sp = 0; while (cond) { __builtin_amdgcn_s_sleep(1); \
    if ((++_sp & 255u) == 0u) { if (xb_ld(&(bar)[XB_TMO])) break; if (_sp > XB_SPIN_CAP) { atomicAdd(&(bar)[XB_TMO], 1u); break; } } } } while (0)

struct XcdBarrier {
    unsigned* bar; unsigned x;
    volatile LAS unsigned* st;
};

__device__ __forceinline__ XcdBarrier xcd_barrier_post(unsigned* bar, volatile LAS unsigned* st) {
    XcdBarrier b; b.bar = bar; b.x = xb_xcc_id(); b.st = st;
    if (threadIdx.x == 0) (void)xb_add(&bar[XB_XCNT(b.x)], 1u);
    return b;
}
__device__ __forceinline__ void xcd_barrier_complete(unsigned* bar, unsigned x, unsigned& nloc, unsigned& nx) {
    const unsigned G = gridDim.x * gridDim.y * gridDim.z;
    unsigned sum, cnt, mine, sp = 0u;
    for (;;) {
        sum = 0u; cnt = 0u; mine = 0u;
#pragma unroll
        for (unsigned j = 0; j < 16; ++j) { const unsigned c = xb_ld(&bar[XB_XCNT(j)]); sum += c; cnt += (c > 0u) ? 1u : 0u; mine = (j == x) ? c : mine; }
        if (sum == G) break;
        __builtin_amdgcn_s_sleep(1);
        if ((++sp & 255u) == 0u) { if (xb_ld(&bar[XB_TMO])) break; if (sp > XB_SPIN_CAP) { atomicAdd(&bar[XB_TMO], 1u); break; } }
    }
    nloc = mine > 0u ? mine : 1u; nx = cnt > 0u ? cnt : 1u;
}

__device__ __forceinline__ void xcd_barrier(const XcdBarrier& b) {
    asm volatile("s_waitcnt vmcnt(0)" ::: "memory");
    __syncthreads();
    if (threadIdx.x == 0) {
        unsigned* bar = b.bar;
        __builtin_amdgcn_s_waitcnt(0);
        unsigned nloc = b.st[0], nx = b.st[1];
        if (nloc == 0u) { xcd_barrier_complete(bar, b.x, nloc, nx); b.st[0] = nloc; b.st[1] = nx; }
        const unsigned old = xb_add(&bar[XB_XSUB(b.x)], 1u);
        const unsigned gen = old / nloc;
        if (old + 1u == (gen + 1u) * nloc) {
            __builtin_amdgcn_fence(__ATOMIC_RELEASE, "agent");
            asm volatile("s_waitcnt vmcnt(0)" ::: "memory");
            const unsigned og = xb_add(&bar[XB_TOP], 1u);
            const unsigned tg = og / nx;
            if (og + 1u == (tg + 1u) * nx) xb_add(&bar[XB_TOPGEN], 1u);
            else XB_SPIN(xb_ld(&bar[XB_TOPGEN]) == tg, bar);
            __builtin_amdgcn_fence(__ATOMIC_ACQUIRE, "agent");
            xb_add(&bar[XB_XGEN(b.x)], 1u);
            asm volatile("s_waitcnt vmcnt(0)" ::: "memory");
        } else {
            XB_SPIN(xb_ld(&bar[XB_XGEN(b.x)]) == gen, bar);
            __builtin_amdgcn_fence(__ATOMIC_ACQUIRE, "agent");
            asm volatile("s_waitcnt vmcnt(0)" ::: "memory");
        }
    }
    __syncthreads();
}

typedef float f32x2 __attribute__((ext_vector_type(2)));
typedef unsigned v2u __attribute__((ext_vector_type(2)));
__device__ __forceinline__ unsigned pkc(float lo, float hi) { return pg8::pk2c(lo, hi); }
__device__ __forceinline__ float bf_lo(unsigned w) { return __uint_as_float(w << 16); }
__device__ __forceinline__ float bf_hi(unsigned w) { return __uint_as_float(w & 0xffff0000u); }
__device__ __forceinline__ float wave_sum(float v) {
#pragma unroll
    for (int o = 1; o < 64; o <<= 1) v += __shfl_xor(v, o);
    return v;
}
__device__ __forceinline__ f32x4 mfma16(bf16x8 a, bf16x8 b, f32x4 c) { return __builtin_amdgcn_mfma_f32_16x16x32_bf16(a, b, c, 0, 0, 0); }
__device__ __forceinline__ float ex2(float x) { return __builtin_amdgcn_exp2f(x); }
__device__ __forceinline__ bf16x8 pack8(const f32x4& a, const f32x4& b) { v4u w; w.x = pkc(a[0], a[1]); w.y = pkc(a[2], a[3]); w.z = pkc(b[0], b[1]); w.w = pkc(b[2], b[3]); return __builtin_bit_cast(bf16x8, w); }

__device__ __forceinline__ void tr_item(const float* W, int ldw, int col0, int nvalid, const float* gain, bf16* WT, int ldt, int drow0, LAS float* scr, int kb, int n0, int lane) {
    const int k0 = 64 * kb;
#pragma unroll
    for (int i = 0; i < 32; ++i) { const int kk = 2 * i + (lane >> 5), n = n0 + (lane & 31);
        float v = (n < nvalid) ? W[(size_t)(k0 + kk) * ldw + col0 + n] : 0.f; if (gain) v *= gain[k0 + kk];
        scr[kk * 33 + (lane & 31)] = v; }
    LDS_WAIT(); asm volatile("" ::: "memory");
    const int c = lane & 7;
#pragma unroll
    for (int j = 0; j < 4; ++j) { const int n = (lane >> 3) + 8 * j; const LAS float* s = scr + (8 * c) * 33 + n;
        v4u o; o.x = pkc(s[0 * 33], s[1 * 33]); o.y = pkc(s[2 * 33], s[3 * 33]); o.z = pkc(s[4 * 33], s[5 * 33]); o.w = pkc(s[6 * 33], s[7 * 33]);
        *(GAS v4u*)(WT + (size_t)(drow0 + n) * ldt + k0 + 8 * c) = o; }
    LDS_WAIT(); asm volatile("" ::: "memory");
}

struct In {
    const float *x; const int* pos;
    const float *f1_pre, *f1_wg, *f1_wu, *f1_wd, *f1_post, *mix_pre, *w_in, *pe_k, *w1_k, *w2_k, *pe_v, *w1_v, *w2_v, *conv_w, *aon, *con, *w_out, *mix_post, *f2_pre, *f2_wg, *f2_wu, *f2_wd, *f2_post;
};

__device__ __forceinline__ void pro_weights(const In& I, unsigned char* ws, LAS float* scr, int gw, int NGW, int lane) {
    constexpr int I_GU = 16 * 88, I_D = 44 * 32, I_INM = 16 * 40, I_ING = 16, I_INC = 16 * 16, I_O = 16 * 32, I_W1 = 32 * 8;
    constexpr int PER_LAYER = 4 * I_GU + 2 * I_D + I_INM + I_ING + 3 * I_INC + I_O + 2 * I_W1;
    for (int it = gw; it < NLAYER * PER_LAYER; it += NGW) {
        const int l = it / PER_LAYER; int r = it % PER_LAYER;
        unsigned char* wl = ws + WS_W + (size_t)l * W_LAYER;
        if (r < I_GU) { const int kb = r / 88, n0 = 32 * (r % 88); tr_item(I.f1_wg + (size_t)l * DM * DFF, DFF, 0, DFF, I.f1_pre + (size_t)l * DM, (bf16*)(wl + WO_GU1), DM, (n0 >> 7) * 256 + (n0 & 127), scr, kb, n0, lane); continue; } r -= I_GU;
        if (r < I_GU) { const int kb = r / 88, n0 = 32 * (r % 88); tr_item(I.f1_wu + (size_t)l * DM * DFF, DFF, 0, DFF, I.f1_pre + (size_t)l * DM, (bf16*)(wl + WO_GU1), DM, (n0 >> 7) * 256 + (n0 & 127) + 128, scr, kb, n0, lane); continue; } r -= I_GU;
        if (r < I_D) { const int kb = r / 32, n0 = 32 * (r % 32); tr_item(I.f1_wd + (size_t)l * DFF * DM, DM, 0, DM, nullptr, (bf16*)(wl + WO_D1), DFF, n0, scr, kb, n0, lane); continue; } r -= I_D;
        if (r < I_GU) { const int kb = r / 88, n0 = 32 * (r % 88); tr_item(I.f2_wg + (size_t)l * DM * DFF, DFF, 0, DFF, I.f2_pre + (size_t)l * DM, (bf16*)(wl + WO_GU2), DM, (n0 >> 7) * 256 + (n0 & 127), scr, kb, n0, lane); continue; } r -= I_GU;
        if (r < I_GU) { const int kb = r / 88, n0 = 32 * (r % 88); tr_item(I.f2_wu + (size_t)l * DM * DFF, DFF, 0, DFF, I.f2_pre + (size_t)l * DM, (bf16*)(wl + WO_GU2), DM, (n0 >> 7) * 256 + (n0 & 127) + 128, scr, kb, n0, lane); continue; } r -= I_GU;
        if (r < I_D) { const int kb = r / 32, n0 = 32 * (r % 32); tr_item(I.f2_wd + (size_t)l * DFF * DM, DM, 0, DM, nullptr, (bf16*)(wl + WO_D2), DFF, n0, scr, kb, n0, lane); continue; } r -= I_D;
        const float* Win = I.w_in + (size_t)l * DM * 2840; const float* mpre = I.mix_pre + (size_t)l * DM; bf16* WI = (bf16*)(wl + WO_IN);
        if (r < I_INM) { const int kb = r / 40, n0 = 32 * (r % 40); tr_item(Win, 2840, 0, 1280, mpre, WI, DM, n0, scr, kb, n0, lane); continue; } r -= I_INM;
        if (r < I_ING) { tr_item(Win, 2840, 1280, 24, mpre, WI, DM, 2816, scr, r, 0, lane); continue; } r -= I_ING;
        if (r < I_INC) { const int kb = r / 16, n0 = 32 * (r % 16); tr_item(Win, 2840, 1304, 512, mpre, WI, DM, 1280 + n0, scr, kb, n0, lane); continue; } r -= I_INC;
        if (r < I_INC) { const int kb = r / 16, n0 = 32 * (r % 16); tr_item(Win, 2840, 1816, 512, mpre, WI, DM, 1792 + n0, scr, kb, n0, lane); continue; } r -= I_INC;
        if (r < I_INC) { const int kb = r / 16, n0 = 32 * (r % 16); tr_item(Win, 2840, 2328, 512, mpre, WI, DM, 2304 + n0, scr, kb, n0, lane); continue; } r -= I_INC;
        if (r < I_O) { const int kb = r / 32, n0 = 32 * (r % 32);
            const float* gn = (kb < 8) ? (I.aon + (size_t)l * 512) : (I.con + (size_t)l * 512 - 512);
            tr_item(I.w_out + (size_t)l * DM * DM, DM, 0, DM, gn, (bf16*)(wl + WO_O), DM, n0, scr, kb, n0, lane); continue; } r -= I_O;
        if (r < I_W1) { const int kb = r / 8, n0 = 32 * (r % 8); tr_item(I.w1_k + (size_t)l * 2048 * 256, 256, 0, 256, nullptr, (bf16*)(wl + WO_W1), 2048, n0, scr, kb, n0, lane); continue; } r -= I_W1;
        { const int kb = r / 8, n0 = 32 * (r % 8); tr_item(I.w1_v + (size_t)l * 2048 * 256, 256, 0, 256, nullptr, (bf16*)(wl + WO_W1), 2048, 256 + n0, scr, kb, n0, lane); }
    }
    for (int i = gw * 64 + lane; i < NLAYER * 28672; i += NGW * 64) { const int l = i / 28672, q = i % 28672;
        *(GAS v4u*)(ws + WS_W + (size_t)l * W_LAYER + WO_IN + (size_t)2848 * DM * 2 + (size_t)q * 16) = (v4u){0u, 0u, 0u, 0u}; }
    for (int j = gw; j < 256; j += NGW) { const int vec = j >> 6, c = ((j >> 4) & 3) * 64 + lane, kc = j & 15, l = vec >> 1, kv = vec & 1;
        const float* pe = (kv == 0 ? I.pe_k : I.pe_v) + (size_t)l * 2048 + 128 * kc; const float* w1 = (kv == 0 ? I.w1_k : I.w1_v) + (size_t)l * 2048 * 256 + (size_t)128 * kc * 256;
        float s0 = 0.f, s1 = 0.f, s2 = 0.f, s3 = 0.f;
#pragma unroll 8
        for (int k = 0; k < 128; k += 4) { s0 += pe[k] * w1[(size_t)k * 256 + c]; s1 += pe[k + 1] * w1[(size_t)(k + 1) * 256 + c]; s2 += pe[k + 2] * w1[(size_t)(k + 2) * 256 + c]; s3 += pe[k + 3] * w1[(size_t)(k + 3) * 256 + c]; }
        ((float*)(ws + WS_BIASP))[(kc * 4 + vec) * 256 + c] = (s0 + s1) + (s2 + s3); }
}

__device__ __forceinline__ void pro_rope(const int* pos, float* rope, int gtid, int nthreads) {
    const double invf[8] = {1.0, 0.19392274474868576, 0.03760603093086393, 0.007292664737217109, 0.001414213562373095, 0.0002742481756762073, 5.318295896944988e-05, 1.031338537721246e-05};
    for (int e = gtid; e < M * 8; e += nthreads) { const int row = e >> 3, i = e & 7;
        double f = 1.0;
#pragma unroll
        for (int q = 0; q < 8; ++q) f = (i == q) ? invf[q] : f;
        const double ang = (double)pos[row] * f;
        const double k = __builtin_rint(ang * 0.15915494309189535);
        const double red = __builtin_fma(-k, 1.2246467991473532e-16 * 2.0, __builtin_fma(-k, 6.283185307179586, ang));
        const float rf = (float)red;
        rope[(size_t)row * 16 + i] = cosf(rf); rope[(size_t)row * 16 + 8 + i] = sinf(rf); }
}

__device__ __forceinline__ void pro_x(const float* x, bf16* xb, float* rstd, int gw, int NGW, int lane) {
    constexpr int R = 4;
    for (int row0 = gw * R; row0 < M; row0 += NGW * R) {
        f32x4 v[R][4]; float s[R];
#pragma unroll
        for (int r = 0; r < R; ++r) { const GAS f32x4* xr = (const GAS f32x4*)(x + (size_t)(row0 + r) * DM) + lane;
#pragma unroll
            for (int j = 0; j < 4; ++j) v[r][j] = xr[64 * j]; }
#pragma unroll
        for (int r = 0; r < R; ++r) { s[r] = 0.f; GAS v2u* o8 = (GAS v2u*)(xb + (size_t)(row0 + r) * DM) + lane;
#pragma unroll
            for (int j = 0; j < 4; ++j) { s[r] += (v[r][j].x * v[r][j].x + v[r][j].y * v[r][j].y) + (v[r][j].z * v[r][j].z + v[r][j].w * v[r][j].w); o8[64 * j] = (v2u){pkc(v[r][j].x, v[r][j].y), pkc(v[r][j].z, v[r][j].w)}; } }
#pragma unroll
        for (int o = 1; o < 64; o <<= 1) {
#pragma unroll
            for (int r = 0; r < R; ++r) s[r] += __shfl_xor(s[r], o); }
        if (lane < R) { float vv = s[0];
#pragma unroll
            for (int r = 1; r < R; ++r) vv = (lane == r) ? s[r] : vv;
            rstd[row0 + lane] = 1.0f / sqrtf(vv * (1.0f / DM) + EPS); }
    }
}

template <bool XIN_F32, bool OUT_F32>
__device__ __forceinline__ void rowpass(const void* xin, void* xout, const bf16* h, const float* gpost, float scale, float* rstd, int gw, int NGW, int lane) {
    constexpr int R = 4;
    f32x4 gv[4];
#pragma unroll
    for (int j = 0; j < 4; ++j) gv[j] = *((const GAS f32x4*)gpost + lane + 64 * j);
    for (int row0 = gw * R; row0 < M; row0 += NGW * R) {
        f32x4 xv[R][4]; v2u hw[R][4];
#pragma unroll
        for (int r = 0; r < R; ++r) { const GAS v2u* hr = (const GAS v2u*)(h + (size_t)(row0 + r) * DM) + lane;
#pragma unroll
            for (int j = 0; j < 4; ++j) { hw[r][j] = hr[64 * j];
                if (XIN_F32) xv[r][j] = *((const GAS f32x4*)((const float*)xin + (size_t)(row0 + r) * DM) + lane + 64 * j);
                else { const v2u w = *((const GAS v2u*)((const bf16*)xin + (size_t)(row0 + r) * DM) + lane + 64 * j); xv[r][j] = (f32x4){bf_lo(w.x), bf_hi(w.x), bf_lo(w.y), bf_hi(w.y)}; } } }
        float s[R];
#pragma unroll
        for (int r = 0; r < R; ++r) { s[r] = 0.f;
#pragma unroll
            for (int j = 0; j < 4; ++j) { const float a = bf_lo(hw[r][j].x), b = bf_hi(hw[r][j].x), c = bf_lo(hw[r][j].y), d = bf_hi(hw[r][j].y); s[r] += (a * a + b * b) + (c * c + d * d); } }
#pragma unroll
        for (int o = 1; o < 64; o <<= 1) {
#pragma unroll
            for (int r = 0; r < R; ++r) s[r] += __shfl_xor(s[r], o); }
        float s2[R];
#pragma unroll
        for (int r = 0; r < R; ++r) { const float rh = scale / sqrtf(s[r] * (1.0f / DM) + EPS); s2[r] = 0.f;
#pragma unroll
            for (int j = 0; j < 4; ++j) { const f32x4 hv = {bf_lo(hw[r][j].x), bf_hi(hw[r][j].x), bf_lo(hw[r][j].y), bf_hi(hw[r][j].y)};
                xv[r][j] = xv[r][j] + hv * gv[j] * rh; s2[r] += (xv[r][j].x * xv[r][j].x + xv[r][j].y * xv[r][j].y) + (xv[r][j].z * xv[r][j].z + xv[r][j].w * xv[r][j].w); } }
#pragma unroll
        for (int r = 0; r < R; ++r) {
#pragma unroll
            for (int j = 0; j < 4; ++j) {
                if (OUT_F32) *((GAS f32x4*)((float*)xout + (size_t)(row0 + r) * DM) + lane + 64 * j) = xv[r][j];
                else *((GAS v2u*)((bf16*)xout + (size_t)(row0 + r) * DM) + lane + 64 * j) = (v2u){pkc(xv[r][j].x, xv[r][j].y), pkc(xv[r][j].z, xv[r][j].w)}; } }
        if (!OUT_F32) {
#pragma unroll
            for (int o = 1; o < 64; o <<= 1) {
#pragma unroll
                for (int r = 0; r < R; ++r) s2[r] += __shfl_xor(s2[r], o); }
            if (lane < R) { float v = s2[0];
#pragma unroll
                for (int r = 1; r < R; ++r) v = (lane == r) ? s2[r] : v;
                rstd[row0 + lane] = 1.0f / sqrtf(v * (1.0f / DM) + EPS); }
        }
    }
}

__device__ __forceinline__ float gelu_tanh(float x) {
    const float u = 0.7978845608028654f * (x + 0.044715f * x * x * x);
    const float e = ex2(2.0f * 1.4426950408889634f * u);
    const float th = 1.0f - 2.0f * __builtin_amdgcn_rcpf(e + 1.0f);
    return 0.5f * x * (1.0f + th);
}
__device__ __forceinline__ int kt_off(int key, int d) { return (((key >> 4) * 2 + (d >> 5)) * 64 + ((d & 31) >> 3) * 16 + (key & 15)) * 8 + (d & 7); }
__device__ __forceinline__ int vt_off(int key, int d) { return ((((key >> 5) * 4 + (d >> 4)) * 64) + ((key & 15) >> 2) * 16 + (d & 15)) * 8 + (key & 3) + 4 * ((key >> 4) & 1); }

__device__ __forceinline__ void cmp2_phase(const float* hidp, const float* bias, const float* w2k, const float* w2v, bf16* kc_t, bf16* vc_t, float* kcn, int gw, int NGW, int lane) {
    const int col = lane & 15, g4 = lane >> 4;
    for (int task = gw; task < 512; task += NGW) {
        const int m0 = 16 * task, kv = m0 >> 12, bg = (m0 >> 10) & 3;
        const float* bs = bias + kv * 256; const float* w2 = kv == 0 ? w2k : w2v;
        f32x4 acc[4] = {{0.f, 0.f, 0.f, 0.f}, {0.f, 0.f, 0.f, 0.f}, {0.f, 0.f, 0.f, 0.f}, {0.f, 0.f, 0.f, 0.f}};
        const float* hrow = hidp + (size_t)(m0 + col) * 256 + 4 * g4;
        f32x4 hv[16];
#pragma unroll
        for (int kk = 0; kk < 16; ++kk) hv[kk] = *(const GAS f32x4*)(hrow + 16 * kk) + *(const GAS f32x4*)(bs + 16 * kk + 4 * g4);
#pragma unroll
        for (int p = 1; p < 4; ++p)
#pragma unroll
            for (int kk = 0; kk < 16; ++kk) hv[kk] = hv[kk] + *(const GAS f32x4*)(hrow + (size_t)p * 8192 * 256 + 16 * kk);
#pragma unroll
        for (int kk = 0; kk < 16; ++kk) {
#pragma unroll
            for (int j = 0; j < 4; ++j) { const float av = gelu_tanh(hv[kk][j]); const float* wr = w2 + (size_t)(16 * kk + 4 * g4 + j) * 64 + col;
#pragma unroll
                for (int nt = 0; nt < 4; ++nt) acc[nt] = __builtin_amdgcn_mfma_f32_16x16x4f32(av, wr[16 * nt], acc[nt], 0, 0, 0); }
        }
        float nmax = 0.f;
#pragma unroll
        for (int r = 0; r < 4; ++r) { const int n = (m0 + 4 * g4 + r) & 1023; float sq = 0.f;
#pragma unroll
            for (int nt = 0; nt < 4; ++nt) { const float o = (n == 1023) ? 0.f : acc[nt][r]; sq += o * o; const int d = 16 * nt + col;
                const unsigned short ob = (unsigned short)(pkc(o, 0.f) & 0xffffu);
                if (kv == 0) kc_t[(size_t)bg * 65536 + kt_off(n, d)] = ob; else vc_t[(size_t)bg * 65536 + vt_off(n, d)] = ob; }
#pragma unroll
            for (int o = 1; o < 16; o <<= 1) sq += __shfl_xor(sq, o);
            nmax = fmaxf(nmax, sq); }
        nmax = fmaxf(nmax, __shfl_xor(nmax, 16)); nmax = fmaxf(nmax, __shfl_xor(nmax, 32));
        if (kv == 0 && lane == 0) kcn[bg * 64 + ((m0 & 1023) >> 4)] = nmax;
    }
}
__device__ __forceinline__ void vretile(const bf16* vrm, bf16* vt, int gw, int NGW, int lane) {
    for (int it = gw; it < 4 * (SEQ / 32); it += NGW) {
        const int bg = it / (SEQ / 32), kg = it % (SEQ / 32);
        const bf16* src = vrm + ((size_t)bg * SEQ + kg * 32) * 64; bf16* dst = vt + (size_t)bg * SEQ * 64;
#pragma unroll
        for (int g4 = 0; g4 < 4; ++g4) { unsigned short e[8];
#pragma unroll
            for (int j = 0; j < 8; ++j) { const int key = 4 * g4 + (j & 3) + 16 * (j >> 2); e[j] = src[key * 64 + lane]; }
            v4u w; w.x = e[0] | ((unsigned)e[1] << 16); w.y = e[2] | ((unsigned)e[3] << 16); w.z = e[4] | ((unsigned)e[5] << 16); w.w = e[6] | ((unsigned)e[7] << 16);
            *(GAS v4u*)(dst + (size_t)((kg * 4 + (lane >> 4)) * 64 + g4 * 16 + (lane & 15)) * 8) = w; }
    }
}

__device__ __forceinline__ void unpack8(const v4u w, float (&f)[8]) { f[0] = bf_lo(w.x); f[1] = bf_hi(w.x); f[2] = bf_lo(w.y); f[3] = bf_hi(w.y); f[4] = bf_lo(w.z); f[5] = bf_hi(w.z); f[6] = bf_lo(w.w); f[7] = bf_hi(w.w); }

__device__ __forceinline__ float wave_max(float v) {
#pragma unroll
    for (int o = 1; o < 64; o <<= 1) v = fmaxf(v, __shfl_xor(v, o));
    return v;
}
__device__ __forceinline__ void knorm_pass(const bf16* k_t, float* kn, int gw, int NGW, int lane) {
    for (int it = gw; it < 4 * (SEQ / 16); it += NGW) {
        const bf16* p = k_t + (size_t)it * 1024 + lane * 8;
        const v4u a = *(const GAS v4u*)p, b = *(const GAS v4u*)(p + 512);
        float f[8], s = 0.f;
        unpack8(a, f);
#pragma unroll
        for (int j = 0; j < 8; ++j) s += f[j] * f[j];
        unpack8(b, f);
#pragma unroll
        for (int j = 0; j < 8; ++j) s += f[j] * f[j];
        s += __shfl_xor(s, 16); s += __shfl_xor(s, 32);
#pragma unroll
        for (int o = 1; o < 16; o <<= 1) s = fmaxf(s, __shfl_xor(s, o));
        if (lane == 0) kn[it] = s;
    }
}

__device__ __forceinline__ int mbcnt64(unsigned long long m) { return (int)__builtin_amdgcn_mbcnt_hi((unsigned)(m >> 32), __builtin_amdgcn_mbcnt_lo((unsigned)m, 0u)); }
__device__ __forceinline__ void sel_one(const f32x4 sv, int t, int* dst, int lane) {
    const int cur = t >> 6;
    unsigned u[4]; bool ok[4];
#pragma unroll
    for (int k = 0; k < 4; ++k) { const int j = 4 * lane + k; ok[k] = j <= cur; const bool forced = (j == 0) || (j == cur) || (j == cur - 1);
        const float v = forced ? 1e9f : fmaxf(sv[k], 0.f); u[k] = ok[k] ? __float_as_uint(v) : 0u; }
    bool sel[4];
    if (cur + 1 <= KTOP) {
#pragma unroll
        for (int k = 0; k < 4; ++k) sel[k] = ok[k];
    } else {
        unsigned tau = 0u;
#pragma unroll 1
        for (int bit = 30; bit >= 0; --bit) { const unsigned cand = tau | (1u << bit);
            const int cnt = __builtin_popcountll(__ballot(ok[0] && u[0] >= cand)) + __builtin_popcountll(__ballot(ok[1] && u[1] >= cand)) + __builtin_popcountll(__ballot(ok[2] && u[2] >= cand)) + __builtin_popcountll(__ballot(ok[3] && u[3] >= cand));
            if (cnt >= KTOP) tau = cand; }
        bool gt[4], eq[4]; unsigned long long em[4]; int ngt = 0;
#pragma unroll
        for (int k = 0; k < 4; ++k) { gt[k] = ok[k] && u[k] > tau; eq[k] = ok[k] && u[k] == tau; ngt += __builtin_popcountll(__ballot(gt[k])); em[k] = __ballot(eq[k]); }
        const int need = KTOP - ngt;
        int rank = mbcnt64(em[0]) + mbcnt64(em[1]) + mbcnt64(em[2]) + mbcnt64(em[3]);
#pragma unroll
        for (int k = 0; k < 4; ++k) { sel[k] = gt[k] || (eq[k] && rank < need); rank += eq[k] ? 1 : 0; }
    }
    unsigned long long sm[4];
#pragma unroll
    for (int k = 0; k < 4; ++k) sm[k] = __ballot(sel[k]);
    int pos = mbcnt64(sm[0]) + mbcnt64(sm[1]) + mbcnt64(sm[2]) + mbcnt64(sm[3]);
    const int total = __builtin_popcountll(sm[0]) + __builtin_popcountll(sm[1]) + __builtin_popcountll(sm[2]) + __builtin_popcountll(sm[3]);
#pragma unroll
    for (int k = 0; k < 4; ++k) { if (sel[k] && pos < KTOP) dst[pos] = 4 * lane + k; pos += sel[k] ? 1 : 0; }
    if (lane >= total && lane < KTOP) dst[lane] = -1;
}

__device__ __forceinline__ void acmp_item(const bf16* qraw, bf16* ocmp, const bf16* kc_t, const bf16* vc_t, int* idx, const float* kcn, LAS float* sw, int bg, int qt, int lane) {
    const int col = lane & 15, g4 = lane >> 4, b = bg >> 1, g = bg & 1;
    const int t = 16 * qt + col; const size_t row = (size_t)b * SEQ + t;
    const int nmax = (t - 31) >> 4;
    const int ntiles = (qt + 15) >> 4;
    bf16x8 qf[4][2]; float shift[4];
    const float kmx = wave_max(kcn[bg * 64 + lane]);
#pragma unroll
    for (int hh = 0; hh < 4; ++hh) { float qn = 0.f;
#pragma unroll
        for (int s = 0; s < 2; ++s) { qf[hh][s] = *(const bf16x8*)(qraw + row * 512 + (4 * g + hh) * 64 + 32 * s + 8 * g4); float f[8]; unpack8(__builtin_bit_cast(v4u, qf[hh][s]), f);
#pragma unroll
            for (int j = 0; j < 8; ++j) qn += f[j] * f[j]; }
        qn += __shfl_xor(qn, 16); qn += __shfl_xor(qn, 32);
        shift[hh] = C2 * sqrtf(qn * kmx) * 1.01f + 1e-6f; }
    const bf16* kb = kc_t + (size_t)bg * 65536 + lane * 8; const bf16* vb = vc_t + (size_t)bg * 65536 + lane * 8;
    const f32x4 zero = {0.f, 0.f, 0.f, 0.f};
    if (__any(shift[0] > 60.f || shift[1] > 60.f || shift[2] > 60.f || shift[3] > 60.f)) {
        float mx[4] = {-1e30f, -1e30f, -1e30f, -1e30f};
        for (int T = 0; T < ntiles; ++T) { const bf16x8 k0 = *(const bf16x8*)(kb + (T * 2 + 0) * 512), k1 = *(const bf16x8*)(kb + (T * 2 + 1) * 512);
#pragma unroll
            for (int hh = 0; hh < 4; ++hh) { f32x4 s = mfma16(k0, qf[hh][0], zero); s = mfma16(k1, qf[hh][1], s);
#pragma unroll
                for (int r = 0; r < 4; ++r) mx[hh] = ((16 * T + 4 * g4 + r) <= nmax) ? fmaxf(mx[hh], s[r] * C2) : mx[hh]; } }
#pragma unroll
        for (int hh = 0; hh < 4; ++hh) { float m = fmaxf(mx[hh], __shfl_xor(mx[hh], 16)); m = fmaxf(m, __shfl_xor(m, 32)); shift[hh] = m; }
    }
    float ls[4] = {0.f, 0.f, 0.f, 0.f};
    if (ntiles > 0) {
        bf16x8 k0 = *(const bf16x8*)(kb), k1 = *(const bf16x8*)(kb + 512);
        for (int T = 0; T < ntiles; ++T) {
            const int Tn = (T + 1 < ntiles) ? T + 1 : T;
            const bf16x8 n0 = *(const bf16x8*)(kb + (Tn * 2 + 0) * 512), n1 = *(const bf16x8*)(kb + (Tn * 2 + 1) * 512);
#pragma unroll
            for (int hh = 0; hh < 4; ++hh) { f32x4 s = mfma16(k0, qf[hh][0], zero); s = mfma16(k1, qf[hh][1], s);
#pragma unroll
                for (int r = 0; r < 4; ++r) ls[hh] += ((16 * T + 4 * g4 + r) <= nmax) ? ex2(__builtin_fmaf(s[r], C2, -shift[hh])) : 0.f; }
            k0 = n0; k1 = n1;
        }
    }
#pragma unroll
    for (int hh = 0; hh < 4; ++hh) { float l = ls[hh]; l += __shfl_xor(l, 16); l += __shfl_xor(l, 32); ls[hh] = l > 0.f ? 1.0f / l : 0.f; }
    f32x4 O[4][4];
#pragma unroll
    for (int hh = 0; hh < 4; ++hh)
#pragma unroll
        for (int dt = 0; dt < 4; ++dt) O[hh][dt] = zero;
    float carry = 0.f;
    const int npairs = (ntiles + 1) >> 1;
    LAS float* srow = sw + col * 256;
    for (int kg = 0; kg < npairs; ++kg) {
        bf16x8 vf[4], kf[2][2];
#pragma unroll
        for (int dt = 0; dt < 4; ++dt) vf[dt] = *(const bf16x8*)(vb + (kg * 4 + dt) * 512);
#pragma unroll
        for (int tt = 0; tt < 2; ++tt)
#pragma unroll
            for (int s = 0; s < 2; ++s) kf[tt][s] = *(const bf16x8*)(kb + ((2 * kg + tt) * 2 + s) * 512);
        f32x4 p[2][4]; float aa[2], bb[2];
#pragma unroll
        for (int tt = 0; tt < 2; ++tt) {
            const int T = 2 * kg + tt;
            aa[tt] = 0.f; bb[tt] = 0.f;
#pragma unroll
            for (int hh = 0; hh < 4; ++hh) {
                f32x4 s = mfma16(kf[tt][0], qf[hh][0], zero); s = mfma16(kf[tt][1], qf[hh][1], s);
#pragma unroll
                for (int r = 0; r < 4; ++r) p[tt][hh][r] = ((16 * T + 4 * g4 + r) <= nmax) ? ex2(__builtin_fmaf(s[r], C2, -shift[hh])) * ls[hh] : 0.f;
                aa[tt] += 2.0f * (p[tt][hh][0] + p[tt][hh][1] + p[tt][hh][2]) + p[tt][hh][3]; bb[tt] += p[tt][hh][3];
            }
        }
#pragma unroll
        for (int hh = 0; hh < 4; ++hh) { const bf16x8 pf = pack8(p[0][hh], p[1][hh]);
#pragma unroll
            for (int dt = 0; dt < 4; ++dt) O[hh][dt] = mfma16(vf[dt], pf, O[hh][dt]); }
#pragma unroll
        for (int tt = 0; tt < 2; ++tt) {
            const int T = 2 * kg + tt;
            const float bsh = __shfl(bb[tt], (lane + 48) & 63);
            const float val = aa[tt] + (g4 == 0 ? carry : bsh);
            carry = bsh;
            srow[4 * T + g4] = val;
        }
    }
    for (int j = 8 * npairs + g4; j < NSELB; j += 4) srow[j] = (j == 8 * npairs) ? carry : 0.f;
#pragma unroll
    for (int hh = 0; hh < 4; ++hh)
#pragma unroll
        for (int dt = 0; dt < 4; ++dt) { const f32x4 o = O[hh][dt];
            *(GAS v2u*)(ocmp + row * 512 + (4 * g + hh) * 64 + 16 * dt + 4 * g4) = (v2u){pkc(o[0], o[1]), pkc(o[2], o[3])}; }
    asm volatile("s_waitcnt lgkmcnt(0)" ::: "memory");
    for (int qi = 0; qi < 16; ++qi) {
        const f32x4 sv = *((const LAS f32x4*)(sw + qi * 256) + lane);
        const int tq = 16 * qt + qi;
        sel_one(sv, tq, idx + (((size_t)b * SEQ + tq) * 2 + g) * KTOP, lane);
    }
    asm volatile("s_waitcnt lgkmcnt(0)" ::: "memory");
}

struct SlcFrags { bf16x8 kf[4][2], vf[2][4]; };
__device__ __forceinline__ void slc_load(SlcFrags& f, const bf16* kb, const bf16* vb, int blk) {
#pragma unroll
    for (int T = 0; T < 4; ++T)
#pragma unroll
        for (int s = 0; s < 2; ++s) f.kf[T][s] = *(const bf16x8*)(kb + (size_t)((blk * 4 + T) * 2 + s) * 512);
#pragma unroll
    for (int ks = 0; ks < 2; ++ks)
#pragma unroll
        for (int dt = 0; dt < 4; ++dt) f.vf[ks][dt] = *(const bf16x8*)(vb + (size_t)((blk * 2 + ks) * 4 + dt) * 512);
}
__device__ __forceinline__ void slc_compute(const SlcFrags& f, const bf16x8 (&qf)[2], f32x4 (&O)[4], float& Mx, float& l, int blk, int cur, int t, int g4) {
    const f32x4 zero = {0.f, 0.f, 0.f, 0.f};
    f32x4 e[4]; float mt = -1e30f;
    const bool diag = (blk == cur);
#pragma unroll
    for (int T = 0; T < 4; ++T) { f32x4 s = mfma16(f.kf[T][0], qf[0], zero); s = mfma16(f.kf[T][1], qf[1], s);
#pragma unroll
        for (int r = 0; r < 4; ++r) { const bool valid = !diag || (64 * blk + 16 * T + 4 * g4 + r) <= t; e[T][r] = valid ? s[r] * C2 : -1e30f; mt = fmaxf(mt, e[T][r]); } }
    mt = fmaxf(mt, __shfl_xor(mt, 16)); mt = fmaxf(mt, __shfl_xor(mt, 32));
    const float Mn = fmaxf(Mx, mt), alpha = ex2(Mx - Mn); Mx = Mn;
    float add = 0.f;
#pragma unroll
    for (int T = 0; T < 4; ++T)
#pragma unroll
        for (int r = 0; r < 4; ++r) { const float pv = (e[T][r] > -1e29f) ? ex2(e[T][r] - Mn) : 0.f; e[T][r] = pv; add += pv; }
    l = l * alpha + add;
#pragma unroll
    for (int dt = 0; dt < 4; ++dt) O[dt] = O[dt] * alpha;
#pragma unroll
    for (int ks = 0; ks < 2; ++ks) { const bf16x8 pf = pack8(e[2 * ks], e[2 * ks + 1]);
#pragma unroll
        for (int dt = 0; dt < 4; ++dt) O[dt] = mfma16(f.vf[ks][dt], pf, O[dt]); }
}
__device__ __forceinline__ void slc_compute_fs(const SlcFrags& f, const bf16x8 (&qf)[2], f32x4 (&O)[4], float shift, float& l, int blk, int cur, int t, int g4) {
    const f32x4 zero = {0.f, 0.f, 0.f, 0.f};
    f32x4 e[4];
#pragma unroll
    for (int T = 0; T < 4; ++T) { f32x4 s = mfma16(f.kf[T][0], qf[0], zero); s = mfma16(f.kf[T][1], qf[1], s);
#pragma unroll
        for (int r = 0; r < 4; ++r) e[T][r] = ex2(__builtin_fmaf(s[r], C2, -shift)); }
    if (blk == cur) {
#pragma unroll
        for (int T = 0; T < 4; ++T)
#pragma unroll
            for (int r = 0; r < 4; ++r) e[T][r] = ((64 * blk + 16 * T + 4 * g4 + r) <= t) ? e[T][r] : 0.f;
    }
    float add = 0.f;
#pragma unroll
    for (int T = 0; T < 4; ++T) add += (e[T][0] + e[T][1]) + (e[T][2] + e[T][3]);
    l += add;
#pragma unroll
    for (int ks = 0; ks < 2; ++ks) { const bf16x8 pf = pack8(e[2 * ks], e[2 * ks + 1]);
#pragma unroll
        for (int dt = 0; dt < 4; ++dt) O[dt] = mfma16(f.vf[ks][dt], pf, O[dt]); }
}
__device__ __forceinline__ void aslc_item(const bf16* qrot, const bf16* ks_t, const bf16* vs_t, const int* idx, bf16* oslc, const float* ksn, int row, int g, int lane) {
    const int col = lane & 15, g4 = lane >> 4, b = row >> 14, t = row & (SEQ - 1), bg = b * 2 + g, cur = t >> 6;
    const int myidx = (lane < KTOP) ? idx[((size_t)row * 2 + g) * KTOP + lane] : -1;
    const int nsel = __builtin_popcountll(__ballot(myidx >= 0));
    bf16x8 qf[2];
#pragma unroll
    for (int s = 0; s < 2; ++s) { if (col < 4) qf[s] = *(const bf16x8*)(qrot + (size_t)row * 512 + (4 * g + col) * 64 + 32 * s + 8 * g4); else qf[s] = (bf16x8){0, 0, 0, 0, 0, 0, 0, 0}; }
    const bf16* kb = ks_t + (size_t)bg * SEQ * 64 + lane * 8; const bf16* vb = vs_t + (size_t)bg * SEQ * 64 + lane * 8;
    const f32x4 zero = {0.f, 0.f, 0.f, 0.f};
    f32x4 O[4] = {zero, zero, zero, zero}; float Mx = -1e30f, l = 0.f;
    SlcFrags fa, fb;
    slc_load(fa, kb, vb, __builtin_amdgcn_readlane(myidx, 0));
    float qn = 0.f;
    { float f[8]; unpack8(__builtin_bit_cast(v4u, qf[0]), f);
#pragma unroll
      for (int j = 0; j < 8; ++j) qn += f[j] * f[j];
      unpack8(__builtin_bit_cast(v4u, qf[1]), f);
#pragma unroll
      for (int j = 0; j < 8; ++j) qn += f[j] * f[j]; }
    qn += __shfl_xor(qn, 16); qn += __shfl_xor(qn, 32);
    const int bsel = __shfl(myidx, lane >> 2);
    const float kmx = wave_max(bsel >= 0 ? ksn[bg * (SEQ / 16) + bsel * 4 + (lane & 3)] : 0.f);
    const float shift = C2 * sqrtf(qn * kmx) * 1.0001f + 1e-6f;
    if (!__any(shift > 60.0f)) {
        for (int k = 0; k < nsel; k += 2) {
            const int b0 = __builtin_amdgcn_readlane(myidx, k);
            const bool has1 = (k + 1 < nsel);
            const int b1 = has1 ? __builtin_amdgcn_readlane(myidx, k + 1) : 0;
            if (has1) slc_load(fb, kb, vb, b1);
            slc_compute_fs(fa, qf, O, shift, l, b0, cur, t, g4);
            if (has1) {
                if (k + 2 < nsel) slc_load(fa, kb, vb, __builtin_amdgcn_readlane(myidx, k + 2));
                slc_compute_fs(fb, qf, O, shift, l, b1, cur, t, g4);
            }
        }
    } else {
        for (int k = 0; k < nsel; ++k) { const int b0 = __builtin_amdgcn_readlane(myidx, k); if (k > 0) slc_load(fa, kb, vb, b0); slc_compute(fa, qf, O, Mx, l, b0, cur, t, g4); }
    }
    l += __shfl_xor(l, 16); l += __shfl_xor(l, 32);
    const float inv = l > 0.f ? 1.0f / l : 0.f;
    if (col < 4) {
#pragma unroll
        for (int dt = 0; dt < 4; ++dt) { const f32x4 o = O[dt] * inv;
            *(GAS v2u*)(oslc + (size_t)row * 512 + (4 * g + col) * 64 + 16 * dt + 4 * g4) = (v2u){pkc(o[0], o[1]), pkc(o[2], o[3])}; }
    }
}

struct WinFrags { bf16x8 kf[2][2], vf[4]; };
__device__ __forceinline__ void win_load(WinFrags& f, const bf16* kb, const bf16* vb, int kg) {
#pragma unroll
    for (int tt = 0; tt < 2; ++tt)
#pragma unroll
        for (int s = 0; s < 2; ++s) f.kf[tt][s] = *(const bf16x8*)(kb + (size_t)((2 * kg + tt) * 2 + s) * 512);
#pragma unroll
    for (int dt = 0; dt < 4; ++dt) f.vf[dt] = *(const bf16x8*)(vb + (size_t)(kg * 4 + dt) * 512);
}
__device__ __forceinline__ void win_compute_fs(const WinFrags& f, const bf16x8 (&qf)[2], f32x4 (&O)[4], float shift, float& l, int kg, int t, int g4, bool edge) {
    const f32x4 zero = {0.f, 0.f, 0.f, 0.f};
    f32x4 e[2];
#pragma unroll
    for (int tt = 0; tt < 2; ++tt) { f32x4 s = mfma16(f.kf[tt][0], qf[0], zero); s = mfma16(f.kf[tt][1], qf[1], s);
#pragma unroll
        for (int r = 0; r < 4; ++r) e[tt][r] = ex2(__builtin_fmaf(s[r], C2, -shift)); }
    if (edge) {
#pragma unroll
        for (int tt = 0; tt < 2; ++tt)
#pragma unroll
            for (int r = 0; r < 4; ++r) { const int df = t - (32 * kg + 16 * tt + 4 * g4 + r); e[tt][r] = (df >= 0 && df < 512) ? e[tt][r] : 0.f; }
    }
    l += ((e[0][0] + e[0][1]) + (e[0][2] + e[0][3])) + ((e[1][0] + e[1][1]) + (e[1][2] + e[1][3]));
    const bf16x8 pf = pack8(e[0], e[1]);
#pragma unroll
    for (int dt = 0; dt < 4; ++dt) O[dt] = mfma16(f.vf[dt], pf, O[dt]);
}
__device__ __forceinline__ void win_compute_on(const WinFrags& f, const bf16x8 (&qf)[2], f32x4 (&O)[4], float& Mx, float& l, int kg, int t, int g4) {
    const f32x4 zero = {0.f, 0.f, 0.f, 0.f};
    f32x4 e[2]; float mt = -1e30f;
#pragma unroll
    for (int tt = 0; tt < 2; ++tt) { f32x4 s = mfma16(f.kf[tt][0], qf[0], zero); s = mfma16(f.kf[tt][1], qf[1], s);
#pragma unroll
        for (int r = 0; r < 4; ++r) { const int df = t - (32 * kg + 16 * tt + 4 * g4 + r); const bool valid = df >= 0 && df < 512; e[tt][r] = valid ? s[r] * C2 : -1e30f; mt = fmaxf(mt, e[tt][r]); } }
    mt = fmaxf(mt, __shfl_xor(mt, 16)); mt = fmaxf(mt, __shfl_xor(mt, 32));
    const float Mn = fmaxf(Mx, mt), alpha = ex2(Mx - Mn); Mx = Mn;
    float add = 0.f;
#pragma unroll
    for (int tt = 0; tt < 2; ++tt)
#pragma unroll
        for (int r = 0; r < 4; ++r) { const float pv = (e[tt][r] > -1e29f) ? ex2(e[tt][r] - Mn) : 0.f; e[tt][r] = pv; add += pv; }
    l = l * alpha + add;
    const bf16x8 pf = pack8(e[0], e[1]);
#pragma unroll
    for (int dt = 0; dt < 4; ++dt) O[dt] = mfma16(f.vf[dt], pf, O[dt] * alpha);
}
__device__ __forceinline__ void awin_item(const bf16* qrot, bf16* owin, const bf16* kw_t, const bf16* vw_t, const float* kwn, int bg, int qt, int lane) {
    const int col = lane & 15, g4 = lane >> 4, b = bg >> 1, g = bg & 1;
    const int t = 16 * qt + col; const size_t row = (size_t)b * SEQ + t;
    const int tlo = qt - 32 > 0 ? qt - 32 : 0, kg0 = tlo >> 1, kg1 = qt >> 1;
    const float kmx = wave_max((2 * kg0 + lane <= 2 * kg1 + 1) ? kwn[bg * (SEQ / 16) + 2 * kg0 + lane] : 0.f);
    bf16x8 qf[4][2]; float shift[4];
#pragma unroll
    for (int hh = 0; hh < 4; ++hh) { float qn = 0.f;
#pragma unroll
        for (int s = 0; s < 2; ++s) { qf[hh][s] = *(const bf16x8*)(qrot + row * 512 + (4 * g + hh) * 64 + 32 * s + 8 * g4); float f[8]; unpack8(__builtin_bit_cast(v4u, qf[hh][s]), f);
#pragma unroll
            for (int j = 0; j < 8; ++j) qn += f[j] * f[j]; }
        qn += __shfl_xor(qn, 16); qn += __shfl_xor(qn, 32);
        shift[hh] = C2 * sqrtf(qn * kmx) * 1.0001f + 1e-6f; }
    const bf16* kb = kw_t + (size_t)bg * SEQ * 64 + lane * 8; const bf16* vb = vw_t + (size_t)bg * SEQ * 64 + lane * 8;
    const f32x4 zero = {0.f, 0.f, 0.f, 0.f};
    f32x4 O[4][4]; float l[4] = {0.f, 0.f, 0.f, 0.f};
#pragma unroll
    for (int hh = 0; hh < 4; ++hh)
#pragma unroll
        for (int dt = 0; dt < 4; ++dt) O[hh][dt] = zero;
    if (!__any(shift[0] > 60.f || shift[1] > 60.f || shift[2] > 60.f || shift[3] > 60.f)) {
        WinFrags fa, fb;
        win_load(fa, kb, vb, kg0);
        for (int kg = kg0; kg <= kg1; kg += 2) {
            const bool has1 = kg + 1 <= kg1;
            if (has1) win_load(fb, kb, vb, kg + 1);
            { const bool edge = (kg <= kg0 + 1) || (kg >= kg1 - 1);
#pragma unroll
              for (int hh = 0; hh < 4; ++hh) win_compute_fs(fa, qf[hh], O[hh], shift[hh], l[hh], kg, t, g4, edge); }
            if (has1) { if (kg + 2 <= kg1) win_load(fa, kb, vb, kg + 2);
                const bool edge = (kg + 1 <= kg0 + 1) || (kg + 1 >= kg1 - 1);
#pragma unroll
                for (int hh = 0; hh < 4; ++hh) win_compute_fs(fb, qf[hh], O[hh], shift[hh], l[hh], kg + 1, t, g4, edge); }
        }
    } else {
        float Mx[4] = {-1e30f, -1e30f, -1e30f, -1e30f};
        for (int kg = kg0; kg <= kg1; ++kg) { WinFrags fa; win_load(fa, kb, vb, kg);
#pragma unroll
            for (int hh = 0; hh < 4; ++hh) win_compute_on(fa, qf[hh], O[hh], Mx[hh], l[hh], kg, t, g4); }
    }
#pragma unroll
    for (int hh = 0; hh < 4; ++hh) { float ll = l[hh]; ll += __shfl_xor(ll, 16); ll += __shfl_xor(ll, 32);
        const float inv = ll > 0.f ? 1.0f / ll : 0.f;
#pragma unroll
        for (int dt = 0; dt < 4; ++dt) { const f32x4 o = O[hh][dt] * inv;
            *(GAS v2u*)(owin + row * 512 + (4 * g + hh) * 64 + 16 * dt + 4 * g4) = (v2u){pkc(o[0], o[1]), pkc(o[2], o[3])}; } }
}

__device__ __forceinline__ void mrg_phase(const bf16* ocmp, const bf16* oslc, const bf16* owin, const float* gates, const bf16* bgp, const bf16* cgp, const bf16* xcp, const float* convw, bf16* merged, int gw, int NGW, int lane) {
    float w0[8], w1[8], w2[8];
#pragma unroll
    for (int j = 0; j < 8; ++j) { w0[j] = convw[8 * lane + j]; w1[j] = convw[512 + 8 * lane + j]; w2[j] = convw[1024 + 8 * lane + j]; }
    for (int row = gw; row < M; row += NGW) {
        const int t = row & (SEQ - 1); const size_t o = (size_t)row * 512 + 8 * lane;
        float a[8], c[8], d[8], att[8];
        unpack8(*(const GAS v4u*)(ocmp + o), a); unpack8(*(const GAS v4u*)(oslc + o), c); unpack8(*(const GAS v4u*)(owin + o), d);
        const float* gr = gates + (size_t)row * NGATE + (lane >> 3) * 3; const float g0 = gr[0], g1 = gr[1], g2 = gr[2];
        float sa = 0.f;
#pragma unroll
        for (int j = 0; j < 8; ++j) { att[j] = g0 * a[j] + g1 * c[j] + g2 * d[j]; sa += att[j] * att[j]; }
        float bgv[8], u0[8], u1[8], u2[8], tmp[8];
        unpack8(*(const GAS v4u*)(bgp + o), bgv);
        unpack8(*(const GAS v4u*)(cgp + o), u2); unpack8(*(const GAS v4u*)(xcp + o), tmp);
#pragma unroll
        for (int j = 0; j < 8; ++j) u2[j] *= tmp[j];
        if (t >= 1) { unpack8(*(const GAS v4u*)(cgp + o - 512), u1); unpack8(*(const GAS v4u*)(xcp + o - 512), tmp);
#pragma unroll
            for (int j = 0; j < 8; ++j) u1[j] *= tmp[j]; }
        else {
#pragma unroll
            for (int j = 0; j < 8; ++j) u1[j] = 0.f; }
        if (t >= 2) { unpack8(*(const GAS v4u*)(cgp + o - 1024), u0); unpack8(*(const GAS v4u*)(xcp + o - 1024), tmp);
#pragma unroll
            for (int j = 0; j < 8; ++j) u0[j] *= tmp[j]; }
        else {
#pragma unroll
            for (int j = 0; j < 8; ++j) u0[j] = 0.f; }
        float y[8]; float sc = 0.f;
#pragma unroll
        for (int j = 0; j < 8; ++j) { y[j] = bgv[j] * (w0[j] * u0[j] + w1[j] * u1[j] + w2[j] * u2[j]); sc += y[j] * y[j]; }
        sa = wave_sum(sa); sc = wave_sum(sc);
        const float ra = 1.0f / sqrtf(sa * (1.0f / 512.0f) + EPS), rc = 1.0f / sqrtf(sc * (1.0f / 512.0f) + EPS);
        v4u wa, wc;
        wa.x = pkc(att[0] * ra, att[1] * ra); wa.y = pkc(att[2] * ra, att[3] * ra); wa.z = pkc(att[4] * ra, att[5] * ra); wa.w = pkc(att[6] * ra, att[7] * ra);
        wc.x = pkc(y[0] * rc, y[1] * rc); wc.y = pkc(y[2] * rc, y[3] * rc); wc.z = pkc(y[4] * rc, y[5] * rc); wc.w = pkc(y[6] * rc, y[7] * rc);
        *(GAS v4u*)(merged + (size_t)row * DM + 8 * lane) = wa; *(GAS v4u*)(merged + (size_t)row * DM + 512 + 8 * lane) = wc;
    }
}

struct Args { const void* in[25]; float* out; unsigned char* ws; int ph_lo, ph_hi, probe, pad; };
__device__ __forceinline__ unsigned char* opaque_ptr(unsigned char* p) { GAS unsigned char* g = (GAS unsigned char*)p; asm volatile("" : "+s"(g)); return (unsigned char*)g; }
__device__ __forceinline__ int opaque_v(int v) { asm volatile("" : "+v"(v)); return v; }
#define PH_LOCALS \
    unsigned char* ws = opaque_ptr(args.ws); \
    const int tid = opaque_v((int)threadIdx.x), lane = tid & 63, wave = __builtin_amdgcn_readfirstlane(tid >> 6); \
    const int G = gridDim.x, bx = blockIdx.x, vcu = (G % 8 == 0) ? (bx % 8) * (G / 8) + bx / 8 : bx, gw = vcu * NWAVES + wave, NGW = G * NWAVES; \
    (void)lane; (void)gw; (void)NGW; (void)ws; (void)bx;
#define INF(k) ((const float*)args.in[k])
#define WSP(T, off) ((T*)(ws + (off)))

__global__ void __launch_bounds__(NWAVES * 64, 2) mk_fwd(Args args) {
    extern __shared__ __attribute__((aligned(16))) unsigned char lds_raw[];
    LAS unsigned char* lds = (LAS unsigned char*)lds_raw;
    const int lo = args.ph_lo, hi = args.ph_hi;
    XcdBarrier bar; bar.bar = (unsigned*)(args.ws + WS_CTL) + CW_BAR; bar.x = 0; bar.st = nullptr;
    {
        const int tid0 = threadIdx.x;
        for (int u = tid0; u < (LDS_BYTES - RING_BYTES) / 4; u += NWAVES * 64) ((LAS unsigned*)(lds + RING_BYTES))[u] = 0u;
        __syncthreads();
        if (hi - lo > 1) bar = xcd_barrier_post((unsigned*)(args.ws + WS_CTL) + CW_BAR, (volatile LAS unsigned*)(lds + MISC_OFF) + 8);
    }
#define IN(k) (lo <= (k) && (k) < hi)
#define SEAM(k) do { if (IN(k) && IN((k) + 1)) xcd_barrier(bar); } while (0)

    if (EN(0) && IN(0)) {
        PH_LOCALS
        In I;
        I.x = INF(0); I.pos = (const int*)args.in[1]; I.f1_pre = INF(2); I.f1_wg = INF(3); I.f1_wu = INF(4); I.f1_wd = INF(5);
        I.f1_post = INF(6); I.mix_pre = INF(7); I.w_in = INF(8); I.pe_k = INF(9); I.w1_k = INF(10); I.w2_k = INF(11);
        I.pe_v = INF(12); I.w1_v = INF(13); I.w2_v = INF(14); I.conv_w = INF(15); I.aon = INF(16); I.con = INF(17);
        I.w_out = INF(18); I.mix_post = INF(19); I.f2_pre = INF(20); I.f2_wg = INF(21); I.f2_wu = INF(22); I.f2_wd = INF(23); I.f2_post = INF(24);
        pro_weights(I, ws, (LAS float*)(lds + wave * 16384), gw, NGW, lane);
        pro_rope(I.pos, WSP(float, WS_ROPE), vcu * NWAVES * 64 + tid, G * NWAVES * 64);
        pro_x(I.x, WSP(bf16, WS_XB), WSP(float, WS_RSTD), gw, NGW, lane);
    }
    SEAM(0);

    for (int l = 0; l < NLAYER; ++l) {
        const int P = 1 + l * PH_PER_LAYER;
        if (hi <= P || lo >= P + PH_PER_LAYER) continue;
        if (EN(1) && IN(P + 0)) {
            PH_LOCALS
            pg8::Gemm g{WSP(bf16, WS_XB), WSP(const bf16, WS_W + (size_t)l * W_LAYER + WO_GU1), M, 2 * DFF, DM, DM, DM}; pg8::StaticOrder S; S.init(M, 2 * DFF, G, bx);
            pg8::EpiSwiGLU E{WSP(bf16, WS_BIG), DFF, WSP(float, WS_RSTD)};
            pg8::gemm_phase<pg8::EpiSwiGLU, pg8::StaticOrder, true, true>(lds, g, S, E);
        }
        SEAM(P + 0);
        if (EN(2) && IN(P + 1)) {
            PH_LOCALS
            pg8::Gemm g{WSP(bf16, WS_BIG), WSP(const bf16, WS_W + (size_t)l * W_LAYER + WO_D1), M, DM, DFF, DFF, DFF}; pg8::StaticOrder S; S.init(M, DM, G, bx);
            pg8::EpiBf16<0> E{WSP(bf16, WS_H), DM, nullptr, 0, 0, 1.f};
            pg8::gemm_phase<pg8::EpiBf16<0>, pg8::StaticOrder, true, true>(lds, g, S, E);
        }
        SEAM(P + 1);
        if (EN(3) && IN(P + 2)) { PH_LOCALS
            bf16* xo = args.probe ? WSP(bf16, WS_BIG) : WSP(bf16, WS_XB); float* ro = args.probe ? WSP(float, WS_BIG + 170 * MiB) : WSP(float, WS_RSTD);
            if (l == 0) rowpass<true, false>(INF(0), xo, WSP(bf16, WS_H), INF(6) + (size_t)l * DM, 0.5f, ro, gw, NGW, lane);
            else rowpass<false, false>(WSP(bf16, WS_XB), xo, WSP(bf16, WS_H), INF(6) + (size_t)l * DM, 0.5f, ro, gw, NGW, lane); }
        SEAM(P + 2);
        if (EN(4) && IN(P + 3)) {
            PH_LOCALS
            pg8::Gemm g{WSP(bf16, WS_XB), WSP(const bf16, WS_W + (size_t)l * W_LAYER + WO_IN), M, NIN, DM, DM, DM}; pg8::StaticOrder S; S.init(M, NIN, G, bx);
            pg8::EpiInProj E{ws};
            pg8::gemm_phase<pg8::EpiInProj, pg8::StaticOrder, true, true>(lds, g, S, E);
        }
        SEAM(P + 3);
        if (EN(5) && IN(P + 4)) {
            PH_LOCALS
            vretile(WSP(bf16, WS_VS_RM), WSP(bf16, WS_VS_T), gw, NGW, lane); vretile(WSP(bf16, WS_VW_RM), WSP(bf16, WS_VW_T), gw, NGW, lane);
            knorm_pass(WSP(bf16, WS_KS_T), WSP(float, WS_KSN), gw, NGW, lane); knorm_pass(WSP(bf16, WS_KW_T), WSP(float, WS_KWN), gw, NGW, lane);
            if (gw < 8) { const int kv = gw >> 2, c = (gw & 3) * 64 + lane; float sacc = 0.f;
                for (int kc = 0; kc < 16; ++kc) sacc += WSP(float, WS_BIASP)[(kc * 4 + l * 2 + kv) * 256 + c];
                WSP(float, WS_BIAS)[(l * 2 + kv) * 256 + c] = sacc; }
            const int ks = (bx >> 5) & 3;
            pg8::Gemm g{WSP(bf16, WS_KRAW) + ks * 512, WSP(const bf16, WS_W + (size_t)l * W_LAYER + WO_W1) + ks * 512, 8192, 512, 512, 1024, 2048}; pg8::CmpOrder S{G, bx < 128 ? (bx & 31) : (1 << 20)};
            pg8::EpiHid E{WSP(float, WS_HIDP) + (size_t)ks * 8192 * 256};
            pg8::gemm_phase<pg8::EpiHid, pg8::CmpOrder, true, true>(lds, g, S, E);
        }
        SEAM(P + 4);
        if (EN(6) && IN(P + 5)) { PH_LOCALS cmp2_phase(WSP(float, WS_HIDP), WSP(float, WS_BIAS) + l * 512, INF(11) + (size_t)l * 256 * 64, INF(14) + (size_t)l * 256 * 64, WSP(bf16, WS_KC_T), WSP(bf16, WS_VC_T), WSP(float, WS_KCN), gw, NGW, lane); }
        SEAM(P + 5);
        if (EN(7) && IN(P + 6)) {
            PH_LOCALS
            for (int p = gw; p < 2048; p += NGW) { const int bg = p >> 9, i = p & 511;
                bf16* od = args.probe ? WSP(bf16, WS_HIDP) : WSP(bf16, WS_QRAW); int* id = args.probe ? WSP(int, WS_XB) : WSP(int, WS_IDX);
                acmp_item(WSP(bf16, WS_QRAW), od, WSP(bf16, WS_KC_T), WSP(bf16, WS_VC_T), id, WSP(float, WS_KCN), (LAS float*)(lds + wave * 16384), bg, i, lane);
                acmp_item(WSP(bf16, WS_QRAW), od, WSP(bf16, WS_KC_T), WSP(bf16, WS_VC_T), id, WSP(float, WS_KCN), (LAS float*)(lds + wave * 16384), bg, 1023 - i, lane); }
        }
        SEAM(P + 6);
        if (EN(9) && IN(P + 8)) { PH_LOCALS
            if (G % 8 == 0) { const int per = G / 8, xg = vcu / per, pair = xg >> 1, half = xg & 1, wloc = (vcu % per) * NWAVES + wave, nw = per * NWAVES;
                for (int t = 2 * wloc + half; t < SEQ; t += 2 * nw) aslc_item(WSP(bf16, WS_QROT), WSP(bf16, WS_KS_T), WSP(bf16, WS_VS_T), WSP(int, WS_IDX), WSP(bf16, WS_OSLC), WSP(float, WS_KSN), (pair >> 1) * SEQ + t, pair & 1, lane); }
            else { for (int it = gw; it < M * 2; it += NGW) aslc_item(WSP(bf16, WS_QROT), WSP(bf16, WS_KS_T), WSP(bf16, WS_VS_T), WSP(int, WS_IDX), WSP(bf16, WS_OSLC), WSP(float, WS_KSN), it >> 1, it & 1, lane); }
        }
        SEAM(P + 8);
        if (EN(10) && IN(P + 9)) { PH_LOCALS for (int p = gw; p < 2048; p += NGW) { const int bg = p >> 9, i = p & 511; bf16* od = args.probe ? WSP(bf16, WS_HIDP) : WSP(bf16, WS_QROT);
            awin_item(WSP(bf16, WS_QROT), od, WSP(bf16, WS_KW_T), WSP(bf16, WS_VW_T), WSP(float, WS_KWN), bg, i, lane); awin_item(WSP(bf16, WS_QROT), od, WSP(bf16, WS_KW_T), WSP(bf16, WS_VW_T), WSP(float, WS_KWN), bg, 1023 - i, lane); } }
        SEAM(P + 9);
        if (EN(11) && IN(P + 10)) { PH_LOCALS mrg_phase(WSP(bf16, WS_QRAW), WSP(bf16, WS_OSLC), WSP(bf16, WS_QROT), WSP(float, WS_GATES), WSP(bf16, WS_BG), WSP(bf16, WS_CG), WSP(bf16, WS_XC), INF(15) + (size_t)l * 3 * 512, (bf16*)args.out, gw, NGW, lane); }
        SEAM(P + 10);
        if (EN(12) && IN(P + 11)) {
            PH_LOCALS
            pg8::Gemm g{(const bf16*)args.out, WSP(const bf16, WS_W + (size_t)l * W_LAYER + WO_O), M, DM, DM, DM, DM}; pg8::StaticOrder S; S.init(M, DM, G, bx);
            pg8::EpiBf16<0> E{WSP(bf16, WS_H), DM, nullptr, 0, 0, 1.f};
            pg8::gemm_phase<pg8::EpiBf16<0>, pg8::StaticOrder, true, true>(lds, g, S, E);
        }
        SEAM(P + 11);
        if (EN(13) && IN(P + 12)) { PH_LOCALS
            bf16* xo = args.probe ? WSP(bf16, WS_BIG) : WSP(bf16, WS_XB); float* ro = args.probe ? WSP(float, WS_BIG + 170 * MiB) : WSP(float, WS_RSTD);
            rowpass<false, false>(WSP(bf16, WS_XB), xo, WSP(bf16, WS_H), INF(19) + (size_t)l * DM, 1.0f, ro, gw, NGW, lane); }
        SEAM(P + 12);
        if (EN(14) && IN(P + 13)) {
            PH_LOCALS
            pg8::Gemm g{WSP(bf16, WS_XB), WSP(const bf16, WS_W + (size_t)l * W_LAYER + WO_GU2), M, 2 * DFF, DM, DM, DM}; pg8::StaticOrder S; S.init(M, 2 * DFF, G, bx);
            pg8::EpiSwiGLU E{WSP(bf16, WS_BIG), DFF, WSP(float, WS_RSTD)};
            pg8::gemm_phase<pg8::EpiSwiGLU, pg8::StaticOrder, true, true>(lds, g, S, E);
        }
        SEAM(P + 13);
        if (EN(15) && IN(P + 14)) {
            PH_LOCALS
            pg8::Gemm g{WSP(bf16, WS_BIG), WSP(const bf16, WS_W + (size_t)l * W_LAYER + WO_D2), M, DM, DFF, DFF, DFF}; pg8::StaticOrder S; S.init(M, DM, G, bx);
            pg8::EpiBf16<0> E{WSP(bf16, WS_H), DM, nullptr, 0, 0, 1.f};
            pg8::gemm_phase<pg8::EpiBf16<0>, pg8::StaticOrder, true, true>(lds, g, S, E);
        }
        SEAM(P + 14);
        if (EN(16) && IN(P + 15)) { PH_LOCALS
            float* ro = args.probe ? WSP(float, WS_BIG + 170 * MiB) : WSP(float, WS_RSTD);
            if (l == NLAYER - 1) rowpass<false, true>(WSP(bf16, WS_XB), args.probe ? (void*)WSP(float, WS_BIG) : (void*)args.out, WSP(bf16, WS_H), INF(24) + (size_t)l * DM, 0.5f, ro, gw, NGW, lane);
            else rowpass<false, false>(WSP(bf16, WS_XB), args.probe ? WSP(bf16, WS_BIG) : WSP(bf16, WS_XB), WSP(bf16, WS_H), INF(24) + (size_t)l * DM, 0.5f, ro, gw, NGW, lane); }
        if (l != NLAYER - 1) SEAM(P + 15);
    }
#undef IN
#undef SEAM
}

extern "C" void kernel_launch(void* const* d_in, const int* in_sizes, int n_in, void* d_out, int out_size, void* d_ws, size_t ws_size, hipStream_t stream) {
    static int grid = 0;
    if (grid == 0) {
        if (n_in != 25 || out_size != M * DM || ws_size < WS_END) { fprintf(stderr, "kernel_launch: unexpected shapes (n_in %d out %d ws %zu)\n", n_in, out_size, ws_size); grid = -1; return; }
        int dev = 0, cus = 0, per_cu = 0;
        if (hipGetDevice(&dev) != hipSuccess || hipDeviceGetAttribute(&cus, hipDeviceAttributeMultiprocessorCount, dev) != hipSuccess) { grid = -1; return; }
        if (hipFuncSetAttribute((const void*)mk_fwd, hipFuncAttributeMaxDynamicSharedMemorySize, LDS_BYTES) != hipSuccess) { fprintf(stderr, "kernel_launch: hipFuncSetAttribute failed\n"); grid = -1; return; }
        if (hipOccupancyMaxActiveBlocksPerMultiprocessor(&per_cu, (const void*)mk_fwd, NWAVES * 64, LDS_BYTES) != hipSuccess || per_cu < 1) fprintf(stderr, "kernel_launch: occupancy query reports %d\n", per_cu);
        (void)hipGetLastError();
        grid = cus;
    }
    if (grid < 0) return;
    if (hipMemsetAsync((char*)d_ws + WS_CTL, 0, CTL_ZERO_BYTES, stream) != hipSuccess) return;
    Args a{};
    for (int i = 0; i < 25; ++i) a.in[i] = d_in[i];
    a.out = (float*)d_out; a.ws = (unsigned char*)d_ws;
#if MK_ONE_LAUNCH
    a.ph_lo = 0; a.ph_hi = N_PHASES;
    hipLaunchKernelGGL(mk_fwd, dim3(grid), dim3(NWAVES * 64), LDS_BYTES, stream, a);
#else
    for (int p = 0; p < N_PHASES; ++p) { a.ph_lo = p; a.ph_hi = p + 1;
#ifdef REP_MASK
        { const int k = p == 0 ? 0 : 1 + (p - 1) % PH_PER_LAYER; if (((REP_MASK) >> k) & 1) { a.probe = 1; hipLaunchKernelGGL(mk_fwd, dim3(grid), dim3(NWAVES * 64), LDS_BYTES, stream, a); a.probe = 0; } }
#endif
        hipLaunchKernelGGL(mk_fwd, dim3(grid), dim3(NWAVES * 64), LDS_BYTES, stream, a);
    }
#endif
}
```

```cpp
#include <hip/hip_runtime.h>
#include <cstdio>
#include <cstdint>

constexpr int NWAVES = 8;
constexpr int BATCH = 2, SEQ = 16384, DM = 1024, M = BATCH * SEQ, DFF = 2816, NIN = 3072, NLAYER = 2;
constexpr int DATT = 512, NGATE = 24, NSELB = 256, KTOP = 16;
constexpr float EPS = 1e-6f;
constexpr float C2 = 0.125f * 1.4426950408889634f;
constexpr size_t MiB = 1u << 20;
constexpr size_t WS_CTL = 0, CTL_ZERO_BYTES = 1 * MiB;
constexpr size_t WS_W = 2 * MiB, W_LAYER = 43 * MiB;
constexpr size_t WO_GU1 = 0, WO_D1 = 11 * MiB, WO_IN = 11 * MiB + 5632 * 1024, WO_O = WO_IN + 6 * MiB, WO_GU2 = WO_O + 2 * MiB, WO_D2 = WO_GU2 + 11 * MiB, WO_W1 = WO_D2 + 5632 * 1024;
static_assert(WO_W1 + 2 * MiB == W_LAYER, "weight map");
constexpr size_t WS_XB = 88 * MiB;
constexpr size_t WS_H = 152 * MiB;
constexpr size_t WS_BIG = 216 * MiB;
constexpr size_t WS_QRAW = WS_BIG, WS_QROT = WS_BIG + 32 * MiB, WS_OSLC = WS_BIG + 64 * MiB, WS_BG = WS_BIG + 96 * MiB, WS_CG = WS_BIG + 128 * MiB, WS_KRAW = WS_BIG + 160 * MiB, WS_VRAW = WS_KRAW + 8 * MiB;
constexpr size_t WS_XC = 392 * MiB, WS_KS_T = 424 * MiB, WS_KW_T = 432 * MiB, WS_VS_T = 440 * MiB, WS_VW_T = 448 * MiB, WS_GATES = 456 * MiB, WS_IDX = 460 * MiB, WS_HID = 464 * MiB;
constexpr size_t WS_KC_T = 472 * MiB, WS_VC_T = WS_KC_T + 512 * 1024, WS_ROPE = 473 * MiB, WS_RSTD = 475 * MiB, WS_BIAS = 476 * MiB, WS_BIASP = WS_BIAS + 64 * 1024, WS_KSN = WS_BIAS + 256 * 1024, WS_KWN = WS_KSN + 16 * 1024, WS_KCN = WS_KWN + 16 * 1024, WS_HIDP = 477 * MiB, WS_END = 509 * MiB;
constexpr size_t WS_VS_RM = WS_H, WS_VW_RM = WS_H + 8 * MiB, WS_SCORES = WS_H;
constexpr int CW_BAR = 4096;
constexpr int CW_KMAX = 64;

constexpr int RING_BYTES = 131072, MISC_OFF = RING_BYTES + 320, LDS_BYTES = 147456;

constexpr int PH_PER_LAYER = 16, N_PHASES = 1 + NLAYER * PH_PER_LAYER;
#ifndef PH_MASK
#define PH_MASK 0x1ffff
#endif
#define EN(k) (((PH_MASK) >> (k)) & 1)
#ifndef MK_ONE_LAUNCH
#define MK_ONE_LAUNCH 1
#endif

namespace pg8 {
#define PG8_LAS __attribute__((address_space(3)))
typedef unsigned short bf16_t;
typedef short bf16x8 __attribute__((ext_vector_type(8)));
typedef float f32x4 __attribute__((ext_vector_type(4)));
typedef unsigned u32x4 __attribute__((ext_vector_type(4)));
constexpr int BM = 256, BK = 64, HALF = 128, HTB = HALF * BK * 2  , STAGE_BYTES = 8 * HTB, NXCD = 8, WGM = 8;

__host__ __device__ __forceinline__ int lds_byte(int r, int c) { const int st = (r >> 4) * 2 + (c >> 5), rr = r & 15, cc = c & 31, ob = rr * 64 + cc * 2; return st * 1024 + (ob ^ (((ob >> 9) & 1) << 5)); }
__host__ __device__ __forceinline__ void stage_rc(int b, int& R, int& C) { const int st = b / 1024, sb = b % 1024, swz = sb ^ (((sb >> 9) & 1) << 5); R = (st >> 1) * 16 + swz / 64; C = (st & 1) * 32 + (swz % 64) / 2; }
__host__ __device__ __forceinline__ int perm32(int rho) { const int n = rho >> 4, i = rho & 15; return 8 * (i >> 2) + 4 * n + (i & 3); }

struct Unit { int pm, pn; };
struct Gemm { const bf16_t* A; const bf16_t* Bt; int M, N, K, lda, ldb; };

struct StaticOrder {
    int nM, nN, nwg, G, c;
    __host__ __device__ void init(int M, int N, int G_, int c_) { nM = M / BM; nN = N / BM; nwg = nM * nN; G = G_; c = c_; }
    __host__ __device__ bool next(int i, Unit& u) const {
        const long L = (long)i * G + c; if (L >= nwg) return false;
        int wgid = (int)L; { const int q = nwg / NXCD, r = nwg % NXCD, xcd = wgid % NXCD, off = wgid / NXCD; wgid = (xcd < r ? xcd * (q + 1) : r * (q + 1) + (xcd - r) * q) + off; }
        const int nig = WGM * nN, gid = wgid / nig, fm = gid * WGM, gsz = (nM - fm) < WGM ? (nM - fm) : WGM;
        u.pm = fm + ((wgid % nig) % gsz); u.pn = (wgid % nig) / gsz; return true;
    }
    __device__ __forceinline__ void a_ready(const Unit&) const {}
    __device__ __forceinline__ void done(const Unit&) const {}
};

__device__ __forceinline__ unsigned cvt_pk_bf16(float lo, float hi) { unsigned r; asm volatile("v_cvt_pk_bf16_f32 %0, %1, %2" : "=v"(r) : "v"(lo), "v"(hi)); return r; }
typedef float f32x2 __attribute__((ext_vector_type(2)));
__device__ __forceinline__ f32x2 gelu_pk(f32x2 v) {
    const f32x2 av = __builtin_elementwise_abs(v), d = av * 0.2316418882f + 1.0f;
    f32x2 t; t.x = __builtin_amdgcn_rcpf(d.x); t.y = __builtin_amdgcn_rcpf(d.y);
    f32x2 q = t * 0.5307027145f + (-0.7265760135f); q = q * t + 0.7107068705f; q = q * t + (-0.142248368f); q = q * t + 0.127414796f; q = q * t;
    const f32x2 s = (v * v) * (-0.72134752044f);
    f32x2 e; e.x = __builtin_amdgcn_exp2f(s.x); e.y = __builtin_amdgcn_exp2f(s.y);
    const f32x2 m = v * (q * e), r = v - m;
    f32x2 o; o.x = v.x < 0.f ? m.x : r.x; o.y = v.y < 0.f ? m.y : r.y; return o;
}

template <int ACT  > struct EpiBf16 {
    static constexpr bool PERM = true, AFTER_DRAIN = false; static_assert(ACT == 0 || ACT == 1, "EpiBf16: ACT is 0 (none) or 1 (gelu_pk)");
    bf16_t* O; int ldc; const float* bias; int split_cols; size_t split_stride; float scale0;
    __device__ __forceinline__ void operator()(const f32x4 (&acc)[2][2][4][2], const Unit& u, int wr, int wc, int fr, int fq) const {
        const int row0 = u.pm * BM + wr * 64 + fr; int colt = u.pn * BM; bf16_t* base = O;
        float sc = 1.f; if (split_cols) { const int t = colt / split_cols; base += (size_t)t * split_stride; colt -= t * split_cols; if (t == 0) sc = scale0; }
        const int col0 = colt + wc * 32 + 8 * fq, bcol0 = u.pn * BM + wc * 32 + 8 * fq;
        f32x4 bv[2][2];
#pragma unroll
        for (int bj = 0; bj < 2; ++bj)
#pragma unroll
            for (int n = 0; n < 2; ++n) bv[bj][n] = bias ? *(const f32x4*)(bias + bcol0 + bj * HALF + 4 * n) : (f32x4){0.f, 0.f, 0.f, 0.f};
#pragma unroll
        for (int ai = 0; ai < 2; ++ai)
#pragma unroll
            for (int m = 0; m < 4; ++m) { bf16_t* rowp = base + (size_t)(row0 + ai * HALF + m * 16) * ldc + col0;
#pragma unroll
                for (int bj = 0; bj < 2; ++bj) { f32x4 v0 = acc[ai][bj][m][0] + bv[bj][0], v1 = acc[ai][bj][m][1] + bv[bj][1];
                    if (ACT == 1) { f32x2 a = gelu_pk((f32x2){v0[0], v0[1]}), b = gelu_pk((f32x2){v0[2], v0[3]}), c = gelu_pk((f32x2){v1[0], v1[1]}), d = gelu_pk((f32x2){v1[2], v1[3]});
                        v0 = (f32x4){a.x, a.y, b.x, b.y}; v1 = (f32x4){c.x, c.y, d.x, d.y}; }
                    v0 = v0 * sc; v1 = v1 * sc; u32x4 w; w.x = cvt_pk_bf16(v0[0], v0[1]); w.y = cvt_pk_bf16(v0[2], v0[3]); w.z = cvt_pk_bf16(v1[0], v1[1]); w.w = cvt_pk_bf16(v1[2], v1[3]);
                    *(u32x4*)(rowp + bj * HALF) = w; } }
    }
};

constexpr int SEQ_ = SEQ;
__device__ __forceinline__ unsigned pk2c(float lo, float hi) { typedef float f2_t __attribute__((ext_vector_type(2))); typedef __bf16 b2_t __attribute__((ext_vector_type(2))); f2_t v = {lo, hi}; b2_t b = __builtin_convertvector(v, b2_t); return __builtin_bit_cast(unsigned, b); }
__device__ __forceinline__ void store8(bf16_t* dst, const f32x4& v0, const f32x4& v1) { u32x4 w; w.x = pk2c(v0[0], v0[1]); w.y = pk2c(v0[2], v0[3]); w.z = pk2c(v1[0], v1[1]); w.w = pk2c(v1[2], v1[3]); *(u32x4*)dst = w; }
__device__ __forceinline__ float silu_f(float x) { return x * __builtin_amdgcn_rcpf(1.0f + __builtin_amdgcn_exp2f(-1.4426950408889634f * x)); }
__device__ __forceinline__ float sigmoid_f(float x) { return __builtin_amdgcn_rcpf(1.0f + __builtin_amdgcn_exp2f(-1.4426950408889634f * x)); }

struct EpiSwiGLU {
    static constexpr bool PERM = true, AFTER_DRAIN = false;
    bf16_t* O; int ldc; const float* rstd;
    __device__ __forceinline__ void operator()(const f32x4 (&acc)[2][2][4][2], const Unit& u, int wr, int wc, int fr, int fq) const {
        const int row0 = u.pm * BM + wr * 64 + fr, col0 = u.pn * 128 + wc * 32 + 8 * fq;
#pragma unroll
        for (int ai = 0; ai < 2; ++ai)
#pragma unroll
            for (int m = 0; m < 4; ++m) { const int r = row0 + ai * HALF + m * 16; const float rs = rstd[r];
                const f32x4 g0 = acc[ai][0][m][0] * rs, g1 = acc[ai][0][m][1] * rs, u0 = acc[ai][1][m][0] * rs, u1 = acc[ai][1][m][1] * rs;
                f32x4 o0, o1;
#pragma unroll
                for (int j = 0; j < 4; ++j) { o0[j] = silu_f(g0[j]) * u0[j]; o1[j] = silu_f(g1[j]) * u1[j]; }
                store8(O + (size_t)r * ldc + col0, o0, o1); }
    }
};

struct EpiHid {
    static constexpr bool PERM = false, AFTER_DRAIN = false;
    float* C;
    __device__ __forceinline__ void operator()(const f32x4 (&acc)[2][2][4][2], const Unit& u, int wr, int wc, int fr, int fq) const {
        const int row0 = u.pm * BM + wr * 64 + fr, col0 = wc * 32 + 4 * fq;
#pragma unroll
        for (int ai = 0; ai < 2; ++ai)
#pragma unroll
            for (int m = 0; m < 4; ++m) { float* rowp = C + (size_t)(row0 + ai * HALF + m * 16) * 256 + col0;
#pragma unroll
                for (int bj = 0; bj < 2; ++bj)
#pragma unroll
                    for (int n = 0; n < 2; ++n) *(f32x4*)(rowp + bj * HALF + n * 16) = acc[ai][bj][m][n]; }
    }
};

__device__ __forceinline__ void rope8(f32x4& v0, f32x4& v1, const float* rope_row, int wc, int fq) {
    if ((wc & 1) == 0) {
        f32x4 o0, o1;
#pragma unroll
        for (int j = 0; j < 4; ++j) { o0[j] = __shfl_xor(v0[j], 16); o1[j] = __shfl_xor(v1[j], 16); }
        if (fq < 2) {
            const f32x4 c0 = *(const f32x4*)(rope_row), c1 = *(const f32x4*)(rope_row + 4), s0 = *(const f32x4*)(rope_row + 8), s1 = *(const f32x4*)(rope_row + 12);
            if (fq == 0) { v0 = v0 * c0 - o0 * s0; v1 = v1 * c1 - o1 * s1; }
            else         { v0 = v0 * c0 + o0 * s0; v1 = v1 * c1 + o1 * s1; }
        }
    }
}

struct EpiInProj {
    static constexpr bool PERM = true, AFTER_DRAIN = false;
    unsigned char* ws;
    __device__ __forceinline__ void operator()(const f32x4 (&acc)[2][2][4][2], const Unit& u, int wr, int wc, int fr, int fq) const {
        const float* rstd = (const float*)(ws + WS_RSTD); const float* rope = (const float*)(ws + WS_ROPE);
        bf16_t* qraw = (bf16_t*)(ws + WS_QRAW); bf16_t* qrot = (bf16_t*)(ws + WS_QROT); bf16_t* kraw = (bf16_t*)(ws + WS_KRAW); bf16_t* vraw = (bf16_t*)(ws + WS_VRAW);
        bf16_t* ks_t = (bf16_t*)(ws + WS_KS_T); bf16_t* vs_rm = (bf16_t*)(ws + WS_VS_RM); bf16_t* kw_t = (bf16_t*)(ws + WS_KW_T); bf16_t* vw_rm = (bf16_t*)(ws + WS_VW_RM);
        bf16_t* bg = (bf16_t*)(ws + WS_BG); bf16_t* cg = (bf16_t*)(ws + WS_CG); bf16_t* xc = (bf16_t*)(ws + WS_XC); float* gates = (float*)(ws + WS_GATES);
        const int pn = u.pn, row0 = u.pm * BM + wr * 64 + fr;
#pragma unroll
        for (int ai = 0; ai < 2; ++ai)
#pragma unroll
            for (int m = 0; m < 4; ++m) {
                const int r = row0 + ai * HALF + m * 16; const float rs = rstd[r];
                const int b = r >> 14, s = r & (SEQ_ - 1);
                const float* rrow = rope + (size_t)r * 16;
#pragma unroll
                for (int bj = 0; bj < 2; ++bj) {
                    f32x4 v0 = acc[ai][bj][m][0] * rs, v1 = acc[ai][bj][m][1] * rs;
                    const int ct = bj * HALF + wc * 32 + 8 * fq;
                    const int c = wc * 32 + 8 * fq, g = c >> 6, d0 = c & 63;
                    if (pn <= 1) {
                        const size_t o = (size_t)r * 512 + pn * 256 + ct;
                        store8(qraw + o, v0, v1);
                        rope8(v0, v1, rrow, wc, fq);
                        store8(qrot + o, v0, v1);
                    } else if (pn == 2) {
                        bf16_t* dst = (bj == 0 ? kraw : vraw) + ((size_t)((b * 2 + g) * SEQ_ + s)) * 64 + d0;
                        store8(dst, v0, v1);
                    } else if (pn <= 4) {
                        if (bj == 0) {
                            rope8(v0, v1, rrow, wc, fq);
                            if (pn == 3) {
                                unsigned char* base8 = (unsigned char*)ks_t + (size_t)(b * 2 + g) * SEQ_ * 64;
                                const int off8 = ((s >> 4) * 64 + ((d0 & 31) >> 3) * 16 + (s & 15)) * 16 + (d0 >> 5) * 8;
                                int w0 = __builtin_amdgcn_cvt_pk_fp8_f32(v0[0], v0[1], 0, false); w0 = __builtin_amdgcn_cvt_pk_fp8_f32(v0[2], v0[3], w0, true);
                                int w1 = __builtin_amdgcn_cvt_pk_fp8_f32(v1[0], v1[1], 0, false); w1 = __builtin_amdgcn_cvt_pk_fp8_f32(v1[2], v1[3], w1, true);
                                typedef unsigned u32x2_t __attribute__((ext_vector_type(2)));
                                *(u32x2_t*)(base8 + off8) = (u32x2_t){(unsigned)w0, (unsigned)w1};
                            } else {
                            bf16_t* base = kw_t + (size_t)(b * 2 + g) * SEQ_ * 64;
                            const int off = (((s >> 4) * 2 + (d0 >> 5)) * 64 + ((d0 & 31) >> 3) * 16 + (s & 15)) * 8;
                            store8(base + off, v0, v1);
                            }
                        } else {
                            bf16_t* dst = (pn == 3 ? vs_rm : vw_rm) + ((size_t)((b * 2 + g) * SEQ_ + s)) * 64 + d0;
                            store8(dst, v0, v1);
                        }
                    } else if (pn <= 10) {
                        bf16_t* base = pn <= 6 ? bg : (pn <= 8 ? cg : xc);
                        store8(base + (size_t)r * 512 + ((pn - 5) & 1) * 256 + ct, v0, v1);
                    } else {
                        if (bj == 0 && wc == 0 && fq < 3) {
                            f32x4 a, bb;
#pragma unroll
                            for (int j = 0; j < 4; ++j) { a[j] = sigmoid_f(v0[j]); bb[j] = sigmoid_f(v1[j]); }
                            float* dst = gates + (size_t)r * 24 + 8 * fq;
                            *(f32x4*)dst = a; *(f32x4*)(dst + 4) = bb;
                        }
                    }
                }
            }
    }
};

struct CmpOrder {
    int G, c;
    __device__ __forceinline__ bool next(int i, Unit& u) const { const int L = i * G + c; if (L >= 32) return false; u.pm = L; u.pn = L >> 4; return true; }
    __device__ __forceinline__ void a_ready(const Unit&) const {}
    __device__ __forceinline__ void done(const Unit&) const {}
};
template <class Epi, class Sched, bool ALIGN_EPI = false, bool SP2 = false>
__device__ __forceinline__ void gemm_phase(PG8_LAS unsigned char* lds, const Gemm g, const Sched& S, const Epi& E) {
    int tid_ = threadIdx.x; asm volatile("" : "+v"(tid_));
    const int tid = tid_, wid = __builtin_amdgcn_readfirstlane(tid >> 6), lane = tid & 63, wr = wid >> 2, wc = wid & 3, fr = lane & 15, fq = lane >> 4;
    const int K = g.K, nt = K / BK;
    unsigned voffA[2], voffB[2];
#pragma unroll
    for (int i = 0; i < 2; ++i) { int R, C; stage_rc(tid * 16 + i * 8192, R, C); const int Rb = Epi::PERM ? ((R & ~31) + perm32(R & 31)) : R;
        voffA[i] = (unsigned)(R * g.lda + C) * 2u; voffB[i] = (unsigned)(Rb * g.ldb + C) * 2u; }
    const size_t kstep = (size_t)(BK * 2);
    const size_t hstepA = (size_t)HALF * g.lda * 2, hstepB = (size_t)HALF * g.ldb * 2;
    const size_t tstepA = 2 * hstepA, tstepB = 2 * hstepB;
    const unsigned ldsw = (unsigned)wid * 1024u;
    const int aoff = lds_byte(wr * 64 + fr, fq * 8), boff = lds_byte(wc * 32 + fr, fq * 8);
#define PG8_SA(b, h) (((b) * 2 + (h)) * HTB)
#define PG8_SB(b, h) ((4 + (b) * 2 + (h)) * HTB)
#define PG8_STAGE(bufoff, gbase, voff) do { _Pragma("unroll") for (int _i = 0; _i < 2; ++_i) \
        __builtin_amdgcn_global_load_lds((const unsigned*)((const char*)(gbase) + (voff)[_i]), (PG8_LAS unsigned*)(lds + (bufoff) + ldsw + _i * 8192), 16, 0, 0); } while (0)
#define PG8_LDA(dst, b, h) do { _Pragma("unroll") for (int m = 0; m < 4; ++m) _Pragma("unroll") for (int k = 0; k < 2; ++k) dst[m][k] = *(const PG8_LAS bf16x8*)(lds + PG8_SA(b, h) + aoff + m * 2048 + k * 1024); } while (0)
#define PG8_LDB(dst, b, h) do { _Pragma("unroll") for (int n = 0; n < 2; ++n) _Pragma("unroll") for (int k = 0; k < 2; ++k) dst[n][k] = *(const PG8_LAS bf16x8*)(lds + PG8_SB(b, h) + boff + n * 2048 + k * 1024); } while (0)
#define PG8_MMA(ai, bj, At, Bt) do { __builtin_amdgcn_s_setprio(1); _Pragma("unroll") for (int m = 0; m < 4; ++m) _Pragma("unroll") for (int n = 0; n < 2; ++n) _Pragma("unroll") for (int k = 0; k < 2; ++k) \
        acc[ai][bj][m][n] = __builtin_amdgcn_mfma_f32_16x16x32_bf16(Bt[n][k], At[m][k], acc[ai][bj][m][n], 0, 0, 0); __builtin_amdgcn_s_setprio(0); } while (0)
#define PG8_WAIT_V(n) asm volatile("s_waitcnt vmcnt(" #n ")" ::: "memory")
#define PG8_WAIT_L(n) asm volatile("s_waitcnt lgkmcnt(" #n ")" ::: "memory")
#define PG8_BAR __builtin_amdgcn_s_barrier()
#define PG8_SCHED __builtin_amdgcn_sched_barrier(0)
    Unit cur, nxt; int ui = 0;
    if (!S.next(0, cur)) return;
    f32x4 acc[2][2][4][2];
#pragma unroll
    for (int a = 0; a < 2; ++a)
#pragma unroll
        for (int b = 0; b < 2; ++b)
#pragma unroll
            for (int m = 0; m < 4; ++m)
#pragma unroll
                for (int n = 0; n < 2; ++n) acc[a][b][m][n] = (f32x4){0.f, 0.f, 0.f, 0.f};
    bf16x8 At[4][2], B0[2][2], B1[2][2];
    const char* cA = (const char*)g.A + (size_t)cur.pm * tstepA; const char* cB = (const char*)g.Bt + (size_t)cur.pn * tstepB;
    S.a_ready(cur);
    if constexpr (SP2) {
        PG8_STAGE(PG8_SB(0, 0), cB, voffB); PG8_STAGE(PG8_SB(0, 1), cB + hstepB, voffB); PG8_STAGE(PG8_SA(0, 0), cA, voffA); PG8_STAGE(PG8_SA(0, 1), cA + hstepA, voffA);
        if (wr == 1) PG8_BAR;
        PG8_WAIT_V(2); PG8_BAR;
        PG8_STAGE(PG8_SB(1, 0), cB + kstep, voffB); PG8_STAGE(PG8_SA(1, 0), cA + kstep, voffA); PG8_STAGE(PG8_SB(1, 1), cB + hstepB + kstep, voffB);
        PG8_WAIT_V(6); PG8_BAR;
    } else {
        PG8_STAGE(PG8_SB(0, 0), cB, voffB); PG8_STAGE(PG8_SA(0, 0), cA, voffA); PG8_STAGE(PG8_SB(0, 1), cB + hstepB, voffB); PG8_STAGE(PG8_SA(0, 1), cA + hstepA, voffA);
        if (wr == 1) PG8_BAR;
        PG8_WAIT_V(4); PG8_BAR;
        PG8_STAGE(PG8_SB(1, 0), cB + kstep, voffB); PG8_STAGE(PG8_SA(1, 0), cA + kstep, voffA); PG8_STAGE(PG8_SB(1, 1), cB + hstepB + kstep, voffB);
        PG8_WAIT_V(6); PG8_BAR;
    }
    for (;;) {
        const bool has_next = S.next(ui + 1, nxt);
        const char* nA = has_next ? (const char*)g.A + (size_t)nxt.pm * tstepA : cA; const char* nB = has_next ? (const char*)g.Bt + (size_t)nxt.pn * tstepB : cB;
        for (int t = 0; t < nt; t += 2) {
            const bool last = (t == nt - 2);
            const char* a1 = cA + (size_t)(t + 1) * kstep;
            const char* a2 = last ? nA : cA + (size_t)(t + 2) * kstep; const char* b2 = last ? nB : cB + (size_t)(t + 2) * kstep;
            const char* a3 = a2 + kstep; const char* b3 = b2 + kstep;
            if (last && has_next) S.a_ready(nxt);
            if constexpr (SP2) {
            PG8_LDB(B0, 0, 0); PG8_LDB(B1, 0, 1); PG8_SCHED; PG8_LDA(At, 0, 0); PG8_STAGE(PG8_SA(1, 1), a1 + hstepA, voffA);
            PG8_WAIT_V(8); PG8_WAIT_L(0); PG8_BAR; PG8_MMA(0, 0, At, B0); PG8_MMA(0, 1, At, B1); PG8_BAR; PG8_SCHED;
            PG8_LDA(At, 0, 1); PG8_STAGE(PG8_SB(0, 0), b2, voffB); PG8_STAGE(PG8_SB(0, 1), b2 + hstepB, voffB); PG8_STAGE(PG8_SA(0, 0), a2, voffA);
            PG8_WAIT_V(8); PG8_WAIT_L(0); PG8_BAR; PG8_MMA(1, 0, At, B0); PG8_MMA(1, 1, At, B1); PG8_BAR; PG8_SCHED;
            PG8_LDB(B0, 1, 0); PG8_LDB(B1, 1, 1); PG8_SCHED; PG8_LDA(At, 1, 0); PG8_STAGE(PG8_SA(0, 1), a2 + hstepA, voffA);
            PG8_WAIT_V(8); PG8_WAIT_L(0); PG8_BAR; PG8_MMA(0, 0, At, B0); PG8_MMA(0, 1, At, B1); PG8_BAR; PG8_SCHED;
            PG8_LDA(At, 1, 1); PG8_STAGE(PG8_SB(1, 0), b3, voffB); PG8_STAGE(PG8_SB(1, 1), b3 + hstepB, voffB); PG8_STAGE(PG8_SA(1, 0), a3, voffA);
            PG8_WAIT_V(8); PG8_WAIT_L(0); PG8_BAR; PG8_MMA(1, 0, At, B0); PG8_MMA(1, 1, At, B1); PG8_BAR; PG8_SCHED;
            } else {
            PG8_LDB(B0, 0, 0); PG8_SCHED; PG8_LDA(At, 0, 0); PG8_STAGE(PG8_SA(1, 1), a1 + hstepA, voffA);
            PG8_WAIT_L(8); PG8_BAR; PG8_WAIT_L(0); PG8_MMA(0, 0, At, B0); PG8_BAR; PG8_SCHED;
            PG8_LDB(B1, 0, 1); PG8_STAGE(PG8_SB(0, 0), b2, voffB);
            PG8_BAR; PG8_WAIT_L(0); PG8_MMA(0, 1, At, B1); PG8_BAR;
            PG8_LDA(At, 0, 1); PG8_STAGE(PG8_SA(0, 0), a2, voffA);
            PG8_BAR; PG8_WAIT_L(0); PG8_MMA(1, 0, At, B0); PG8_BAR; PG8_SCHED;
            PG8_STAGE(PG8_SB(0, 1), b2 + hstepB, voffB);
            PG8_WAIT_V(6); PG8_BAR; PG8_MMA(1, 1, At, B1); PG8_BAR;
            PG8_LDB(B0, 1, 0); PG8_SCHED; PG8_LDA(At, 1, 0); PG8_STAGE(PG8_SA(0, 1), a2 + hstepA, voffA);
            PG8_WAIT_L(8); PG8_BAR; PG8_WAIT_L(0); PG8_MMA(0, 0, At, B0); PG8_BAR; PG8_SCHED;
            PG8_LDB(B1, 1, 1); PG8_STAGE(PG8_SB(1, 0), b3, voffB);
            PG8_BAR; PG8_WAIT_L(0); PG8_MMA(0, 1, At, B1); PG8_BAR;
            PG8_LDA(At, 1, 1); PG8_STAGE(PG8_SA(1, 0), a3, voffA);
            PG8_BAR; PG8_WAIT_L(0); PG8_MMA(1, 0, At, B0); PG8_BAR; PG8_SCHED;
            PG8_STAGE(PG8_SB(1, 1), b3 + hstepB, voffB);
            PG8_WAIT_V(6); PG8_BAR; PG8_MMA(1, 1, At, B1); PG8_BAR;
            }
        }
        if constexpr (ALIGN_EPI) { if (wr == 0) PG8_BAR; }
        if constexpr (!Epi::AFTER_DRAIN) { E(acc, cur, wr, wc, fr, fq); S.done(cur); }
        if (!has_next) break;
#pragma unroll
        for (int a = 0; a < 2; ++a)
#pragma unroll
            for (int b = 0; b < 2; ++b)
#pragma unroll
                for (int m = 0; m < 4; ++m)
#pragma unroll
                    for (int n = 0; n < 2; ++n) acc[a][b][m][n] = (f32x4){0.f, 0.f, 0.f, 0.f};
        cur = nxt; cA = nA; cB = nB; ++ui;
        if constexpr (ALIGN_EPI) { if (wr == 1) PG8_BAR; }
    }
    PG8_WAIT_V(0);
    if constexpr (!ALIGN_EPI) { if (wr == 0) PG8_BAR; }
    PG8_BAR;
    if constexpr (Epi::AFTER_DRAIN) { E.fused(acc, cur, wr, wc, fr, fq, lds, wid, lane); S.done(cur); }
#undef PG8_SA
#undef PG8_SB
#undef PG8_STAGE
#undef PG8_LDA
#undef PG8_LDB
#undef PG8_MMA
#undef PG8_WAIT_V
#undef PG8_WAIT_L
#undef PG8_BAR
#undef PG8_SCHED
}
}
#define GAS __attribute__((address_space(1)))
#define LAS __attribute__((address_space(3)))
typedef unsigned short bf16;
typedef unsigned v4u __attribute__((ext_vector_type(4)));
typedef float f32x4 __attribute__((ext_vector_type(4)));
typedef short bf16x8 __attribute__((ext_vector_type(8)));
typedef GAS unsigned gu32;
typedef GAS unsigned long long gu64;
#define RLX_AGENT __ATOMIC_RELAXED, __HIP_MEMORY_SCOPE_AGENT
#define LDS_WAIT() asm volatile("s_waitcnt lgkmcnt(0)" ::: "memory")
#define VM_WAIT() asm volatile("s_waitcnt vmcnt(0)" ::: "memory")
__device__ __forceinline__ unsigned long long rt() { return __builtin_amdgcn_s_memrealtime(); }
__device__ __forceinline__ unsigned f2bf(float f) { unsigned u = __builtin_bit_cast(unsigned, f); return (u + 0x7fffu + ((u >> 16) & 1u)) >> 16; }
__device__ __forceinline__ unsigned pk2(float lo, float hi) { return f2bf(lo) | (f2bf(hi) << 16); }

#define XB_TMO      128
#define XB_XCNT(j)  (256  + 64 * (j))
#define XB_XSUB(j)  (1280 + 64 * (j))
#define XB_XGEN(j)  (2304 + 64 * (j))
#define XB_TOP      3328
#define XB_TOPGEN   3392
#define XCD_BAR_WORDS 3456
#define XB_SPIN_CAP (1u << 18)

__device__ __forceinline__ unsigned xb_ld(unsigned* p)              { return __hip_atomic_load(p, __ATOMIC_RELAXED, __HIP_MEMORY_SCOPE_AGENT); }
__device__ __forceinline__ unsigned xb_add(unsigned* p, unsigned v) { return __hip_atomic_fetch_add(p, v, __ATOMIC_RELAXED, __HIP_MEMORY_SCOPE_AGENT); }
__device__ __forceinline__ unsigned xb_xcc_id() { return (unsigned)__builtin_amdgcn_s_getreg((3 << 11) | 20) & 0xFu; }
#define XB_SPIN(cond, bar) do { unsigned _sp = 0; while (cond) { __builtin_amdgcn_s_sleep(1); \
    if ((++_sp & 255u) == 0u) { if (xb_ld(&(bar)[XB_TMO])) break; if (_sp > XB_SPIN_CAP) { atomicAdd(&(bar)[XB_TMO], 1u); break; } } } } while (0)

struct XcdBarrier {
    unsigned* bar; unsigned x;
    volatile LAS unsigned* st;
};

__device__ __forceinline__ XcdBarrier xcd_barrier_post(unsigned* bar, volatile LAS unsigned* st) {
    XcdBarrier b; b.bar = bar; b.x = xb_xcc_id(); b.st = st;
    if (threadIdx.x == 0) (void)xb_add(&bar[XB_XCNT(b.x)], 1u);
    return b;
}
__device__ __forceinline__ void xcd_barrier_complete(unsigned* bar, unsigned x, unsigned& nloc, unsigned& nx) {
    const unsigned G = gridDim.x * gridDim.y * gridDim.z;
    unsigned sum, cnt, mine, sp = 0u;
    for (;;) {
        sum = 0u; cnt = 0u; mine = 0u;
#pragma unroll
        for (unsigned j = 0; j < 16; ++j) { const unsigned c = xb_ld(&bar[XB_XCNT(j)]); sum += c; cnt += (c > 0u) ? 1u : 0u; mine = (j == x) ? c : mine; }
        if (sum == G) break;
        __builtin_amdgcn_s_sleep(1);
        if ((++sp & 255u) == 0u) { if (xb_ld(&bar[XB_TMO])) break; if (sp > XB_SPIN_CAP) { atomicAdd(&bar[XB_TMO], 1u); break; } }
    }
    nloc = mine > 0u ? mine : 1u; nx = cnt > 0u ? cnt : 1u;
}

__device__ __forceinline__ void xcd_barrier(const XcdBarrier& b) {
    asm volatile("s_waitcnt vmcnt(0)" ::: "memory");
    __syncthreads();
    int tz_ = threadIdx.x; asm volatile("" : "+v"(tz_));
    if (tz_ == 0) {
        unsigned* bar = b.bar;
        __builtin_amdgcn_s_waitcnt(0);
        unsigned nloc = b.st[0], nx = b.st[1];
        if (nloc == 0u) { xcd_barrier_complete(bar, b.x, nloc, nx); b.st[0] = nloc; b.st[1] = nx; }
        const unsigned old = xb_add(&bar[XB_XSUB(b.x)], 1u);
        const unsigned gen = old / nloc;
        if (old + 1u == (gen + 1u) * nloc) {
            __builtin_amdgcn_fence(__ATOMIC_RELEASE, "agent");
            asm volatile("s_waitcnt vmcnt(0)" ::: "memory");
            const unsigned og = xb_add(&bar[XB_TOP], 1u);
            const unsigned tg = og / nx;
            if (og + 1u == (tg + 1u) * nx) xb_add(&bar[XB_TOPGEN], 1u);
            else XB_SPIN(xb_ld(&bar[XB_TOPGEN]) == tg, bar);
            __builtin_amdgcn_fence(__ATOMIC_ACQUIRE, "agent");
            xb_add(&bar[XB_XGEN(b.x)], 1u);
            asm volatile("s_waitcnt vmcnt(0)" ::: "memory");
        } else {
            XB_SPIN(xb_ld(&bar[XB_XGEN(b.x)]) == gen, bar);
            __builtin_amdgcn_fence(__ATOMIC_ACQUIRE, "agent");
            asm volatile("s_waitcnt vmcnt(0)" ::: "memory");
        }
    }
    __syncthreads();
}

typedef float f32x2 __attribute__((ext_vector_type(2)));
typedef unsigned v2u __attribute__((ext_vector_type(2)));
__device__ __forceinline__ unsigned pkc(float lo, float hi) { return pg8::pk2c(lo, hi); }
__device__ __forceinline__ float bf_lo(unsigned w) { return __uint_as_float(w << 16); }
__device__ __forceinline__ float bf_hi(unsigned w) { return __uint_as_float(w & 0xffff0000u); }
__device__ __forceinline__ float wave_sum(float v) {
#pragma unroll
    for (int o = 1; o < 64; o <<= 1) v += __shfl_xor(v, o);
    return v;
}
__device__ __forceinline__ f32x4 mfma16(bf16x8 a, bf16x8 b, f32x4 c) { return __builtin_amdgcn_mfma_f32_16x16x32_bf16(a, b, c, 0, 0, 0); }
__device__ __forceinline__ float ex2(float x) { return __builtin_amdgcn_exp2f(x); }
__device__ __forceinline__ bf16x8 pack8(const f32x4& a, const f32x4& b) { v4u w; w.x = pkc(a[0], a[1]); w.y = pkc(a[2], a[3]); w.z = pkc(b[0], b[1]); w.w = pkc(b[2], b[3]); return __builtin_bit_cast(bf16x8, w); }

__device__ __forceinline__ void tr_item(const float* W, int ldw, int col0, int nvalid, const float* gain, bf16* WT, int ldt, int drow0, LAS float* scr, int kb, int n0, int lane) {
    const int k0 = 64 * kb;
#pragma unroll
    for (int i = 0; i < 32; ++i) { const int kk = 2 * i + (lane >> 5), n = n0 + (lane & 31);
        float v = (n < nvalid) ? W[(size_t)(k0 + kk) * ldw + col0 + n] : 0.f; if (gain) v *= gain[k0 + kk];
        scr[kk * 33 + (lane & 31)] = v; }
    LDS_WAIT(); asm volatile("" ::: "memory");
    const int c = lane & 7;
#pragma unroll
    for (int j = 0; j < 4; ++j) { const int n = (lane >> 3) + 8 * j; const LAS float* s = scr + (8 * c) * 33 + n;
        v4u o; o.x = pkc(s[0 * 33], s[1 * 33]); o.y = pkc(s[2 * 33], s[3 * 33]); o.z = pkc(s[4 * 33], s[5 * 33]); o.w = pkc(s[6 * 33], s[7 * 33]);
        *(GAS v4u*)(WT + (size_t)(drow0 + n) * ldt + k0 + 8 * c) = o; }
    LDS_WAIT(); asm volatile("" ::: "memory");
}

struct In {
    const float *x; const int* pos;
    const float *f1_pre, *f1_wg, *f1_wu, *f1_wd, *f1_post, *mix_pre, *w_in, *pe_k, *w1_k, *w2_k, *pe_v, *w1_v, *w2_v, *conv_w, *aon, *con, *w_out, *mix_post, *f2_pre, *f2_wg, *f2_wu, *f2_wd, *f2_post;
};

__device__ __forceinline__ void pro_weights(const In& I, unsigned char* ws, LAS float* scr, int gw, int NGW, int lane) {
    constexpr int I_GU = 16 * 88, I_D = 44 * 32, I_INM = 16 * 40, I_ING = 16, I_INC = 16 * 16, I_O = 16 * 32, I_W1 = 32 * 8;
    constexpr int PER_LAYER = 4 * I_GU + 2 * I_D + I_INM + I_ING + 3 * I_INC + I_O + 2 * I_W1;
    for (int it = gw; it < NLAYER * PER_LAYER; it += NGW) {
        const int l = it / PER_LAYER; int r = it % PER_LAYER;
        unsigned char* wl = ws + WS_W + (size_t)l * W_LAYER;
        if (r < I_GU) { const int kb = r / 88, n0 = 32 * (r % 88); tr_item(I.f1_wg + (size_t)l * DM * DFF, DFF, 0, DFF, I.f1_pre + (size_t)l * DM, (bf16*)(wl + WO_GU1), DM, (n0 >> 7) * 256 + (n0 & 127), scr, kb, n0, lane); continue; } r -= I_GU;
        if (r < I_GU) { const int kb = r / 88, n0 = 32 * (r % 88); tr_item(I.f1_wu + (size_t)l * DM * DFF, DFF, 0, DFF, I.f1_pre + (size_t)l * DM, (bf16*)(wl + WO_GU1), DM, (n0 >> 7) * 256 + (n0 & 127) + 128, scr, kb, n0, lane); continue; } r -= I_GU;
        if (r < I_D) { const int kb = r / 32, n0 = 32 * (r % 32); tr_item(I.f1_wd + (size_t)l * DFF * DM, DM, 0, DM, nullptr, (bf16*)(wl + WO_D1), DFF, n0, scr, kb, n0, lane); continue; } r -= I_D;
        if (r < I_GU) { const int kb = r / 88, n0 = 32 * (r % 88); tr_item(I.f2_wg + (size_t)l * DM * DFF, DFF, 0, DFF, I.f2_pre + (size_t)l * DM, (bf16*)(wl + WO_GU2), DM, (n0 >> 7) * 256 + (n0 & 127), scr, kb, n0, lane); continue; } r -= I_GU;
        if (r < I_GU) { const int kb = r / 88, n0 = 32 * (r % 88); tr_item(I.f2_wu + (size_t)l * DM * DFF, DFF, 0, DFF, I.f2_pre + (size_t)l * DM, (bf16*)(wl + WO_GU2), DM, (n0 >> 7) * 256 + (n0 & 127) + 128, scr, kb, n0, lane); continue; } r -= I_GU;
        if (r < I_D) { const int kb = r / 32, n0 = 32 * (r % 32); tr_item(I.f2_wd + (size_t)l * DFF * DM, DM, 0, DM, nullptr, (bf16*)(wl + WO_D2), DFF, n0, scr, kb, n0, lane); continue; } r -= I_D;
        const float* Win = I.w_in + (size_t)l * DM * 2840; const float* mpre = I.mix_pre + (size_t)l * DM; bf16* WI = (bf16*)(wl + WO_IN);
        if (r < I_INM) { const int kb = r / 40, n0 = 32 * (r % 40); tr_item(Win, 2840, 0, 1280, mpre, WI, DM, n0, scr, kb, n0, lane); continue; } r -= I_INM;
        if (r < I_ING) { tr_item(Win, 2840, 1280, 24, mpre, WI, DM, 2816, scr, r, 0, lane); continue; } r -= I_ING;
        if (r < I_INC) { const int kb = r / 16, n0 = 32 * (r % 16); tr_item(Win, 2840, 1304, 512, mpre, WI, DM, 1280 + n0, scr, kb, n0, lane); continue; } r -= I_INC;
        if (r < I_INC) { const int kb = r / 16, n0 = 32 * (r % 16); tr_item(Win, 2840, 1816, 512, mpre, WI, DM, 1792 + n0, scr, kb, n0, lane); continue; } r -= I_INC;
        if (r < I_INC) { const int kb = r / 16, n0 = 32 * (r % 16); tr_item(Win, 2840, 2328, 512, mpre, WI, DM, 2304 + n0, scr, kb, n0, lane); continue; } r -= I_INC;
        if (r < I_O) { const int kb = r / 32, n0 = 32 * (r % 32);
            const float* gn = (kb < 8) ? (I.aon + (size_t)l * 512) : (I.con + (size_t)l * 512 - 512);
            tr_item(I.w_out + (size_t)l * DM * DM, DM, 0, DM, gn, (bf16*)(wl + WO_O), DM, n0, scr, kb, n0, lane); continue; } r -= I_O;
        if (r < I_W1) { const int kb = r / 8, n0 = 32 * (r % 8); tr_item(I.w1_k + (size_t)l * 2048 * 256, 256, 0, 256, nullptr, (bf16*)(wl + WO_W1), 2048, n0, scr, kb, n0, lane); continue; } r -= I_W1;
        { const int kb = r / 8, n0 = 32 * (r % 8); tr_item(I.w1_v + (size_t)l * 2048 * 256, 256, 0, 256, nullptr, (bf16*)(wl + WO_W1), 2048, 256 + n0, scr, kb, n0, lane); }
    }
    for (int i = gw * 64 + lane; i < NLAYER * 28672; i += NGW * 64) { const int l = i / 28672, q = i % 28672;
        *(GAS v4u*)(ws + WS_W + (size_t)l * W_LAYER + WO_IN + (size_t)2848 * DM * 2 + (size_t)q * 16) = (v4u){0u, 0u, 0u, 0u}; }
    for (int j = gw; j < 256; j += NGW) { const int vec = j >> 6, c = ((j >> 4) & 3) * 64 + lane, kc = j & 15, l = vec >> 1, kv = vec & 1;
        const float* pe = (kv == 0 ? I.pe_k : I.pe_v) + (size_t)l * 2048 + 128 * kc; const float* w1 = (kv == 0 ? I.w1_k : I.w1_v) + (size_t)l * 2048 * 256 + (size_t)128 * kc * 256;
        float s0 = 0.f, s1 = 0.f, s2 = 0.f, s3 = 0.f;
#pragma unroll 8
        for (int k = 0; k < 128; k += 4) { s0 += pe[k] * w1[(size_t)k * 256 + c]; s1 += pe[k + 1] * w1[(size_t)(k + 1) * 256 + c]; s2 += pe[k + 2] * w1[(size_t)(k + 2) * 256 + c]; s3 += pe[k + 3] * w1[(size_t)(k + 3) * 256 + c]; }
        ((float*)(ws + WS_BIASP))[(kc * 4 + vec) * 256 + c] = (s0 + s1) + (s2 + s3); }
}

__device__ __forceinline__ void pro_rope(const int* pos, float* rope, int gtid, int nthreads) {
    const double invf[8] = {1.0, 0.19392274474868576, 0.03760603093086393, 0.007292664737217109, 0.001414213562373095, 0.0002742481756762073, 5.318295896944988e-05, 1.031338537721246e-05};
    for (int e = gtid; e < M * 8; e += nthreads) { const int row = e >> 3, i = e & 7;
        double f = 1.0;
#pragma unroll
        for (int q = 0; q < 8; ++q) f = (i == q) ? invf[q] : f;
        const double ang = (double)pos[row] * f;
        const double k = __builtin_rint(ang * 0.15915494309189535);
        const double red = __builtin_fma(-k, 1.2246467991473532e-16 * 2.0, __builtin_fma(-k, 6.283185307179586, ang));
        const float rf = (float)red;
        rope[(size_t)row * 16 + i] = cosf(rf); rope[(size_t)row * 16 + 8 + i] = sinf(rf); }
}

__device__ __forceinline__ void pro_x(const float* x, bf16* xb, float* rstd, int gw, int NGW, int lane) {
    constexpr int R = 4;
    for (int row0 = gw * R; row0 < M; row0 += NGW * R) {
        f32x4 v[R][4]; float s[R];
#pragma unroll
        for (int r = 0; r < R; ++r) { const GAS f32x4* xr = (const GAS f32x4*)(x + (size_t)(row0 + r) * DM) + lane;
#pragma unroll
            for (int j = 0; j < 4; ++j) v[r][j] = xr[64 * j]; }
#pragma unroll
        for (int r = 0; r < R; ++r) { s[r] = 0.f; GAS v2u* o8 = (GAS v2u*)(xb + (size_t)(row0 + r) * DM) + lane;
#pragma unroll
            for (int j = 0; j < 4; ++j) { s[r] += (v[r][j].x * v[r][j].x + v[r][j].y * v[r][j].y) + (v[r][j].z * v[r][j].z + v[r][j].w * v[r][j].w); o8[64 * j] = (v2u){pkc(v[r][j].x, v[r][j].y), pkc(v[r][j].z, v[r][j].w)}; } }
#pragma unroll
        for (int o = 1; o < 64; o <<= 1) {
#pragma unroll
            for (int r = 0; r < R; ++r) s[r] += __shfl_xor(s[r], o); }
        if (lane < R) { float vv = s[0];
#pragma unroll
            for (int r = 1; r < R; ++r) vv = (lane == r) ? s[r] : vv;
            rstd[row0 + lane] = 1.0f / sqrtf(vv * (1.0f / DM) + EPS); }
    }
}

template <bool XIN_F32, bool OUT_F32>
__device__ __forceinline__ void rowpass(const void* xin, void* xout, const bf16* h, const float* gpost, float scale, float* rstd, int gw, int NGW, int lane) {
    constexpr int R = 4;
    f32x4 gv[4];
#pragma unroll
    for (int j = 0; j < 4; ++j) gv[j] = *((const GAS f32x4*)gpost + lane + 64 * j);
    for (int row0 = gw * R; row0 < M; row0 += NGW * R) {
        f32x4 xv[R][4]; v2u hw[R][4];
#pragma unroll
        for (int r = 0; r < R; ++r) { const GAS v2u* hr = (const GAS v2u*)(h + (size_t)(row0 + r) * DM) + lane;
#pragma unroll
            for (int j = 0; j < 4; ++j) { hw[r][j] = hr[64 * j];
                if (XIN_F32) xv[r][j] = *((const GAS f32x4*)((const float*)xin + (size_t)(row0 + r) * DM) + lane + 64 * j);
                else { const v2u w = *((const GAS v2u*)((const bf16*)xin + (size_t)(row0 + r) * DM) + lane + 64 * j); xv[r][j] = (f32x4){bf_lo(w.x), bf_hi(w.x), bf_lo(w.y), bf_hi(w.y)}; } } }
        float s[R];
#pragma unroll
        for (int r = 0; r < R; ++r) { s[r] = 0.f;
#pragma unroll
            for (int j = 0; j < 4; ++j) { const float a = bf_lo(hw[r][j].x), b = bf_hi(hw[r][j].x), c = bf_lo(hw[r][j].y), d = bf_hi(hw[r][j].y); s[r] += (a * a + b * b) + (c * c + d * d); } }
#pragma unroll
        for (int o = 1; o < 64; o <<= 1) {
#pragma unroll
            for (int r = 0; r < R; ++r) s[r] += __shfl_xor(s[r], o); }
        float s2[R];
#pragma unroll
        for (int r = 0; r < R; ++r) { const float rh = scale / sqrtf(s[r] * (1.0f / DM) + EPS); s2[r] = 0.f;
#pragma unroll
            for (int j = 0; j < 4; ++j) { const f32x4 hv = {bf_lo(hw[r][j].x), bf_hi(hw[r][j].x), bf_lo(hw[r][j].y), bf_hi(hw[r][j].y)};
                xv[r][j] = xv[r][j] + hv * gv[j] * rh; s2[r] += (xv[r][j].x * xv[r][j].x + xv[r][j].y * xv[r][j].y) + (xv[r][j].z * xv[r][j].z + xv[r][j].w * xv[r][j].w); } }
#pragma unroll
        for (int r = 0; r < R; ++r) {
#pragma unroll
            for (int j = 0; j < 4; ++j) {
                if (OUT_F32) *((GAS f32x4*)((float*)xout + (size_t)(row0 + r) * DM) + lane + 64 * j) = xv[r][j];
                else *((GAS v2u*)((bf16*)xout + (size_t)(row0 + r) * DM) + lane + 64 * j) = (v2u){pkc(xv[r][j].x, xv[r][j].y), pkc(xv[r][j].z, xv[r][j].w)}; } }
        if (!OUT_F32) {
#pragma unroll
            for (int o = 1; o < 64; o <<= 1) {
#pragma unroll
                for (int r = 0; r < R; ++r) s2[r] += __shfl_xor(s2[r], o); }
            if (lane < R) { float v = s2[0];
#pragma unroll
                for (int r = 1; r < R; ++r) v = (lane == r) ? s2[r] : v;
                rstd[row0 + lane] = 1.0f / sqrtf(v * (1.0f / DM) + EPS); }
        }
    }
}

__device__ __forceinline__ float gelu_tanh(float x) {
    const float u = 0.7978845608028654f * (x + 0.044715f * x * x * x);
    const float e = ex2(2.0f * 1.4426950408889634f * u);
    const float th = 1.0f - 2.0f * __builtin_amdgcn_rcpf(e + 1.0f);
    return 0.5f * x * (1.0f + th);
}
__device__ __forceinline__ int kt_off(int key, int d) { return (((key >> 4) * 2 + (d >> 5)) * 64 + ((d & 31) >> 3) * 16 + (key & 15)) * 8 + (d & 7); }
__device__ __forceinline__ int vt_off(int key, int d) { return ((((key >> 5) * 4 + (d >> 4)) * 64) + ((key & 15) >> 2) * 16 + (d & 15)) * 8 + (key & 3) + 4 * ((key >> 4) & 1); }

__device__ __forceinline__ void cmp2_phase(const float* hidp, const float* bias, const float* w2k, const float* w2v, bf16* kc_t, bf16* vc_t, float* kcn, int gw, int NGW, int lane) {
    const int col = lane & 15, g4 = lane >> 4;
    for (int task = gw; task < 512; task += NGW) {
        const int m0 = 16 * task, kv = m0 >> 12, bg = (m0 >> 10) & 3;
        const float* bs = bias + kv * 256; const float* w2 = kv == 0 ? w2k : w2v;
        f32x4 acc[4] = {{0.f, 0.f, 0.f, 0.f}, {0.f, 0.f, 0.f, 0.f}, {0.f, 0.f, 0.f, 0.f}, {0.f, 0.f, 0.f, 0.f}};
        const float* hrow = hidp + (size_t)(m0 + col) * 256 + 4 * g4;
        f32x4 hv[16];
#pragma unroll
        for (int kk = 0; kk < 16; ++kk) hv[kk] = *(const GAS f32x4*)(hrow + 16 * kk) + *(const GAS f32x4*)(bs + 16 * kk + 4 * g4);
#pragma unroll
        for (int p = 1; p < 4; ++p)
#pragma unroll
            for (int kk = 0; kk < 16; ++kk) hv[kk] = hv[kk] + *(const GAS f32x4*)(hrow + (size_t)p * 8192 * 256 + 16 * kk);
#pragma unroll
        for (int kk = 0; kk < 16; ++kk) {
#pragma unroll
            for (int j = 0; j < 4; ++j) { const float av = gelu_tanh(hv[kk][j]); const float* wr = w2 + (size_t)(16 * kk + 4 * g4 + j) * 64 + col;
#pragma unroll
                for (int nt = 0; nt < 4; ++nt) acc[nt] = __builtin_amdgcn_mfma_f32_16x16x4f32(av, wr[16 * nt], acc[nt], 0, 0, 0); }
        }
        float nmax = 0.f;
#pragma unroll
        for (int r = 0; r < 4; ++r) { const int n = (m0 + 4 * g4 + r) & 1023; float sq = 0.f;
#pragma unroll
            for (int nt = 0; nt < 4; ++nt) { const float o = (n == 1023) ? 0.f : acc[nt][r]; sq += o * o; const int d = 16 * nt + col;
                const unsigned short ob = (unsigned short)(pkc(o, 0.f) & 0xffffu);
                if (kv == 0) kc_t[(size_t)bg * 65536 + kt_off(n, d)] = ob; else vc_t[(size_t)bg * 65536 + vt_off(n, d)] = ob; }
#pragma unroll
            for (int o = 1; o < 16; o <<= 1) sq += __shfl_xor(sq, o);
            nmax = fmaxf(nmax, sq); }
        nmax = fmaxf(nmax, __shfl_xor(nmax, 16)); nmax = fmaxf(nmax, __shfl_xor(nmax, 32));
        if (kv == 0 && lane == 0) kcn[bg * 64 + ((m0 & 1023) >> 4)] = nmax;
    }
}
__device__ __forceinline__ void vretile(const bf16* vrm, bf16* vt, int gw, int NGW, int lane) {
    for (int it = gw; it < 4 * (SEQ / 32); it += NGW) {
        const int bg = it / (SEQ / 32), kg = it % (SEQ / 32);
        const bf16* src = vrm + ((size_t)bg * SEQ + kg * 32) * 64; bf16* dst = vt + (size_t)bg * SEQ * 64;
#pragma unroll
        for (int g4 = 0; g4 < 4; ++g4) { unsigned short e[8];
#pragma unroll
            for (int j = 0; j < 8; ++j) { const int key = 4 * g4 + (j & 3) + 16 * (j >> 2); e[j] = src[key * 64 + lane]; }
            v4u w; w.x = e[0] | ((unsigned)e[1] << 16); w.y = e[2] | ((unsigned)e[3] << 16); w.z = e[4] | ((unsigned)e[5] << 16); w.w = e[6] | ((unsigned)e[7] << 16);
            *(GAS v4u*)(dst + (size_t)((kg * 4 + (lane >> 4)) * 64 + g4 * 16 + (lane & 15)) * 8) = w; }
    }
}

__device__ __forceinline__ void unpack8(const v4u w, float (&f)[8]) { f[0] = bf_lo(w.x); f[1] = bf_hi(w.x); f[2] = bf_lo(w.y); f[3] = bf_hi(w.y); f[4] = bf_lo(w.z); f[5] = bf_hi(w.z); f[6] = bf_lo(w.w); f[7] = bf_hi(w.w); }

__device__ __forceinline__ float wave_max(float v) {
#pragma unroll
    for (int o = 1; o < 64; o <<= 1) v = fmaxf(v, __shfl_xor(v, o));
    return v;
}
__device__ __forceinline__ void knorm_pass(const bf16* k_t, float* kn, int gw, int NGW, int lane) {
    for (int it = gw; it < 4 * (SEQ / 16); it += NGW) {
        const bf16* p = k_t + (size_t)it * 1024 + lane * 8;
        const v4u a = *(const GAS v4u*)p, b = *(const GAS v4u*)(p + 512);
        float f[8], s = 0.f;
        unpack8(a, f);
#pragma unroll
        for (int j = 0; j < 8; ++j) s += f[j] * f[j];
        unpack8(b, f);
#pragma unroll
        for (int j = 0; j < 8; ++j) s += f[j] * f[j];
        s += __shfl_xor(s, 16); s += __shfl_xor(s, 32);
#pragma unroll
        for (int o = 1; o < 16; o <<= 1) s = fmaxf(s, __shfl_xor(s, o));
        if (lane == 0) kn[it] = s;
    }
}

__device__ __forceinline__ int mbcnt64(unsigned long long m) { return (int)__builtin_amdgcn_mbcnt_hi((unsigned)(m >> 32), __builtin_amdgcn_mbcnt_lo((unsigned)m, 0u)); }
__device__ __forceinline__ void sel_one(const f32x4 sv, int t, int* dst, int lane) {
    const int cur = t >> 6;
    unsigned u[4]; bool ok[4];
#pragma unroll
    for (int k = 0; k < 4; ++k) { const int j = 4 * lane + k; ok[k] = j <= cur; const bool forced = (j == 0) || (j == cur) || (j == cur - 1);
        const float v = forced ? 1e9f : fmaxf(sv[k], 0.f); u[k] = ok[k] ? __float_as_uint(v) : 0u; }
    bool sel[4];
    if (cur + 1 <= KTOP) {
#pragma unroll
        for (int k = 0; k < 4; ++k) sel[k] = ok[k];
    } else {
        unsigned tau = 0u;
#pragma unroll 1
        for (int bit = 30; bit >= 0; --bit) { const unsigned cand = tau | (1u << bit);
            const int cnt = __builtin_popcountll(__ballot(ok[0] && u[0] >= cand)) + __builtin_popcountll(__ballot(ok[1] && u[1] >= cand)) + __builtin_popcountll(__ballot(ok[2] && u[2] >= cand)) + __builtin_popcountll(__ballot(ok[3] && u[3] >= cand));
            if (cnt >= KTOP) tau = cand;
            if (cnt == KTOP) break; }
        bool gt[4], eq[4]; unsigned long long em[4]; int ngt = 0;
#pragma unroll
        for (int k = 0; k < 4; ++k) { gt[k] = ok[k] && u[k] > tau; eq[k] = ok[k] && u[k] == tau; ngt += __builtin_popcountll(__ballot(gt[k])); em[k] = __ballot(eq[k]); }
        const int need = KTOP - ngt;
        int rank = mbcnt64(em[0]) + mbcnt64(em[1]) + mbcnt64(em[2]) + mbcnt64(em[3]);
#pragma unroll
        for (int k = 0; k < 4; ++k) { sel[k] = gt[k] || (eq[k] && rank < need); rank += eq[k] ? 1 : 0; }
    }
    unsigned long long sm[4];
#pragma unroll
    for (int k = 0; k < 4; ++k) sm[k] = __ballot(sel[k]);
    int pos = mbcnt64(sm[0]) + mbcnt64(sm[1]) + mbcnt64(sm[2]) + mbcnt64(sm[3]);
    const int total = __builtin_popcountll(sm[0]) + __builtin_popcountll(sm[1]) + __builtin_popcountll(sm[2]) + __builtin_popcountll(sm[3]);
#pragma unroll
    for (int k = 0; k < 4; ++k) { if (sel[k] && pos < KTOP) dst[pos] = 4 * lane + k; pos += sel[k] ? 1 : 0; }
    if (lane >= total && lane < KTOP) dst[lane] = -1;
}

__device__ __forceinline__ void acmp_item(const bf16* qraw, bf16* ocmp, const bf16* kc_t, const bf16* vc_t, int* idx, const float* kcn, LAS float* sw, int bg, int qt, int lane) {
    const int col = lane & 15, g4 = lane >> 4, b = bg >> 1, g = bg & 1;
    const int t = 16 * qt + col; const size_t row = (size_t)b * SEQ + t;
    const int nmax = (t - 31) >> 4;
    const int ntiles = (qt + 15) >> 4;
    bf16x8 qf[4][2]; float shift[4];
    const float kmx = wave_max(kcn[bg * 64 + lane]);
#pragma unroll
    for (int hh = 0; hh < 4; ++hh) { float qn = 0.f;
#pragma unroll
        for (int s = 0; s < 2; ++s) { qf[hh][s] = *(const bf16x8*)(qraw + row * 512 + (4 * g + hh) * 64 + 32 * s + 8 * g4); float f[8]; unpack8(__builtin_bit_cast(v4u, qf[hh][s]), f);
#pragma unroll
            for (int j = 0; j < 8; ++j) qn += f[j] * f[j]; }
        qn += __shfl_xor(qn, 16); qn += __shfl_xor(qn, 32);
        shift[hh] = C2 * sqrtf(qn * kmx) * 1.01f + 1e-6f; }
    const bf16* kb = kc_t + (size_t)bg * 65536 + lane * 8; const bf16* vb = vc_t + (size_t)bg * 65536 + lane * 8;
    const f32x4 zero = {0.f, 0.f, 0.f, 0.f};
    if (__any(shift[0] > 60.f || shift[1] > 60.f || shift[2] > 60.f || shift[3] > 60.f)) {
        float mx[4] = {-1e30f, -1e30f, -1e30f, -1e30f};
        for (int T = 0; T < ntiles; ++T) { const bf16x8 k0 = *(const bf16x8*)(kb + (T * 2 + 0) * 512), k1 = *(const bf16x8*)(kb + (T * 2 + 1) * 512);
#pragma unroll
            for (int hh = 0; hh < 4; ++hh) { f32x4 s = mfma16(k0, qf[hh][0], zero); s = mfma16(k1, qf[hh][1], s);
#pragma unroll
                for (int r = 0; r < 4; ++r) mx[hh] = ((16 * T + 4 * g4 + r) <= nmax) ? fmaxf(mx[hh], s[r] * C2) : mx[hh]; } }
#pragma unroll
        for (int hh = 0; hh < 4; ++hh) { float m = fmaxf(mx[hh], __shfl_xor(mx[hh], 16)); m = fmaxf(m, __shfl_xor(m, 32)); shift[hh] = m; }
    }
    float ls[4] = {0.f, 0.f, 0.f, 0.f};
    if (ntiles > 0) {
        bf16x8 k0 = *(const bf16x8*)(kb), k1 = *(const bf16x8*)(kb + 512);
        for (int T = 0; T < ntiles; ++T) {
            const int Tn = (T + 1 < ntiles) ? T + 1 : T;
            const bf16x8 n0 = *(const bf16x8*)(kb + (Tn * 2 + 0) * 512), n1 = *(const bf16x8*)(kb + (Tn * 2 + 1) * 512);
#pragma unroll
            for (int hh = 0; hh < 4; ++hh) { f32x4 s = mfma16(k0, qf[hh][0], zero); s = mfma16(k1, qf[hh][1], s);
#pragma unroll
                for (int r = 0; r < 4; ++r) ls[hh] += ((16 * T + 4 * g4 + r) <= nmax) ? ex2(__builtin_fmaf(s[r], C2, -shift[hh])) : 0.f; }
            k0 = n0; k1 = n1;
        }
    }
#pragma unroll
    for (int hh = 0; hh < 4; ++hh) { float l = ls[hh]; l += __shfl_xor(l, 16); l += __shfl_xor(l, 32); ls[hh] = l > 0.f ? 1.0f / l : 0.f; }
    f32x4 O[4][4];
#pragma unroll
    for (int hh = 0; hh < 4; ++hh)
#pragma unroll
        for (int dt = 0; dt < 4; ++dt) O[hh][dt] = zero;
    float carry = 0.f;
    const int npairs = (ntiles + 1) >> 1;
    LAS float* srow = sw + col * 256;
    bf16x8 kfn[2][2];
    if (npairs > 0) {
#pragma unroll
        for (int tt = 0; tt < 2; ++tt)
#pragma unroll
            for (int s = 0; s < 2; ++s) kfn[tt][s] = *(const bf16x8*)(kb + (tt * 2 + s) * 512);
    }
    for (int kg = 0; kg < npairs; ++kg) {
        bf16x8 vf[4], kf[2][2];
#pragma unroll
        for (int dt = 0; dt < 4; ++dt) vf[dt] = *(const bf16x8*)(vb + (kg * 4 + dt) * 512);
#pragma unroll
        for (int tt = 0; tt < 2; ++tt)
#pragma unroll
            for (int s = 0; s < 2; ++s) kf[tt][s] = kfn[tt][s];
        { const int kn = (kg + 1 < npairs) ? kg + 1 : kg;
#pragma unroll
          for (int tt = 0; tt < 2; ++tt)
#pragma unroll
              for (int s = 0; s < 2; ++s) kfn[tt][s] = *(const bf16x8*)(kb + ((2 * kn + tt) * 2 + s) * 512); }
        f32x4 p[2][4]; float aa[2], bb[2];
#pragma unroll
        for (int tt = 0; tt < 2; ++tt) {
            const int T = 2 * kg + tt;
            aa[tt] = 0.f; bb[tt] = 0.f;
#pragma unroll
            for (int hh = 0; hh < 4; ++hh) {
                f32x4 s = mfma16(kf[tt][0], qf[hh][0], zero); s = mfma16(kf[tt][1], qf[hh][1], s);
#pragma unroll
                for (int r = 0; r < 4; ++r) p[tt][hh][r] = ((16 * T + 4 * g4 + r) <= nmax) ? ex2(__builtin_fmaf(s[r], C2, -shift[hh])) * ls[hh] : 0.f;
                aa[tt] += 2.0f * (p[tt][hh][0] + p[tt][hh][1] + p[tt][hh][2]) + p[tt][hh][3]; bb[tt] += p[tt][hh][3];
            }
        }
#pragma unroll
        for (int hh = 0; hh < 4; ++hh) { const bf16x8 pf = pack8(p[0][hh], p[1][hh]);
#pragma unroll
            for (int dt = 0; dt < 4; ++dt) O[hh][dt] = mfma16(vf[dt], pf, O[hh][dt]); }
#pragma unroll
        for (int tt = 0; tt < 2; ++tt) {
            const int T = 2 * kg + tt;
            const float bsh = __shfl(bb[tt], (lane + 48) & 63);
            const float val = aa[tt] + (g4 == 0 ? carry : bsh);
            carry = bsh;
            srow[4 * T + g4] = val;
        }
    }
    for (int j = 8 * npairs + g4; j < NSELB; j += 4) srow[j] = (j == 8 * npairs) ? carry : 0.f;
#pragma unroll
    for (int hh = 0; hh < 4; ++hh)
#pragma unroll
        for (int dt = 0; dt < 4; ++dt) { const f32x4 o = O[hh][dt];
            *(GAS v2u*)(ocmp + row * 512 + (4 * g + hh) * 64 + 16 * dt + 4 * g4) = (v2u){pkc(o[0], o[1]), pkc(o[2], o[3])}; }
    asm volatile("s_waitcnt lgkmcnt(0)" ::: "memory");
    for (int qi = 0; qi < 16; ++qi) {
        const f32x4 sv = *((const LAS f32x4*)(sw + qi * 256) + lane);
        const int tq = 16 * qt + qi;
        sel_one(sv, tq, idx + (((size_t)b * SEQ + tq) * 2 + g) * KTOP, lane);
    }
    asm volatile("s_waitcnt lgkmcnt(0)" ::: "memory");
}

typedef long fp8x8;
__device__ __forceinline__ f32x4 mfma8(fp8x8 a, fp8x8 b, f32x4 c) { return __builtin_amdgcn_mfma_f32_16x16x32_fp8_fp8(a, b, c, 0, 0, 0); }
__device__ __forceinline__ unsigned pk4_fp8(float a, float b, float c, float d) { int w = __builtin_amdgcn_cvt_pk_fp8_f32(a, b, 0, false); w = __builtin_amdgcn_cvt_pk_fp8_f32(c, d, w, true); return (unsigned)w; }
__device__ __forceinline__ fp8x8 mk64(unsigned lo, unsigned hi) { return (fp8x8)(((unsigned long long)hi << 32) | (unsigned long long)lo); }
struct K8 { v4u k[4]; };
struct V8 { v4u v[2][2]; };
__device__ __forceinline__ void k8_load(K8& f, const unsigned char* kb8, int blk) {
#pragma unroll
    for (int T = 0; T < 4; ++T) f.k[T] = *(const GAS v4u*)(kb8 + (size_t)(blk * 4 + T) * 1024);
}
__device__ __forceinline__ void v8_load(V8& f, const unsigned char* vb8, int blk) {
#pragma unroll
    for (int ks = 0; ks < 2; ++ks)
#pragma unroll
        for (int dp = 0; dp < 2; ++dp) f.v[ks][dp] = *(const GAS v4u*)(vb8 + (size_t)((blk * 2 + ks) * 2 + dp) * 1024);
}
template <bool ONLINE>
__device__ __forceinline__ void slc8_compute(const K8& fk, const V8& fv, const fp8x8 (&qf)[2], f32x4 (&O)[4], float shift, float& Mx, float& l, int blk, bool diag, int t, int g4) {
    const f32x4 zero = {0.f, 0.f, 0.f, 0.f};
    f32x4 e[4];
#pragma unroll
    for (int T = 0; T < 4; ++T) { f32x4 s = mfma8(mk64(fk.k[T].x, fk.k[T].y), qf[0], zero); s = mfma8(mk64(fk.k[T].z, fk.k[T].w), qf[1], s);
#pragma unroll
        for (int r = 0; r < 4; ++r) e[T][r] = ONLINE ? s[r] * C2 : ex2(__builtin_fmaf(s[r], C2, 8.0f - shift)); }
    if (diag) {
#pragma unroll
        for (int T = 0; T < 4; ++T)
#pragma unroll
            for (int r = 0; r < 4; ++r) e[T][r] = ((64 * blk + 16 * T + 4 * g4 + r) <= t) ? e[T][r] : (ONLINE ? -1e30f : 0.f);
    }
    if (ONLINE) {
        float mt = -1e30f;
#pragma unroll
        for (int T = 0; T < 4; ++T) mt = fmaxf(mt, fmaxf(fmaxf(e[T][0], e[T][1]), fmaxf(e[T][2], e[T][3])));
        mt = fmaxf(mt, __shfl_xor(mt, 16)); mt = fmaxf(mt, __shfl_xor(mt, 32));
        const float Mn = fmaxf(Mx, mt), alpha = ex2(Mx - Mn); Mx = Mn; l *= alpha;
#pragma unroll
        for (int dt = 0; dt < 4; ++dt) O[dt] = O[dt] * alpha;
#pragma unroll
        for (int T = 0; T < 4; ++T)
#pragma unroll
            for (int r = 0; r < 4; ++r) e[T][r] = (e[T][r] > -1e29f) ? ex2(e[T][r] - Mn + 8.0f) : 0.f;
    }
    float add = 0.f;
#pragma unroll
    for (int T = 0; T < 4; ++T) add += (e[T][0] + e[T][1]) + (e[T][2] + e[T][3]);
    l += add;
#pragma unroll
    for (int ks = 0; ks < 2; ++ks) {
        const fp8x8 pf = mk64(pk4_fp8(e[2 * ks][0], e[2 * ks][1], e[2 * ks][2], e[2 * ks][3]), pk4_fp8(e[2 * ks + 1][0], e[2 * ks + 1][1], e[2 * ks + 1][2], e[2 * ks + 1][3]));
#pragma unroll
        for (int dp = 0; dp < 2; ++dp) { O[2 * dp] = mfma8(mk64(fv.v[ks][dp].x, fv.v[ks][dp].y), pf, O[2 * dp]); O[2 * dp + 1] = mfma8(mk64(fv.v[ks][dp].z, fv.v[ks][dp].w), pf, O[2 * dp + 1]); }
    }
}
template <bool ONLINE>
__device__ __forceinline__ void slc8_query(const K8& K0, const V8& V0, const K8& KB, const V8& VB, const unsigned char* kb8, const unsigned char* vb8, const fp8x8 (&qf)[2], f32x4 (&O)[4], float shift, float& l,
                                           int myidx, int k1, int cur, int t, int g4) {
    float Mx = -1e30f;
    K8 ka, kb;
    if (1 < k1) k8_load(ka, kb8, __builtin_amdgcn_readlane(myidx, 1));
    slc8_compute<ONLINE>(K0, V0, qf, O, shift, Mx, l, 0, cur == 0, t, g4);
    for (int k = 1; k < k1; k += 2) {
        const int b0 = __builtin_amdgcn_readlane(myidx, k);
        const bool has1 = (k + 1 < k1);
        const int b1 = has1 ? __builtin_amdgcn_readlane(myidx, k + 1) : 0;
        { V8 vv; v8_load(vv, vb8, b0); if (has1) k8_load(kb, kb8, b1);
          slc8_compute<ONLINE>(ka, vv, qf, O, shift, Mx, l, b0, false, t, g4); }
        if (has1) {
            V8 vv; v8_load(vv, vb8, b1); if (k + 2 < k1) k8_load(ka, kb8, __builtin_amdgcn_readlane(myidx, k + 2));
            slc8_compute<ONLINE>(kb, vv, qf, O, shift, Mx, l, b1, false, t, g4);
        }
    }
    if (cur >= 1) slc8_compute<ONLINE>(KB, VB, qf, O, shift, Mx, l, cur, true, t, g4);
}
__device__ __forceinline__ void aslc8_chunk(const bf16* qrot, const unsigned char* ks8, const unsigned char* vs8, const int* idx, bf16* oslc, const float* ksn, int bg, int c, int lane) {
    const int col = lane & 15, g4 = lane >> 4, b = bg >> 1, g = bg & 1, cur = c >> 1, t0 = 32 * c;
    const unsigned char* kb8 = ks8 + (size_t)bg * (SEQ * 64) + lane * 16; const unsigned char* vb8 = vs8 + (size_t)bg * (SEQ * 64) + lane * 16;
    K8 K0, KB; V8 V0, VB;
    k8_load(K0, kb8, 0); v8_load(V0, vb8, 0); k8_load(KB, kb8, cur); v8_load(VB, vb8, cur);
    const int* ip = idx + (((size_t)b * SEQ + t0) * 2 + g) * KTOP;
    int idx_next = (lane < KTOP) ? ip[lane] : -1;
    const f32x4 zero = {0.f, 0.f, 0.f, 0.f};
    for (int qi = 0; qi < 32; ++qi) {
        const int t = t0 + qi; const size_t row = (size_t)b * SEQ + t;
        const int myidx = idx_next;
        if (qi + 1 < 32) idx_next = (lane < KTOP) ? ip[(size_t)(qi + 1) * 2 * KTOP + lane] : -1;
        const int nsel = __builtin_popcountll(__ballot(myidx >= 0));
        const int k1 = nsel - (cur >= 1 ? 1 : 0);
        fp8x8 qf[2]; float qn = 0.f;
#pragma unroll
        for (int s = 0; s < 2; ++s) { float f[8];
            if (col < 4) unpack8(*(const GAS v4u*)(qrot + row * 512 + (4 * g + col) * 64 + 32 * s + 8 * g4), f); else {
#pragma unroll
                for (int j = 0; j < 8; ++j) f[j] = 0.f; }
            const unsigned w0 = pk4_fp8(f[0], f[1], f[2], f[3]), w1 = pk4_fp8(f[4], f[5], f[6], f[7]); qf[s] = mk64(w0, w1);
            { const float a0 = __builtin_amdgcn_cvt_f32_fp8((int)w0, 0), a1 = __builtin_amdgcn_cvt_f32_fp8((int)w0, 1), a2 = __builtin_amdgcn_cvt_f32_fp8((int)w0, 2), a3 = __builtin_amdgcn_cvt_f32_fp8((int)w0, 3);
              const float b0 = __builtin_amdgcn_cvt_f32_fp8((int)w1, 0), b1 = __builtin_amdgcn_cvt_f32_fp8((int)w1, 1), b2 = __builtin_amdgcn_cvt_f32_fp8((int)w1, 2), b3 = __builtin_amdgcn_cvt_f32_fp8((int)w1, 3);
              qn += (a0 * a0 + a1 * a1) + (a2 * a2 + a3 * a3) + (b0 * b0 + b1 * b1) + (b2 * b2 + b3 * b3); } }
        qn += __shfl_xor(qn, 16); qn += __shfl_xor(qn, 32);
        const int bsel = __shfl(myidx, lane >> 2);
        const float kmx = wave_max(bsel >= 0 ? ksn[bg * (SEQ / 16) + bsel * 4 + (lane & 3)] : 0.f);
        const float shift = C2 * sqrtf(qn * kmx) * 1.0001f + 1e-6f;
        f32x4 O[4] = {zero, zero, zero, zero}; float l = 0.f;
        if (!__any(shift > 60.0f)) slc8_query<false>(K0, V0, KB, VB, kb8, vb8, qf, O, shift, l, myidx, k1, cur, t, g4);
        else slc8_query<true>(K0, V0, KB, VB, kb8, vb8, qf, O, shift, l, myidx, k1, cur, t, g4);
        l += __shfl_xor(l, 16); l += __shfl_xor(l, 32);
        const float inv = l > 0.f ? 1.0f / l : 0.f;
        if (col < 4) {
#pragma unroll
            for (int dt = 0; dt < 4; ++dt) { const f32x4 o = O[dt] * inv;
                *(GAS v2u*)(oslc + row * 512 + (4 * g + col) * 64 + 16 * dt + 4 * g4) = (v2u){pkc(o[0], o[1]), pkc(o[2], o[3])}; }
        }
    }
}
__device__ __forceinline__ void vretile8(const bf16* vrm, unsigned char* vt8, int gw, int NGW, int lane) {
    for (int it = gw; it < 4 * (SEQ / 32); it += NGW) {
        const int bg = it / (SEQ / 32), kg = it % (SEQ / 32);
        const bf16* src = vrm + ((size_t)bg * SEQ + kg * 32) * 64; unsigned char* dst = vt8 + (size_t)bg * (SEQ * 64);
#pragma unroll
        for (int g4 = 0; g4 < 4; ++g4) { float e[8];
#pragma unroll
            for (int j = 0; j < 8; ++j) { const int key = 4 * g4 + (j & 3) + 16 * (j >> 2); e[j] = __uint_as_float((unsigned)src[key * 64 + lane] << 16); }
            const v2u w = {pk4_fp8(e[0], e[1], e[2], e[3]), pk4_fp8(e[4], e[5], e[6], e[7])};
            const int dt = lane >> 4;
            *(GAS v2u*)(dst + (size_t)((kg * 2 + (dt >> 1)) * 64 + g4 * 16 + (lane & 15)) * 16 + (dt & 1) * 8) = w; }
    }
}
__device__ __forceinline__ void knorm8_pass(const unsigned char* k8, float* kn, int gw, int NGW, int lane) {
    for (int it = gw; it < 4 * (SEQ / 16); it += NGW) {
        const v4u a = *(const GAS v4u*)(k8 + (size_t)it * 1024 + lane * 16);
        float s = 0.f;
#pragma unroll
        for (int q = 0; q < 4; ++q) { const int w = (int)a[q];
            const float f0 = __builtin_amdgcn_cvt_f32_fp8(w, 0), f1 = __builtin_amdgcn_cvt_f32_fp8(w, 1), f2 = __builtin_amdgcn_cvt_f32_fp8(w, 2), f3 = __builtin_amdgcn_cvt_f32_fp8(w, 3);
            s += (f0 * f0 + f1 * f1) + (f2 * f2 + f3 * f3); }
        s += __shfl_xor(s, 16); s += __shfl_xor(s, 32);
#pragma unroll
        for (int o = 1; o < 16; o <<= 1) s = fmaxf(s, __shfl_xor(s, o));
        if (lane == 0) kn[it] = s;
    }
}

struct WinFrags { bf16x8 kf[2][2], vf[4]; };
__device__ __forceinline__ void win_load(WinFrags& f, const bf16* kb, const bf16* vb, int kg) {
#pragma unroll
    for (int tt = 0; tt < 2; ++tt)
#pragma unroll
        for (int s = 0; s < 2; ++s) f.kf[tt][s] = *(const bf16x8*)(kb + (size_t)((2 * kg + tt) * 2 + s) * 512);
#pragma unroll
    for (int dt = 0; dt < 4; ++dt) f.vf[dt] = *(const bf16x8*)(vb + (size_t)(kg * 4 + dt) * 512);
}
__device__ __forceinline__ void win_compute_fs(const WinFrags& f, const bf16x8 (&qf)[2], f32x4 (&O)[4], float shift, float& l, int kg, int t, int g4, bool edge) {
    const f32x4 zero = {0.f, 0.f, 0.f, 0.f};
    f32x4 e[2];
#pragma unroll
    for (int tt = 0; tt < 2; ++tt) { f32x4 s = mfma16(f.kf[tt][0], qf[0], zero); s = mfma16(f.kf[tt][1], qf[1], s);
#pragma unroll
        for (int r = 0; r < 4; ++r) e[tt][r] = ex2(__builtin_fmaf(s[r], C2, -shift)); }
    if (edge) {
#pragma unroll
        for (int tt = 0; tt < 2; ++tt)
#pragma unroll
            for (int r = 0; r < 4; ++r) { const int df = t - (32 * kg + 16 * tt + 4 * g4 + r); e[tt][r] = (df >= 0 && df < 512) ? e[tt][r] : 0.f; }
    }
    l += ((e[0][0] + e[0][1]) + (e[0][2] + e[0][3])) + ((e[1][0] + e[1][1]) + (e[1][2] + e[1][3]));
    const bf16x8 pf = pack8(e[0], e[1]);
#pragma unroll
    for (int dt = 0; dt < 4; ++dt) O[dt] = mfma16(f.vf[dt], pf, O[dt]);
}
__device__ __forceinline__ void win_compute_on(const WinFrags& f, const bf16x8 (&qf)[2], f32x4 (&O)[4], float& Mx, float& l, int kg, int t, int g4) {
    const f32x4 zero = {0.f, 0.f, 0.f, 0.f};
    f32x4 e[2]; float mt = -1e30f;
#pragma unroll
    for (int tt = 0; tt < 2; ++tt) { f32x4 s = mfma16(f.kf[tt][0], qf[0], zero); s = mfma16(f.kf[tt][1], qf[1], s);
#pragma unroll
        for (int r = 0; r < 4; ++r) { const int df = t - (32 * kg + 16 * tt + 4 * g4 + r); const bool valid = df >= 0 && df < 512; e[tt][r] = valid ? s[r] * C2 : -1e30f; mt = fmaxf(mt, e[tt][r]); } }
    mt = fmaxf(mt, __shfl_xor(mt, 16)); mt = fmaxf(mt, __shfl_xor(mt, 32));
    const float Mn = fmaxf(Mx, mt), alpha = ex2(Mx - Mn); Mx = Mn;
    float add = 0.f;
#pragma unroll
    for (int tt = 0; tt < 2; ++tt)
#pragma unroll
        for (int r = 0; r < 4; ++r) { const float pv = (e[tt][r] > -1e29f) ? ex2(e[tt][r] - Mn) : 0.f; e[tt][r] = pv; add += pv; }
    l = l * alpha + add;
    const bf16x8 pf = pack8(e[0], e[1]);
#pragma unroll
    for (int dt = 0; dt < 4; ++dt) O[dt] = mfma16(f.vf[dt], pf, O[dt] * alpha);
}
__device__ __forceinline__ void awin_item(const bf16* qrot, bf16* owin, const bf16* kw_t, const bf16* vw_t, const float* kwn, int bg, int qt, int lane) {
    const int col = lane & 15, g4 = lane >> 4, b = bg >> 1, g = bg & 1;
    const int t = 16 * qt + col; const size_t row = (size_t)b * SEQ + t;
    const int tlo = qt - 32 > 0 ? qt - 32 : 0, kg0 = tlo >> 1, kg1 = qt >> 1;
    const float kmx = wave_max((2 * kg0 + lane <= 2 * kg1 + 1) ? kwn[bg * (SEQ / 16) + 2 * kg0 + lane] : 0.f);
    bf16x8 qf[4][2]; float shift[4];
#pragma unroll
    for (int hh = 0; hh < 4; ++hh) { float qn = 0.f;
#pragma unroll
        for (int s = 0; s < 2; ++s) { qf[hh][s] = *(const bf16x8*)(qrot + row * 512 + (4 * g + hh) * 64 + 32 * s + 8 * g4); float f[8]; unpack8(__builtin_bit_cast(v4u, qf[hh][s]), f);
#pragma unroll
            for (int j = 0; j < 8; ++j) qn += f[j] * f[j]; }
        qn += __shfl_xor(qn, 16); qn += __shfl_xor(qn, 32);
        shift[hh] = C2 * sqrtf(qn * kmx) * 1.0001f + 1e-6f; }
    const bf16* kb = kw_t + (size_t)bg * SEQ * 64 + lane * 8; const bf16* vb = vw_t + (size_t)bg * SEQ * 64 + lane * 8;
    const f32x4 zero = {0.f, 0.f, 0.f, 0.f};
    f32x4 O[4][4]; float l[4] = {0.f, 0.f, 0.f, 0.f};
#pragma unroll
    for (int hh = 0; hh < 4; ++hh)
#pragma unroll
        for (int dt = 0; dt < 4; ++dt) O[hh][dt] = zero;
    if (!__any(shift[0] > 60.f || shift[1] > 60.f || shift[2] > 60.f || shift[3] > 60.f)) {
        WinFrags fa, fb;
        win_load(fa, kb, vb, kg0);
        for (int kg = kg0; kg <= kg1; kg += 2) {
            const bool has1 = kg + 1 <= kg1;
            if (has1) win_load(fb, kb, vb, kg + 1);
            { const bool edge = (kg <= kg0 + 1) || (kg >= kg1 - 1);
#pragma unroll
              for (int hh = 0; hh < 4; ++hh) win_compute_fs(fa, qf[hh], O[hh], shift[hh], l[hh], kg, t, g4, edge); }
            if (has1) { if (kg + 2 <= kg1) win_load(fa, kb, vb, kg + 2);
                const bool edge = (kg + 1 <= kg0 + 1) || (kg + 1 >= kg1 - 1);
#pragma unroll
                for (int hh = 0; hh < 4; ++hh) win_compute_fs(fb, qf[hh], O[hh], shift[hh], l[hh], kg + 1, t, g4, edge); }
        }
    } else {
        float Mx[4] = {-1e30f, -1e30f, -1e30f, -1e30f};
        for (int kg = kg0; kg <= kg1; ++kg) { WinFrags fa; win_load(fa, kb, vb, kg);
#pragma unroll
            for (int hh = 0; hh < 4; ++hh) win_compute_on(fa, qf[hh], O[hh], Mx[hh], l[hh], kg, t, g4); }
    }
#pragma unroll
    for (int hh = 0; hh < 4; ++hh) { float ll = l[hh]; ll += __shfl_xor(ll, 16); ll += __shfl_xor(ll, 32);
        const float inv = ll > 0.f ? 1.0f / ll : 0.f;
#pragma unroll
        for (int dt = 0; dt < 4; ++dt) { const f32x4 o = O[hh][dt] * inv;
            *(GAS v2u*)(owin + row * 512 + (4 * g + hh) * 64 + 16 * dt + 4 * g4) = (v2u){pkc(o[0], o[1]), pkc(o[2], o[3])}; } }
}

__device__ __forceinline__ void mrg_phase(const bf16* ocmp, const bf16* oslc, const bf16* owin, const float* gates, const bf16* bgp, const bf16* cgp, const bf16* xcp, const float* convw, bf16* merged, int gw, int NGW, int lane) {
    float w0[8], w1[8], w2[8];
#pragma unroll
    for (int j = 0; j < 8; ++j) { w0[j] = convw[8 * lane + j]; w1[j] = convw[512 + 8 * lane + j]; w2[j] = convw[1024 + 8 * lane + j]; }
    for (int row = gw; row < M; row += NGW) {
        const int t = row & (SEQ - 1); const size_t o = (size_t)row * 512 + 8 * lane;
        float a[8], c[8], d[8], att[8];
        unpack8(*(const GAS v4u*)(ocmp + o), a); unpack8(*(const GAS v4u*)(oslc + o), c); unpack8(*(const GAS v4u*)(owin + o), d);
        const float* gr = gates + (size_t)row * NGATE + (lane >> 3) * 3; const float g0 = gr[0], g1 = gr[1], g2 = gr[2];
        float sa = 0.f;
#pragma unroll
        for (int j = 0; j < 8; ++j) { att[j] = g0 * a[j] + g1 * c[j] + g2 * d[j]; sa += att[j] * att[j]; }
        float bgv[8], u0[8], u1[8], u2[8], tmp[8];
        unpack8(*(const GAS v4u*)(bgp + o), bgv);
        unpack8(*(const GAS v4u*)(cgp + o), u2); unpack8(*(const GAS v4u*)(xcp + o), tmp);
#pragma unroll
        for (int j = 0; j < 8; ++j) u2[j] *= tmp[j];
        if (t >= 1) { unpack8(*(const GAS v4u*)(cgp + o - 512), u1); unpack8(*(const GAS v4u*)(xcp + o - 512), tmp);
#pragma unroll
            for (int j = 0; j < 8; ++j) u1[j] *= tmp[j]; }
        else {
#pragma unroll
            for (int j = 0; j < 8; ++j) u1[j] = 0.f; }
        if (t >= 2) { unpack8(*(const GAS v4u*)(cgp + o - 1024), u0); unpack8(*(const GAS v4u*)(xcp + o - 1024), tmp);
#pragma unroll
            for (int j = 0; j < 8; ++j) u0[j] *= tmp[j]; }
        else {
#pragma unroll
            for (int j = 0; j < 8; ++j) u0[j] = 0.f; }
        float y[8]; float sc = 0.f;
#pragma unroll
        for (int j = 0; j < 8; ++j) { y[j] = bgv[j] * (w0[j] * u0[j] + w1[j] * u1[j] + w2[j] * u2[j]); sc += y[j] * y[j]; }
        sa = wave_sum(sa); sc = wave_sum(sc);
        const float ra = 1.0f / sqrtf(sa * (1.0f / 512.0f) + EPS), rc = 1.0f / sqrtf(sc * (1.0f / 512.0f) + EPS);
        v4u wa, wc;
        wa.x = pkc(att[0] * ra, att[1] * ra); wa.y = pkc(att[2] * ra, att[3] * ra); wa.z = pkc(att[4] * ra, att[5] * ra); wa.w = pkc(att[6] * ra, att[7] * ra);
        wc.x = pkc(y[0] * rc, y[1] * rc); wc.y = pkc(y[2] * rc, y[3] * rc); wc.z = pkc(y[4] * rc, y[5] * rc); wc.w = pkc(y[6] * rc, y[7] * rc);
        *(GAS v4u*)(merged + (size_t)row * DM + 8 * lane) = wa; *(GAS v4u*)(merged + (size_t)row * DM + 512 + 8 * lane) = wc;
    }
}

struct Args { const void* in[25]; float* out; unsigned char* ws; int ph_lo, ph_hi, probe, pad; };
__device__ __forceinline__ unsigned char* opaque_ptr(unsigned char* p) { GAS unsigned char* g = (GAS unsigned char*)p; asm volatile("" : "+s"(g)); return (unsigned char*)g; }
__device__ __forceinline__ int opaque_v(int v) { asm volatile("" : "+v"(v)); return v; }
#define PH_LOCALS \
    unsigned char* ws = opaque_ptr(args.ws); \
    const int tid = opaque_v((int)threadIdx.x), lane = tid & 63, wave = __builtin_amdgcn_readfirstlane(tid >> 6); \
    const int G = gridDim.x, bx = blockIdx.x, vcu = (G % 8 == 0) ? (bx % 8) * (G / 8) + bx / 8 : bx, gw = vcu * NWAVES + wave, NGW = G * NWAVES; \
    (void)lane; (void)gw; (void)NGW; (void)ws; (void)bx;
#define INF(k) ((const float*)args.in[k])
#define WSP(T, off) ((T*)(ws + (off)))

__global__ void __launch_bounds__(NWAVES * 64, 2) mk_fwd(Args args) {
    extern __shared__ __attribute__((aligned(16))) unsigned char lds_raw[];
    LAS unsigned char* lds = (LAS unsigned char*)lds_raw;
    const int lo = args.ph_lo, hi = args.ph_hi;
    XcdBarrier bar; bar.bar = (unsigned*)(args.ws + WS_CTL) + CW_BAR; bar.x = 0; bar.st = nullptr;
    {
        const int tid0 = threadIdx.x;
        for (int u = tid0; u < (LDS_BYTES - RING_BYTES) / 4; u += NWAVES * 64) ((LAS unsigned*)(lds + RING_BYTES))[u] = 0u;
        __syncthreads();
        if (hi - lo > 1) bar = xcd_barrier_post((unsigned*)(args.ws + WS_CTL) + CW_BAR, (volatile LAS unsigned*)(lds + MISC_OFF) + 8);
    }
#define IN(k) (lo <= (k) && (k) < hi)
#define SEAM(k) do { if (IN(k) && IN((k) + 1)) { XcdBarrier bb_ = bar; bb_.bar = (unsigned*)opaque_ptr((unsigned char*)bar.bar); asm volatile("" : "+s"(bb_.x)); xcd_barrier(bb_); } } while (0)

    if (EN(0) && IN(0)) {
        PH_LOCALS
        In I;
        I.x = INF(0); I.pos = (const int*)args.in[1]; I.f1_pre = INF(2); I.f1_wg = INF(3); I.f1_wu = INF(4); I.f1_wd = INF(5);
        I.f1_post = INF(6); I.mix_pre = INF(7); I.w_in = INF(8); I.pe_k = INF(9); I.w1_k = INF(10); I.w2_k = INF(11);
        I.pe_v = INF(12); I.w1_v = INF(13); I.w2_v = INF(14); I.conv_w = INF(15); I.aon = INF(16); I.con = INF(17);
        I.w_out = INF(18); I.mix_post = INF(19); I.f2_pre = INF(20); I.f2_wg = INF(21); I.f2_wu = INF(22); I.f2_wd = INF(23); I.f2_post = INF(24);
        pro_weights(I, ws, (LAS float*)(lds + wave * 16384), gw, NGW, lane);
        pro_rope(I.pos, WSP(float, WS_ROPE), vcu * NWAVES * 64 + tid, G * NWAVES * 64);
        pro_x(I.x, WSP(bf16, WS_XB), WSP(float, WS_RSTD), gw, NGW, lane);
    }
    SEAM(0);

    for (int l = 0; l < NLAYER; ++l) {
        const int P = 1 + l * PH_PER_LAYER;
        if (hi <= P || lo >= P + PH_PER_LAYER) continue;
        if (EN(1) && IN(P + 0)) {
            PH_LOCALS
            pg8::Gemm g{WSP(bf16, WS_XB), WSP(const bf16, WS_W + (size_t)l * W_LAYER + WO_GU1), M, 2 * DFF, DM, DM, DM}; pg8::StaticOrder S; S.init(M, 2 * DFF, G, bx);
            pg8::EpiSwiGLU E{WSP(bf16, WS_BIG), DFF, WSP(float, WS_RSTD)};
            pg8::gemm_phase<pg8::EpiSwiGLU, pg8::StaticOrder, true, true>(lds, g, S, E);
        }
        SEAM(P + 0);
        if (EN(2) && IN(P + 1)) {
            PH_LOCALS
            pg8::Gemm g{WSP(bf16, WS_BIG), WSP(const bf16, WS_W + (size_t)l * W_LAYER + WO_D1), M, DM, DFF, DFF, DFF}; pg8::StaticOrder S; S.init(M, DM, G, bx);
            pg8::EpiBf16<0> E{WSP(bf16, WS_H), DM, nullptr, 0, 0, 1.f};
            pg8::gemm_phase<pg8::EpiBf16<0>, pg8::StaticOrder, true, true>(lds, g, S, E);
        }
        SEAM(P + 1);
        if (EN(3) && IN(P + 2)) { PH_LOCALS
            bf16* xo = args.probe ? WSP(bf16, WS_BIG) : WSP(bf16, WS_XB); float* ro = args.probe ? WSP(float, WS_BIG + 170 * MiB) : WSP(float, WS_RSTD);
            if (l == 0) rowpass<true, false>(INF(0), xo, WSP(bf16, WS_H), INF(6) + (size_t)l * DM, 0.5f, ro, gw, NGW, lane);
            else rowpass<false, false>(WSP(bf16, WS_XB), xo, WSP(bf16, WS_H), INF(6) + (size_t)l * DM, 0.5f, ro, gw, NGW, lane); }
        SEAM(P + 2);
        if (EN(4) && IN(P + 3)) {
            PH_LOCALS
            pg8::Gemm g{WSP(bf16, WS_XB), WSP(const bf16, WS_W + (size_t)l * W_LAYER + WO_IN), M, NIN, DM, DM, DM}; pg8::StaticOrder S; S.init(M, NIN, G, bx);
            pg8::EpiInProj E{ws};
            pg8::gemm_phase<pg8::EpiInProj, pg8::StaticOrder, true, true>(lds, g, S, E);
        }
        SEAM(P + 3);
        if (EN(5) && IN(P + 4)) {
            PH_LOCALS
            vretile8(WSP(bf16, WS_VS_RM), WSP(unsigned char, WS_VS_T), gw, NGW, lane); vretile(WSP(bf16, WS_VW_RM), WSP(bf16, WS_VW_T), gw, NGW, lane);
            knorm8_pass(WSP(unsigned char, WS_KS_T), WSP(float, WS_KSN), gw, NGW, lane); knorm_pass(WSP(bf16, WS_KW_T), WSP(float, WS_KWN), gw, NGW, lane);
            if (gw < 8) { const int kv = gw >> 2, c = (gw & 3) * 64 + lane; float sacc = 0.f;
                for (int kc = 0; kc < 16; ++kc) sacc += WSP(float, WS_BIASP)[(kc * 4 + l * 2 + kv) * 256 + c];
                WSP(float, WS_BIAS)[(l * 2 + kv) * 256 + c] = sacc; }
            const int ks = (bx >> 5) & 3;
            pg8::Gemm g{WSP(bf16, WS_KRAW) + ks * 512, WSP(const bf16, WS_W + (size_t)l * W_LAYER + WO_W1) + ks * 512, 8192, 512, 512, 1024, 2048}; pg8::CmpOrder S{G, bx < 128 ? (bx & 31) : (1 << 20)};
            pg8::EpiHid E{WSP(float, WS_HIDP) + (size_t)ks * 8192 * 256};
            pg8::gemm_phase<pg8::EpiHid, pg8::CmpOrder, true, true>(lds, g, S, E);
        }
        SEAM(P + 4);
        if (EN(6) && IN(P + 5)) { PH_LOCALS cmp2_phase(WSP(float, WS_HIDP), WSP(float, WS_BIAS) + l * 512, INF(11) + (size_t)l * 256 * 64, INF(14) + (size_t)l * 256 * 64, WSP(bf16, WS_KC_T), WSP(bf16, WS_VC_T), WSP(float, WS_KCN), gw, NGW, lane); }
        SEAM(P + 5);
        if (EN(7) && IN(P + 6)) {
            PH_LOCALS
            for (int p = gw; p < 2048; p += NGW) { const int bg = p >> 9, i = p & 511;
                bf16* od = args.probe ? WSP(bf16, WS_HIDP) : WSP(bf16, WS_QRAW); int* id = args.probe ? WSP(int, WS_XB) : WSP(int, WS_IDX);
                acmp_item(WSP(bf16, WS_QRAW), od, WSP(bf16, WS_KC_T), WSP(bf16, WS_VC_T), id, WSP(float, WS_KCN), (LAS float*)(lds + wave * 16384), bg, i, lane);
                acmp_item(WSP(bf16, WS_QRAW), od, WSP(bf16, WS_KC_T), WSP(bf16, WS_VC_T), id, WSP(float, WS_KCN), (LAS float*)(lds + wave * 16384), bg, 1023 - i, lane); }
        }
        SEAM(P + 6);
        if (EN(9) && IN(P + 8)) { PH_LOCALS
            if (G == 256) { const int xg = vcu >> 5, wloc = (vcu & 31) * NWAVES + wave;
                aslc8_chunk(WSP(bf16, WS_QROT), WSP(unsigned char, WS_KS_T), WSP(unsigned char, WS_VS_T), WSP(int, WS_IDX), WSP(bf16, WS_OSLC), WSP(float, WS_KSN), xg >> 1, (xg & 1) * 256 + wloc, lane); }
            else { for (int ci = gw; ci < 2048; ci += NGW) aslc8_chunk(WSP(bf16, WS_QROT), WSP(unsigned char, WS_KS_T), WSP(unsigned char, WS_VS_T), WSP(int, WS_IDX), WSP(bf16, WS_OSLC), WSP(float, WS_KSN), ci >> 9, ci & 511, lane); }
        }
        SEAM(P + 8);
        if (EN(10) && IN(P + 9)) { PH_LOCALS for (int p = gw; p < 2048; p += NGW) { const int bg = p >> 9, i = p & 511; bf16* od = args.probe ? WSP(bf16, WS_HIDP) : WSP(bf16, WS_QROT);
            awin_item(WSP(bf16, WS_QROT), od, WSP(bf16, WS_KW_T), WSP(bf16, WS_VW_T), WSP(float, WS_KWN), bg, i, lane); awin_item(WSP(bf16, WS_QROT), od, WSP(bf16, WS_KW_T), WSP(bf16, WS_VW_T), WSP(float, WS_KWN), bg, 1023 - i, lane); } }
        SEAM(P + 9);
        if (EN(11) && IN(P + 10)) { PH_LOCALS mrg_phase(WSP(bf16, WS_QRAW), WSP(bf16, WS_OSLC), WSP(bf16, WS_QROT), WSP(float, WS_GATES), WSP(bf16, WS_BG), WSP(bf16, WS_CG), WSP(bf16, WS_XC), INF(15) + (size_t)l * 3 * 512, (bf16*)args.out, gw, NGW, lane); }
        SEAM(P + 10);
        if (EN(12) && IN(P + 11)) {
            PH_LOCALS
            pg8::Gemm g{(const bf16*)args.out, WSP(const bf16, WS_W + (size_t)l * W_LAYER + WO_O), M, DM, DM, DM, DM}; pg8::StaticOrder S; S.init(M, DM, G, bx);
            pg8::EpiBf16<0> E{WSP(bf16, WS_H), DM, nullptr, 0, 0, 1.f};
            pg8::gemm_phase<pg8::EpiBf16<0>, pg8::StaticOrder, true, true>(lds, g, S, E);
        }
        SEAM(P + 11);
        if (EN(13) && IN(P + 12)) { PH_LOCALS
            bf16* xo = args.probe ? WSP(bf16, WS_BIG) : WSP(bf16, WS_XB); float* ro = args.probe ? WSP(float, WS_BIG + 170 * MiB) : WSP(float, WS_RSTD);
            rowpass<false, false>(WSP(bf16, WS_XB), xo, WSP(bf16, WS_H), INF(19) + (size_t)l * DM, 1.0f, ro, gw, NGW, lane); }
        SEAM(P + 12);
        if (EN(14) && IN(P + 13)) {
            PH_LOCALS
            pg8::Gemm g{WSP(bf16, WS_XB), WSP(const bf16, WS_W + (size_t)l * W_LAYER + WO_GU2), M, 2 * DFF, DM, DM, DM}; pg8::StaticOrder S; S.init(M, 2 * DFF, G, bx);
            pg8::EpiSwiGLU E{WSP(bf16, WS_BIG), DFF, WSP(float, WS_RSTD)};
            pg8::gemm_phase<pg8::EpiSwiGLU, pg8::StaticOrder, true, true>(lds, g, S, E);
        }
        SEAM(P + 13);
        if (EN(15) && IN(P + 14)) {
            PH_LOCALS
            pg8::Gemm g{WSP(bf16, WS_BIG), WSP(const bf16, WS_W + (size_t)l * W_LAYER + WO_D2), M, DM, DFF, DFF, DFF}; pg8::StaticOrder S; S.init(M, DM, G, bx);
            pg8::EpiBf16<0> E{WSP(bf16, WS_H), DM, nullptr, 0, 0, 1.f};
            pg8::gemm_phase<pg8::EpiBf16<0>, pg8::StaticOrder, true, true>(lds, g, S, E);
        }
        SEAM(P + 14);
        if (EN(16) && IN(P + 15)) { PH_LOCALS
            float* ro = args.probe ? WSP(float, WS_BIG + 170 * MiB) : WSP(float, WS_RSTD);
            if (l == NLAYER - 1) rowpass<false, true>(WSP(bf16, WS_XB), args.probe ? (void*)WSP(float, WS_BIG) : (void*)args.out, WSP(bf16, WS_H), INF(24) + (size_t)l * DM, 0.5f, ro, gw, NGW, lane);
            else rowpass<false, false>(WSP(bf16, WS_XB), args.probe ? WSP(bf16, WS_BIG) : WSP(bf16, WS_XB), WSP(bf16, WS_H), INF(24) + (size_t)l * DM, 0.5f, ro, gw, NGW, lane); }
        if (l != NLAYER - 1) SEAM(P + 15);
    }
#undef IN
#undef SEAM
}

extern "C" void kernel_launch(void* const* d_in, const int* in_sizes, int n_in, void* d_out, int out_size, void* d_ws, size_t ws_size, hipStream_t stream) {
    static int grid = 0;
    if (grid == 0) {
        if (n_in != 25 || out_size != M * DM || ws_size < WS_END) { fprintf(stderr, "kernel_launch: unexpected shapes (n_in %d out %d ws %zu)\n", n_in, out_size, ws_size); grid = -1; return; }
        int dev = 0, cus = 0, per_cu = 0;
        if (hipGetDevice(&dev) != hipSuccess || hipDeviceGetAttribute(&cus, hipDeviceAttributeMultiprocessorCount, dev) != hipSuccess) { grid = -1; return; }
        if (hipFuncSetAttribute((const void*)mk_fwd, hipFuncAttributeMaxDynamicSharedMemorySize, LDS_BYTES) != hipSuccess) { fprintf(stderr, "kernel_launch: hipFuncSetAttribute failed\n"); grid = -1; return; }
        if (hipOccupancyMaxActiveBlocksPerMultiprocessor(&per_cu, (const void*)mk_fwd, NWAVES * 64, LDS_BYTES) != hipSuccess || per_cu < 1) fprintf(stderr, "kernel_launch: occupancy query reports %d\n", per_cu);
        (void)hipGetLastError();
        grid = cus;
    }
    if (grid < 0) return;
    if (hipMemsetAsync((char*)d_ws + WS_CTL, 0, CTL_ZERO_BYTES, stream) != hipSuccess) return;
    Args a{};
    for (int i = 0; i < 25; ++i) a.in[i] = d_in[i];
    a.out = (float*)d_out; a.ws = (unsigned char*)d_ws;
#if MK_ONE_LAUNCH
    a.ph_lo = 0; a.ph_hi = N_PHASES;
    hipLaunchKernelGGL(mk_fwd, dim3(grid), dim3(NWAVES * 64), LDS_BYTES, stream, a);
#else
    for (int p = 0; p < N_PHASES; ++p) { a.ph_lo = p; a.ph_hi = p + 1;
#ifdef REP_MASK
        { const int k = p == 0 ? 0 : 1 + (p - 1) % PH_PER_LAYER; if (((REP_MASK) >> k) & 1) { a.probe = 1; hipLaunchKernelGGL(mk_fwd, dim3(grid), dim3(NWAVES * 64), LDS_BYTES, stream, a); a.probe = 0; } }
#endif
        hipLaunchKernelGGL(mk_fwd, dim3(grid), dim3(NWAVES * 64), LDS_BYTES, stream, a);
    }
#endif
}
```

```cpp
#include <hip/hip_runtime.h>
#include <cstdio>
#include <cstdint>

constexpr int NWAVES = 8;
constexpr int BATCH = 2, SEQ = 16384, DM = 1024, M = BATCH * SEQ, DFF = 2816, NIN = 3072, NLAYER = 2;
constexpr int DATT = 512, NGATE = 24, NSELB = 256, KTOP = 16;
constexpr float EPS = 1e-6f;
constexpr float C2 = 0.125f * 1.4426950408889634f;
constexpr size_t MiB = 1u << 20;
constexpr size_t WS_CTL = 0, CTL_ZERO_BYTES = 1 * MiB;
constexpr size_t WS_W = 2 * MiB, W_LAYER = 43 * MiB;
constexpr size_t WO_GU1 = 0, WO_D1 = 11 * MiB, WO_IN = 11 * MiB + 5632 * 1024, WO_O = WO_IN + 6 * MiB, WO_GU2 = WO_O + 2 * MiB, WO_D2 = WO_GU2 + 11 * MiB, WO_W1 = WO_D2 + 5632 * 1024;
static_assert(WO_W1 + 2 * MiB == W_LAYER, "weight map");
constexpr size_t WS_XB = 88 * MiB;
constexpr size_t WS_H = 152 * MiB;
constexpr size_t WS_BIG = 216 * MiB;
constexpr size_t WS_QRAW = WS_BIG, WS_QROT = WS_BIG + 32 * MiB, WS_OSLC = WS_BIG + 64 * MiB, WS_BG = WS_BIG + 96 * MiB, WS_CG = WS_BIG + 128 * MiB, WS_KRAW = WS_BIG + 160 * MiB, WS_VRAW = WS_KRAW + 8 * MiB;
constexpr size_t WS_XC = 392 * MiB, WS_KS_T = 424 * MiB, WS_KW_T = 432 * MiB, WS_VS_T = 440 * MiB, WS_VW_T = 448 * MiB, WS_GATES = 456 * MiB, WS_IDX = 460 * MiB, WS_HID = 464 * MiB;
constexpr size_t WS_KC_T = 472 * MiB, WS_VC_T = WS_KC_T + 512 * 1024, WS_ROPE = 473 * MiB, WS_RSTD = 475 * MiB, WS_BIAS = 476 * MiB, WS_BIASP = WS_BIAS + 64 * 1024, WS_KSN = WS_BIAS + 256 * 1024, WS_KWN = WS_KSN + 16 * 1024, WS_KCN = WS_KWN + 16 * 1024, WS_HIDP = 477 * MiB, WS_END = 509 * MiB;
constexpr size_t WS_VS_RM = WS_H, WS_VW_RM = WS_H + 8 * MiB, WS_SCORES = WS_H;
constexpr int CW_BAR = 4096;
constexpr int CW_KMAX = 64;

constexpr int RING_BYTES = 131072, MISC_OFF = RING_BYTES + 320, LDS_BYTES = 147456;

constexpr int PH_PER_LAYER = 16, N_PHASES = 1 + NLAYER * PH_PER_LAYER;
#ifndef PH_MASK
#define PH_MASK 0x1ffff
#endif
#define EN(k) (((PH_MASK) >> (k)) & 1)
#ifndef MK_ONE_LAUNCH
#define MK_ONE_LAUNCH 1
#endif

namespace pg8 {
#define PG8_LAS __attribute__((address_space(3)))
typedef unsigned short bf16_t;
typedef short bf16x8 __attribute__((ext_vector_type(8)));
typedef float f32x4 __attribute__((ext_vector_type(4)));
typedef unsigned u32x4 __attribute__((ext_vector_type(4)));
constexpr int BM = 256, BK = 64, HALF = 128, HTB = HALF * BK * 2  , STAGE_BYTES = 8 * HTB, NXCD = 8, WGM = 8;

__host__ __device__ __forceinline__ int lds_byte(int r, int c) { const int st = (r >> 4) * 2 + (c >> 5), rr = r & 15, cc = c & 31, ob = rr * 64 + cc * 2; return st * 1024 + (ob ^ (((ob >> 9) & 1) << 5)); }
__host__ __device__ __forceinline__ void stage_rc(int b, int& R, int& C) { const int st = b / 1024, sb = b % 1024, swz = sb ^ (((sb >> 9) & 1) << 5); R = (st >> 1) * 16 + swz / 64; C = (st & 1) * 32 + (swz % 64) / 2; }
__host__ __device__ __forceinline__ int perm32(int rho) { const int n = rho >> 4, i = rho & 15; return 8 * (i >> 2) + 4 * n + (i & 3); }

struct Unit { int pm, pn; };
struct Gemm { const bf16_t* A; const bf16_t* Bt; int M, N, K, lda, ldb; };

struct StaticOrder {
    int nM, nN, nwg, G, c;
    __host__ __device__ void init(int M, int N, int G_, int c_) { nM = M / BM; nN = N / BM; nwg = nM * nN; G = G_; c = c_; }
    __host__ __device__ bool next(int i, Unit& u) const {
        const long L = (long)i * G + c; if (L >= nwg) return false;
        int wgid = (int)L; { const int q = nwg / NXCD, r = nwg % NXCD, xcd = wgid % NXCD, off = wgid / NXCD; wgid = (xcd < r ? xcd * (q + 1) : r * (q + 1) + (xcd - r) * q) + off; }
        const int nig = WGM * nN, gid = wgid / nig, fm = gid * WGM, gsz = (nM - fm) < WGM ? (nM - fm) : WGM;
        u.pm = fm + ((wgid % nig) % gsz); u.pn = (wgid % nig) / gsz; return true;
    }
    __device__ __forceinline__ void a_ready(const Unit&) const {}
    __device__ __forceinline__ void done(const Unit&) const {}
};

__device__ __forceinline__ unsigned cvt_pk_bf16(float lo, float hi) { unsigned r; asm volatile("v_cvt_pk_bf16_f32 %0, %1, %2" : "=v"(r) : "v"(lo), "v"(hi)); return r; }
typedef float f32x2 __attribute__((ext_vector_type(2)));
__device__ __forceinline__ f32x2 gelu_pk(f32x2 v) {
    const f32x2 av = __builtin_elementwise_abs(v), d = av * 0.2316418882f + 1.0f;
    f32x2 t; t.x = __builtin_amdgcn_rcpf(d.x); t.y = __builtin_amdgcn_rcpf(d.y);
    f32x2 q = t * 0.5307027145f + (-0.7265760135f); q = q * t + 0.7107068705f; q = q * t + (-0.142248368f); q = q * t + 0.127414796f; q = q * t;
    const f32x2 s = (v * v) * (-0.72134752044f);
    f32x2 e; e.x = __builtin_amdgcn_exp2f(s.x); e.y = __builtin_amdgcn_exp2f(s.y);
    const f32x2 m = v * (q * e), r = v - m;
    f32x2 o; o.x = v.x < 0.f ? m.x : r.x; o.y = v.y < 0.f ? m.y : r.y; return o;
}

template <int ACT  > struct EpiBf16 {
    static constexpr bool PERM = true, AFTER_DRAIN = false; static_assert(ACT == 0 || ACT == 1, "EpiBf16: ACT is 0 (none) or 1 (gelu_pk)");
    bf16_t* O; int ldc; const float* bias; int split_cols; size_t split_stride; float scale0;
    __device__ __forceinline__ void operator()(const f32x4 (&acc)[2][2][4][2], const Unit& u, int wr, int wc, int fr, int fq) const {
        const int row0 = u.pm * BM + wr * 64 + fr; int colt = u.pn * BM; bf16_t* base = O;
        float sc = 1.f; if (split_cols) { const int t = colt / split_cols; base += (size_t)t * split_stride; colt -= t * split_cols; if (t == 0) sc = scale0; }
        const int col0 = colt + wc * 32 + 8 * fq, bcol0 = u.pn * BM + wc * 32 + 8 * fq;
        f32x4 bv[2][2];
#pragma unroll
        for (int bj = 0; bj < 2; ++bj)
#pragma unroll
            for (int n = 0; n < 2; ++n) bv[bj][n] = bias ? *(const f32x4*)(bias + bcol0 + bj * HALF + 4 * n) : (f32x4){0.f, 0.f, 0.f, 0.f};
#pragma unroll
        for (int ai = 0; ai < 2; ++ai)
#pragma unroll
            for (int m = 0; m < 4; ++m) { bf16_t* rowp = base + (size_t)(row0 + ai * HALF + m * 16) * ldc + col0;
#pragma unroll
                for (int bj = 0; bj < 2; ++bj) { f32x4 v0 = acc[ai][bj][m][0] + bv[bj][0], v1 = acc[ai][bj][m][1] + bv[bj][1];
                    if (ACT == 1) { f32x2 a = gelu_pk((f32x2){v0[0], v0[1]}), b = gelu_pk((f32x2){v0[2], v0[3]}), c = gelu_pk((f32x2){v1[0], v1[1]}), d = gelu_pk((f32x2){v1[2], v1[3]});
                        v0 = (f32x4){a.x, a.y, b.x, b.y}; v1 = (f32x4){c.x, c.y, d.x, d.y}; }
                    v0 = v0 * sc; v1 = v1 * sc; u32x4 w; w.x = cvt_pk_bf16(v0[0], v0[1]); w.y = cvt_pk_bf16(v0[2], v0[3]); w.z = cvt_pk_bf16(v1[0], v1[1]); w.w = cvt_pk_bf16(v1[2], v1[3]);
                    *(u32x4*)(rowp + bj * HALF) = w; } }
    }
};

constexpr int SEQ_ = SEQ;
__device__ __forceinline__ unsigned pk2c(float lo, float hi) { typedef float f2_t __attribute__((ext_vector_type(2))); typedef __bf16 b2_t __attribute__((ext_vector_type(2))); f2_t v = {lo, hi}; b2_t b = __builtin_convertvector(v, b2_t); return __builtin_bit_cast(unsigned, b); }
__device__ __forceinline__ void store8(bf16_t* dst, const f32x4& v0, const f32x4& v1) { u32x4 w; w.x = pk2c(v0[0], v0[1]); w.y = pk2c(v0[2], v0[3]); w.z = pk2c(v1[0], v1[1]); w.w = pk2c(v1[2], v1[3]); *(u32x4*)dst = w; }
__device__ __forceinline__ float silu_f(float x) { return x * __builtin_amdgcn_rcpf(1.0f + __builtin_amdgcn_exp2f(-1.4426950408889634f * x)); }
__device__ __forceinline__ float sigmoid_f(float x) { return __builtin_amdgcn_rcpf(1.0f + __builtin_amdgcn_exp2f(-1.4426950408889634f * x)); }

struct EpiSwiGLU {
    static constexpr bool PERM = true, AFTER_DRAIN = false;
    bf16_t* O; int ldc; const float* rstd;
    __device__ __forceinline__ void operator()(const f32x4 (&acc)[2][2][4][2], const Unit& u, int wr, int wc, int fr, int fq) const {
        const int row0 = u.pm * BM + wr * 64 + fr, col0 = u.pn * 128 + wc * 32 + 8 * fq;
#pragma unroll
        for (int ai = 0; ai < 2; ++ai)
#pragma unroll
            for (int m = 0; m < 4; ++m) { const int r = row0 + ai * HALF + m * 16; const float rs = rstd[r];
                const f32x4 g0 = acc[ai][0][m][0] * rs, g1 = acc[ai][0][m][1] * rs, u0 = acc[ai][1][m][0] * rs, u1 = acc[ai][1][m][1] * rs;
                f32x4 o0, o1;
#pragma unroll
                for (int j = 0; j < 4; ++j) { o0[j] = silu_f(g0[j]) * u0[j]; o1[j] = silu_f(g1[j]) * u1[j]; }
                store8(O + (size_t)r * ldc + col0, o0, o1); }
    }
};

struct EpiHid {
    static constexpr bool PERM = false, AFTER_DRAIN = false;
    float* C;
    __device__ __forceinline__ void operator()(const f32x4 (&acc)[2][2][4][2], const Unit& u, int wr, int wc, int fr, int fq) const {
        const int row0 = u.pm * BM + wr * 64 + fr, col0 = wc * 32 + 4 * fq;
#pragma unroll
        for (int ai = 0; ai < 2; ++ai)
#pragma unroll
            for (int m = 0; m < 4; ++m) { float* rowp = C + (size_t)(row0 + ai * HALF + m * 16) * 256 + col0;
#pragma unroll
                for (int bj = 0; bj < 2; ++bj)
#pragma unroll
                    for (int n = 0; n < 2; ++n) *(f32x4*)(rowp + bj * HALF + n * 16) = acc[ai][bj][m][n]; }
    }
};

__device__ __forceinline__ void rope8(f32x4& v0, f32x4& v1, const float* rope_row, int wc, int fq) {
    if ((wc & 1) == 0) {
        f32x4 o0, o1;
#pragma unroll
        for (int j = 0; j < 4; ++j) { o0[j] = __shfl_xor(v0[j], 16); o1[j] = __shfl_xor(v1[j], 16); }
        if (fq < 2) {
            const f32x4 c0 = *(const f32x4*)(rope_row), c1 = *(const f32x4*)(rope_row + 4), s0 = *(const f32x4*)(rope_row + 8), s1 = *(const f32x4*)(rope_row + 12);
            if (fq == 0) { v0 = v0 * c0 - o0 * s0; v1 = v1 * c1 - o1 * s1; }
            else         { v0 = v0 * c0 + o0 * s0; v1 = v1 * c1 + o1 * s1; }
        }
    }
}

struct EpiInProj {
    static constexpr bool PERM = true, AFTER_DRAIN = false;
    unsigned char* ws;
    __device__ __forceinline__ void operator()(const f32x4 (&acc)[2][2][4][2], const Unit& u, int wr, int wc, int fr, int fq) const {
        const float* rstd = (const float*)(ws + WS_RSTD); const float* rope = (const float*)(ws + WS_ROPE);
        bf16_t* qraw = (bf16_t*)(ws + WS_QRAW); bf16_t* qrot = (bf16_t*)(ws + WS_QROT); bf16_t* kraw = (bf16_t*)(ws + WS_KRAW); bf16_t* vraw = (bf16_t*)(ws + WS_VRAW);
        bf16_t* ks_t = (bf16_t*)(ws + WS_KS_T); bf16_t* vs_rm = (bf16_t*)(ws + WS_VS_RM); bf16_t* kw_t = (bf16_t*)(ws + WS_KW_T); bf16_t* vw_rm = (bf16_t*)(ws + WS_VW_RM);
        bf16_t* bg = (bf16_t*)(ws + WS_BG); bf16_t* cg = (bf16_t*)(ws + WS_CG); bf16_t* xc = (bf16_t*)(ws + WS_XC); float* gates = (float*)(ws + WS_GATES);
        const int pn = u.pn, row0 = u.pm * BM + wr * 64 + fr;
#pragma unroll
        for (int ai = 0; ai < 2; ++ai)
#pragma unroll
            for (int m = 0; m < 4; ++m) {
                const int r = row0 + ai * HALF + m * 16; const float rs = rstd[r];
                const int b = r >> 14, s = r & (SEQ_ - 1);
                const float* rrow = rope + (size_t)r * 16;
#pragma unroll
                for (int bj = 0; bj < 2; ++bj) {
                    f32x4 v0 = acc[ai][bj][m][0] * rs, v1 = acc[ai][bj][m][1] * rs;
                    const int ct = bj * HALF + wc * 32 + 8 * fq;
                    const int c = wc * 32 + 8 * fq, g = c >> 6, d0 = c & 63;
                    if (pn <= 1) {
                        const size_t o = (size_t)r * 512 + pn * 256 + ct;
                        store8(qraw + o, v0, v1);
                        rope8(v0, v1, rrow, wc, fq);
                        store8(qrot + o, v0, v1);
                    } else if (pn == 2) {
                        bf16_t* dst = (bj == 0 ? kraw : vraw) + ((size_t)((b * 2 + g) * SEQ_ + s)) * 64 + d0;
                        store8(dst, v0, v1);
                    } else if (pn <= 4) {
                        if (bj == 0) {
                            rope8(v0, v1, rrow, wc, fq);
                            if (pn == 3) {
                                unsigned char* base8 = (unsigned char*)ks_t + (size_t)(b * 2 + g) * SEQ_ * 64;
                                const int off8 = ((s >> 4) * 64 + ((d0 & 31) >> 3) * 16 + (s & 15)) * 16 + (d0 >> 5) * 8;
                                int w0 = __builtin_amdgcn_cvt_pk_fp8_f32(v0[0], v0[1], 0, false); w0 = __builtin_amdgcn_cvt_pk_fp8_f32(v0[2], v0[3], w0, true);
                                int w1 = __builtin_amdgcn_cvt_pk_fp8_f32(v1[0], v1[1], 0, false); w1 = __builtin_amdgcn_cvt_pk_fp8_f32(v1[2], v1[3], w1, true);
                                typedef unsigned u32x2_t __attribute__((ext_vector_type(2)));
                                *(u32x2_t*)(base8 + off8) = (u32x2_t){(unsigned)w0, (unsigned)w1};
                            } else {
                            bf16_t* base = kw_t + (size_t)(b * 2 + g) * SEQ_ * 64;
                            const int off = (((s >> 4) * 2 + (d0 >> 5)) * 64 + ((d0 & 31) >> 3) * 16 + (s & 15)) * 8;
                            store8(base + off, v0, v1);
                            }
                        } else {
                            bf16_t* dst = (pn == 3 ? vs_rm : vw_rm) + ((size_t)((b * 2 + g) * SEQ_ + s)) * 64 + d0;
                            store8(dst, v0, v1);
                        }
                    } else if (pn <= 10) {
                        bf16_t* base = pn <= 6 ? bg : (pn <= 8 ? cg : xc);
                        store8(base + (size_t)r * 512 + ((pn - 5) & 1) * 256 + ct, v0, v1);
                    } else {
                        if (bj == 0 && wc == 0 && fq < 3) {
                            f32x4 a, bb;
#pragma unroll
                            for (int j = 0; j < 4; ++j) { a[j] = sigmoid_f(v0[j]); bb[j] = sigmoid_f(v1[j]); }
                            float* dst = gates + (size_t)r * 24 + 8 * fq;
                            *(f32x4*)dst = a; *(f32x4*)(dst + 4) = bb;
                        }
                    }
                }
            }
    }
};

struct CmpOrder {
    int G, c;
    __device__ __forceinline__ bool next(int i, Unit& u) const { const int L = i * G + c; if (L >= 32) return false; u.pm = L; u.pn = L >> 4; return true; }
    __device__ __forceinline__ void a_ready(const Unit&) const {}
    __device__ __forceinline__ void done(const Unit&) const {}
};
template <class Epi, class Sched, bool ALIGN_EPI = false, bool SP2 = false>
__device__ __forceinline__ void gemm_phase(PG8_LAS unsigned char* lds, const Gemm g, const Sched& S, const Epi& E) {
    int tid_ = threadIdx.x; asm volatile("" : "+v"(tid_));
    const int tid = tid_, wid = __builtin_amdgcn_readfirstlane(tid >> 6), lane = tid & 63, wr = wid >> 2, wc = wid & 3, fr = lane & 15, fq = lane >> 4;
    const int K = g.K, nt = K / BK;
    unsigned voffA[2], voffB[2];
#pragma unroll
    for (int i = 0; i < 2; ++i) { int R, C; stage_rc(tid * 16 + i * 8192, R, C); const int Rb = Epi::PERM ? ((R & ~31) + perm32(R & 31)) : R;
        voffA[i] = (unsigned)(R * g.lda + C) * 2u; voffB[i] = (unsigned)(Rb * g.ldb + C) * 2u; }
    const size_t kstep = (size_t)(BK * 2);
    const size_t hstepA = (size_t)HALF * g.lda * 2, hstepB = (size_t)HALF * g.ldb * 2;
    const size_t tstepA = 2 * hstepA, tstepB = 2 * hstepB;
    const unsigned ldsw = (unsigned)wid * 1024u;
    const int aoff = lds_byte(wr * 64 + fr, fq * 8), boff = lds_byte(wc * 32 + fr, fq * 8);
#define PG8_SA(b, h) (((b) * 2 + (h)) * HTB)
#define PG8_SB(b, h) ((4 + (b) * 2 + (h)) * HTB)
#define PG8_STAGE(bufoff, gbase, voff) do { _Pragma("unroll") for (int _i = 0; _i < 2; ++_i) \
        __builtin_amdgcn_global_load_lds((const unsigned*)((const char*)(gbase) + (voff)[_i]), (PG8_LAS unsigned*)(lds + (bufoff) + ldsw + _i * 8192), 16, 0, 0); } while (0)
#define PG8_LDA(dst, b, h) do { _Pragma("unroll") for (int m = 0; m < 4; ++m) _Pragma("unroll") for (int k = 0; k < 2; ++k) dst[m][k] = *(const PG8_LAS bf16x8*)(lds + PG8_SA(b, h) + aoff + m * 2048 + k * 1024); } while (0)
#define PG8_LDB(dst, b, h) do { _Pragma("unroll") for (int n = 0; n < 2; ++n) _Pragma("unroll") for (int k = 0; k < 2; ++k) dst[n][k] = *(const PG8_LAS bf16x8*)(lds + PG8_SB(b, h) + boff + n * 2048 + k * 1024); } while (0)
#define PG8_MMA(ai, bj, At, Bt) do { __builtin_amdgcn_s_setprio(1); _Pragma("unroll") for (int m = 0; m < 4; ++m) _Pragma("unroll") for (int n = 0; n < 2; ++n) _Pragma("unroll") for (int k = 0; k < 2; ++k) \
        acc[ai][bj][m][n] = __builtin_amdgcn_mfma_f32_16x16x32_bf16(Bt[n][k], At[m][k], acc[ai][bj][m][n], 0, 0, 0); __builtin_amdgcn_s_setprio(0); } while (0)
#define PG8_WAIT_V(n) asm volatile("s_waitcnt vmcnt(" #n ")" ::: "memory")
#define PG8_WAIT_L(n) asm volatile("s_waitcnt lgkmcnt(" #n ")" ::: "memory")
#define PG8_BAR __builtin_amdgcn_s_barrier()
#define PG8_SCHED __builtin_amdgcn_sched_barrier(0)
    Unit cur, nxt; int ui = 0;
    if (!S.next(0, cur)) return;
    f32x4 acc[2][2][4][2];
#pragma unroll
    for (int a = 0; a < 2; ++a)
#pragma unroll
        for (int b = 0; b < 2; ++b)
#pragma unroll
            for (int m = 0; m < 4; ++m)
#pragma unroll
                for (int n = 0; n < 2; ++n) acc[a][b][m][n] = (f32x4){0.f, 0.f, 0.f, 0.f};
    bf16x8 At[4][2], B0[2][2], B1[2][2];
    const char* cA = (const char*)g.A + (size_t)cur.pm * tstepA; const char* cB = (const char*)g.Bt + (size_t)cur.pn * tstepB;
    S.a_ready(cur);
    if constexpr (SP2) {
        PG8_STAGE(PG8_SB(0, 0), cB, voffB); PG8_STAGE(PG8_SB(0, 1), cB + hstepB, voffB); PG8_STAGE(PG8_SA(0, 0), cA, voffA); PG8_STAGE(PG8_SA(0, 1), cA + hstepA, voffA);
        if (wr == 1) PG8_BAR;
        PG8_WAIT_V(2); PG8_BAR;
        PG8_STAGE(PG8_SB(1, 0), cB + kstep, voffB); PG8_STAGE(PG8_SA(1, 0), cA + kstep, voffA); PG8_STAGE(PG8_SB(1, 1), cB + hstepB + kstep, voffB);
        PG8_WAIT_V(6); PG8_BAR;
    } else {
        PG8_STAGE(PG8_SB(0, 0), cB, voffB); PG8_STAGE(PG8_SA(0, 0), cA, voffA); PG8_STAGE(PG8_SB(0, 1), cB + hstepB, voffB); PG8_STAGE(PG8_SA(0, 1), cA + hstepA, voffA);
        if (wr == 1) PG8_BAR;
        PG8_WAIT_V(4); PG8_BAR;
        PG8_STAGE(PG8_SB(1, 0), cB + kstep, voffB); PG8_STAGE(PG8_SA(1, 0), cA + kstep, voffA); PG8_STAGE(PG8_SB(1, 1), cB + hstepB + kstep, voffB);
        PG8_WAIT_V(6); PG8_BAR;
    }
    for (;;) {
        const bool has_next = S.next(ui + 1, nxt);
        const char* nA = has_next ? (const char*)g.A + (size_t)nxt.pm * tstepA : cA; const char* nB = has_next ? (const char*)g.Bt + (size_t)nxt.pn * tstepB : cB;
        for (int t = 0; t < nt; t += 2) {
            const bool last = (t == nt - 2);
            const char* a1 = cA + (size_t)(t + 1) * kstep;
            const char* a2 = last ? nA : cA + (size_t)(t + 2) * kstep; const char* b2 = last ? nB : cB + (size_t)(t + 2) * kstep;
            const char* a3 = a2 + kstep; const char* b3 = b2 + kstep;
            if (last && has_next) S.a_ready(nxt);
            if constexpr (SP2) {
            PG8_LDB(B0, 0, 0); PG8_LDB(B1, 0, 1); PG8_SCHED; PG8_LDA(At, 0, 0); PG8_STAGE(PG8_SA(1, 1), a1 + hstepA, voffA);
            PG8_WAIT_V(8); PG8_WAIT_L(0); PG8_BAR; PG8_MMA(0, 0, At, B0); PG8_MMA(0, 1, At, B1); PG8_BAR; PG8_SCHED;
            PG8_LDA(At, 0, 1); PG8_STAGE(PG8_SB(0, 0), b2, voffB); PG8_STAGE(PG8_SB(0, 1), b2 + hstepB, voffB); PG8_STAGE(PG8_SA(0, 0), a2, voffA);
            PG8_WAIT_V(8); PG8_WAIT_L(0); PG8_BAR; PG8_MMA(1, 0, At, B0); PG8_MMA(1, 1, At, B1); PG8_BAR; PG8_SCHED;
            PG8_LDB(B0, 1, 0); PG8_LDB(B1, 1, 1); PG8_SCHED; PG8_LDA(At, 1, 0); PG8_STAGE(PG8_SA(0, 1), a2 + hstepA, voffA);
            PG8_WAIT_V(8); PG8_WAIT_L(0); PG8_BAR; PG8_MMA(0, 0, At, B0); PG8_MMA(0, 1, At, B1); PG8_BAR; PG8_SCHED;
            PG8_LDA(At, 1, 1); PG8_STAGE(PG8_SB(1, 0), b3, voffB); PG8_STAGE(PG8_SB(1, 1), b3 + hstepB, voffB); PG8_STAGE(PG8_SA(1, 0), a3, voffA);
            PG8_WAIT_V(8); PG8_WAIT_L(0); PG8_BAR; PG8_MMA(1, 0, At, B0); PG8_MMA(1, 1, At, B1); PG8_BAR; PG8_SCHED;
            } else {
            PG8_LDB(B0, 0, 0); PG8_SCHED; PG8_LDA(At, 0, 0); PG8_STAGE(PG8_SA(1, 1), a1 + hstepA, voffA);
            PG8_WAIT_L(8); PG8_BAR; PG8_WAIT_L(0); PG8_MMA(0, 0, At, B0); PG8_BAR; PG8_SCHED;
            PG8_LDB(B1, 0, 1); PG8_STAGE(PG8_SB(0, 0), b2, voffB);
            PG8_BAR; PG8_WAIT_L(0); PG8_MMA(0, 1, At, B1); PG8_BAR;
            PG8_LDA(At, 0, 1); PG8_STAGE(PG8_SA(0, 0), a2, voffA);
            PG8_BAR; PG8_WAIT_L(0); PG8_MMA(1, 0, At, B0); PG8_BAR; PG8_SCHED;
            PG8_STAGE(PG8_SB(0, 1), b2 + hstepB, voffB);
            PG8_WAIT_V(6); PG8_BAR; PG8_MMA(1, 1, At, B1); PG8_BAR;
            PG8_LDB(B0, 1, 0); PG8_SCHED; PG8_LDA(At, 1, 0); PG8_STAGE(PG8_SA(0, 1), a2 + hstepA, voffA);
            PG8_WAIT_L(8); PG8_BAR; PG8_WAIT_L(0); PG8_MMA(0, 0, At, B0); PG8_BAR; PG8_SCHED;
            PG8_LDB(B1, 1, 1); PG8_STAGE(PG8_SB(1, 0), b3, voffB);
            PG8_BAR; PG8_WAIT_L(0); PG8_MMA(0, 1, At, B1); PG8_BAR;
            PG8_LDA(At, 1, 1); PG8_STAGE(PG8_SA(1, 0), a3, voffA);
            PG8_BAR; PG8_WAIT_L(0); PG8_MMA(1, 0, At, B0); PG8_BAR; PG8_SCHED;
            PG8_STAGE(PG8_SB(1, 1), b3 + hstepB, voffB);
            PG8_WAIT_V(6); PG8_BAR; PG8_MMA(1, 1, At, B1); PG8_BAR;
            }
        }
        if constexpr (ALIGN_EPI) { if (wr == 0) PG8_BAR; }
        if constexpr (!Epi::AFTER_DRAIN) { E(acc, cur, wr, wc, fr, fq); S.done(cur); }
        if (!has_next) break;
#pragma unroll
        for (int a = 0; a < 2; ++a)
#pragma unroll
            for (int b = 0; b < 2; ++b)
#pragma unroll
                for (int m = 0; m < 4; ++m)
#pragma unroll
                    for (int n = 0; n < 2; ++n) acc[a][b][m][n] = (f32x4){0.f, 0.f, 0.f, 0.f};
        cur = nxt; cA = nA; cB = nB; ++ui;
        if constexpr (ALIGN_EPI) { if (wr == 1) PG8_BAR; }
    }
    PG8_WAIT_V(0);
    if constexpr (!ALIGN_EPI) { if (wr == 0) PG8_BAR; }
    PG8_BAR;
    if constexpr (Epi::AFTER_DRAIN) { E.fused(acc, cur, wr, wc, fr, fq, lds, wid, lane); S.done(cur); }
#undef PG8_SA
#undef PG8_SB
#undef PG8_STAGE
#undef PG8_LDA
#undef PG8_LDB
#undef PG8_MMA
#undef PG8_WAIT_V
#undef PG8_WAIT_L
#undef PG8_BAR
#undef PG8_SCHED
}
}
#define GAS __attribute__((address_space(1)))
#define LAS __attribute__((address_space(3)))
typedef unsigned short bf16;
typedef unsigned v4u __attribute__((ext_vector_type(4)));
typedef float f32x4 __attribute__((ext_vector_type(4)));
typedef short bf16x8 __attribute__((ext_vector_type(8)));
typedef GAS unsigned gu32;
typedef GAS unsigned long long gu64;
#define RLX_AGENT __ATOMIC_RELAXED, __HIP_MEMORY_SCOPE_AGENT
#define LDS_WAIT() asm volatile("s_waitcnt lgkmcnt(0)" ::: "memory")
#define VM_WAIT() asm volatile("s_waitcnt vmcnt(0)" ::: "memory")
__device__ __forceinline__ unsigned long long rt() { return __builtin_amdgcn_s_memrealtime(); }
__device__ __forceinline__ unsigned f2bf(float f) { unsigned u = __builtin_bit_cast(unsigned, f); return (u + 0x7fffu + ((u >> 16) & 1u)) >> 16; }
__device__ __forceinline__ unsigned pk2(float lo, float hi) { return f2bf(lo) | (f2bf(hi) << 16); }

#define XB_TMO      128
#define XB_XCNT(j)  (256  + 64 * (j))
#define XB_XSUB(j)  (1280 + 64 * (j))
#define XB_XGEN(j)  (2304 + 64 * (j))
#define XB_TOP      3328
#define XB_TOPGEN   3392
#define XCD_BAR_WORDS 3456
#define XB_SPIN_CAP (1u << 18)

__device__ __forceinline__ unsigned xb_ld(unsigned* p)              { return __hip_atomic_load(p, __ATOMIC_RELAXED, __HIP_MEMORY_SCOPE_AGENT); }
__device__ __forceinline__ unsigned xb_add(unsigned* p, unsigned v) { return __hip_atomic_fetch_add(p, v, __ATOMIC_RELAXED, __HIP_MEMORY_SCOPE_AGENT); }
__device__ __forceinline__ unsigned xb_xcc_id() { return (unsigned)__builtin_amdgcn_s_getreg((3 << 11) | 20) & 0xFu; }
#define XB_SPIN(cond, bar) do { unsigned _sp = 0; while (cond) { __builtin_amdgcn_s_sleep(1); \
    if ((++_sp & 255u) == 0u) { if (xb_ld(&(bar)[XB_TMO])) break; if (_sp > XB_SPIN_CAP) { atomicAdd(&(bar)[XB_TMO], 1u); break; } } } } while (0)

struct XcdBarrier {
    unsigned* bar; unsigned x;
    volatile LAS unsigned* st;
};

__device__ __forceinline__ XcdBarrier xcd_barrier_post(unsigned* bar, volatile LAS unsigned* st) {
    XcdBarrier b; b.bar = bar; b.x = xb_xcc_id(); b.st = st;
    if (threadIdx.x == 0) (void)xb_add(&bar[XB_XCNT(b.x)], 1u);
    return b;
}
__device__ __forceinline__ void xcd_barrier_complete(unsigned* bar, unsigned x, unsigned& nloc, unsigned& nx) {
    const unsigned G = gridDim.x * gridDim.y * gridDim.z;
    unsigned sum, cnt, mine, sp = 0u;
    for (;;) {
        sum = 0u; cnt = 0u; mine = 0u;
#pragma unroll
        for (unsigned j = 0; j < 16; ++j) { const unsigned c = xb_ld(&bar[XB_XCNT(j)]); sum += c; cnt += (c > 0u) ? 1u : 0u; mine = (j == x) ? c : mine; }
        if (sum == G) break;
        __builtin_amdgcn_s_sleep(1);
        if ((++sp & 255u) == 0u) { if (xb_ld(&bar[XB_TMO])) break; if (sp > XB_SPIN_CAP) { atomicAdd(&bar[XB_TMO], 1u); break; } }
    }
    nloc = mine > 0u ? mine : 1u; nx = cnt > 0u ? cnt : 1u;
}

__device__ __forceinline__ void xcd_barrier(const XcdBarrier& b) {
    asm volatile("s_waitcnt vmcnt(0)" ::: "memory");
    __syncthreads();
    int tz_ = threadIdx.x; asm volatile("" : "+v"(tz_));
    if (tz_ == 0) {
        unsigned* bar = b.bar;
        __builtin_amdgcn_s_waitcnt(0);
        unsigned nloc = b.st[0], nx = b.st[1];
        if (nloc == 0u) { xcd_barrier_complete(bar, b.x, nloc, nx); b.st[0] = nloc; b.st[1] = nx; }
        const unsigned old = xb_add(&bar[XB_XSUB(b.x)], 1u);
        const unsigned gen = old / nloc;
        if (old + 1u == (gen + 1u) * nloc) {
            __builtin_amdgcn_fence(__ATOMIC_RELEASE, "agent");
            asm volatile("s_waitcnt vmcnt(0)" ::: "memory");
            const unsigned og = xb_add(&bar[XB_TOP], 1u);
            const unsigned tg = og / nx;
            if (og + 1u == (tg + 1u) * nx) xb_add(&bar[XB_TOPGEN], 1u);
            else XB_SPIN(xb_ld(&bar[XB_TOPGEN]) == tg, bar);
            __builtin_amdgcn_fence(__ATOMIC_ACQUIRE, "agent");
            xb_add(&bar[XB_XGEN(b.x)], 1u);
            asm volatile("s_waitcnt vmcnt(0)" ::: "memory");
        } else {
            XB_SPIN(xb_ld(&bar[XB_XGEN(b.x)]) == gen, bar);
            __builtin_amdgcn_fence(__ATOMIC_ACQUIRE, "agent");
            asm volatile("s_waitcnt vmcnt(0)" ::: "memory");
        }
    }
    __syncthreads();
}

typedef float f32x2 __attribute__((ext_vector_type(2)));
typedef unsigned v2u __attribute__((ext_vector_type(2)));
__device__ __forceinline__ unsigned pkc(float lo, float hi) { return pg8::pk2c(lo, hi); }
__device__ __forceinline__ float bf_lo(unsigned w) { return __uint_as_float(w << 16); }
__device__ __forceinline__ float bf_hi(unsigned w) { return __uint_as_float(w & 0xffff0000u); }
__device__ __forceinline__ float wave_sum(float v) {
#pragma unroll
    for (int o = 1; o < 64; o <<= 1) v += __shfl_xor(v, o);
    return v;
}
__device__ __forceinline__ f32x4 mfma16(bf16x8 a, bf16x8 b, f32x4 c) { return __builtin_amdgcn_mfma_f32_16x16x32_bf16(a, b, c, 0, 0, 0); }
__device__ __forceinline__ float ex2(float x) { return __builtin_amdgcn_exp2f(x); }
__device__ __forceinline__ bf16x8 pack8(const f32x4& a, const f32x4& b) { v4u w; w.x = pkc(a[0], a[1]); w.y = pkc(a[2], a[3]); w.z = pkc(b[0], b[1]); w.w = pkc(b[2], b[3]); return __builtin_bit_cast(bf16x8, w); }

template <bool A4>
__device__ __forceinline__ void tr_item(const float* W, int ldw, int col0, int nvalid, const float* gain, bf16* WT, int ldt, int drow0, LAS float* scr, int kb, int n0, int lane) {
    const int k0 = 64 * kb;
    if (A4) {
        const int rr = lane >> 3, c4 = (lane & 7) * 4;
        f32x4 v[8];
#pragma unroll
        for (int i = 0; i < 8; ++i) v[i] = *(const GAS f32x4*)(W + (size_t)(k0 + 8 * i + rr) * ldw + col0 + n0 + c4);
#pragma unroll
        for (int i = 0; i < 8; ++i) { const int kk = 8 * i + rr; const float gsc = gain ? gain[k0 + kk] : 1.0f;
            scr[kk * 33 + c4 + 0] = v[i].x * gsc; scr[kk * 33 + c4 + 1] = v[i].y * gsc; scr[kk * 33 + c4 + 2] = v[i].z * gsc; scr[kk * 33 + c4 + 3] = v[i].w * gsc; }
    } else {
#pragma unroll
    for (int i = 0; i < 32; ++i) { const int kk = 2 * i + (lane >> 5), n = n0 + (lane & 31);
        float v = (n < nvalid) ? W[(size_t)(k0 + kk) * ldw + col0 + n] : 0.f; if (gain) v *= gain[k0 + kk];
        scr[kk * 33 + (lane & 31)] = v; }
    }
    LDS_WAIT(); asm volatile("" ::: "memory");
    const int c = lane & 7;
#pragma unroll
    for (int j = 0; j < 4; ++j) { const int n = (lane >> 3) + 8 * j; const LAS float* sp = scr + (8 * c) * 33 + n;
        v4u o; o.x = pkc(sp[0 * 33], sp[1 * 33]); o.y = pkc(sp[2 * 33], sp[3 * 33]); o.z = pkc(sp[4 * 33], sp[5 * 33]); o.w = pkc(sp[6 * 33], sp[7 * 33]);
        *(GAS v4u*)(WT + (size_t)(drow0 + n) * ldt + k0 + 8 * c) = o; }
    LDS_WAIT(); asm volatile("" ::: "memory");
}

struct In {
    const float *x; const int* pos;
    const float *f1_pre, *f1_wg, *f1_wu, *f1_wd, *f1_post, *mix_pre, *w_in, *pe_k, *w1_k, *w2_k, *pe_v, *w1_v, *w2_v, *conv_w, *aon, *con, *w_out, *mix_post, *f2_pre, *f2_wg, *f2_wu, *f2_wd, *f2_post;
};

__device__ __forceinline__ void pro_weights(const In& I, unsigned char* ws, LAS float* scr, int gw, int NGW, int lane) {
    constexpr int I_GU = 16 * 88, I_D = 44 * 32, I_INM = 16 * 40, I_ING = 16, I_INC = 16 * 16, I_O = 16 * 32, I_W1 = 32 * 8;
    constexpr int PER_LAYER = 4 * I_GU + 2 * I_D + I_INM + I_ING + 3 * I_INC + I_O + 2 * I_W1;
    for (int it = gw; it < NLAYER * PER_LAYER; it += NGW) {
        const int l = it / PER_LAYER; int r = it % PER_LAYER;
        unsigned char* wl = ws + WS_W + (size_t)l * W_LAYER;
        if (r < I_GU) { const int kb = r / 88, n0 = 32 * (r % 88); tr_item<true>(I.f1_wg + (size_t)l * DM * DFF, DFF, 0, DFF, I.f1_pre + (size_t)l * DM, (bf16*)(wl + WO_GU1), DM, (n0 >> 7) * 256 + (n0 & 127), scr, kb, n0, lane); continue; } r -= I_GU;
        if (r < I_GU) { const int kb = r / 88, n0 = 32 * (r % 88); tr_item<true>(I.f1_wu + (size_t)l * DM * DFF, DFF, 0, DFF, I.f1_pre + (size_t)l * DM, (bf16*)(wl + WO_GU1), DM, (n0 >> 7) * 256 + (n0 & 127) + 128, scr, kb, n0, lane); continue; } r -= I_GU;
        if (r < I_D) { const int kb = r / 32, n0 = 32 * (r % 32); tr_item<true>(I.f1_wd + (size_t)l * DFF * DM, DM, 0, DM, nullptr, (bf16*)(wl + WO_D1), DFF, n0, scr, kb, n0, lane); continue; } r -= I_D;
        if (r < I_GU) { const int kb = r / 88, n0 = 32 * (r % 88); tr_item<true>(I.f2_wg + (size_t)l * DM * DFF, DFF, 0, DFF, I.f2_pre + (size_t)l * DM, (bf16*)(wl + WO_GU2), DM, (n0 >> 7) * 256 + (n0 & 127), scr, kb, n0, lane); continue; } r -= I_GU;
        if (r < I_GU) { const int kb = r / 88, n0 = 32 * (r % 88); tr_item<true>(I.f2_wu + (size_t)l * DM * DFF, DFF, 0, DFF, I.f2_pre + (size_t)l * DM, (bf16*)(wl + WO_GU2), DM, (n0 >> 7) * 256 + (n0 & 127) + 128, scr, kb, n0, lane); continue; } r -= I_GU;
        if (r < I_D) { const int kb = r / 32, n0 = 32 * (r % 32); tr_item<true>(I.f2_wd + (size_t)l * DFF * DM, DM, 0, DM, nullptr, (bf16*)(wl + WO_D2), DFF, n0, scr, kb, n0, lane); continue; } r -= I_D;
        const float* Win = I.w_in + (size_t)l * DM * 2840; const float* mpre = I.mix_pre + (size_t)l * DM; bf16* WI = (bf16*)(wl + WO_IN);
        if (r < I_INM) { const int kb = r / 40, n0 = 32 * (r % 40); tr_item<true>(Win, 2840, 0, 1280, mpre, WI, DM, n0, scr, kb, n0, lane); continue; } r -= I_INM;
        if (r < I_ING) { tr_item<false>(Win, 2840, 1280, 24, mpre, WI, DM, 2816, scr, r, 0, lane); continue; } r -= I_ING;
        if (r < I_INC) { const int kb = r / 16, n0 = 32 * (r % 16); tr_item<true>(Win, 2840, 1304, 512, mpre, WI, DM, 1280 + n0, scr, kb, n0, lane); continue; } r -= I_INC;
        if (r < I_INC) { const int kb = r / 16, n0 = 32 * (r % 16); tr_item<true>(Win, 2840, 1816, 512, mpre, WI, DM, 1792 + n0, scr, kb, n0, lane); continue; } r -= I_INC;
        if (r < I_INC) { const int kb = r / 16, n0 = 32 * (r % 16); tr_item<true>(Win, 2840, 2328, 512, mpre, WI, DM, 2304 + n0, scr, kb, n0, lane); continue; } r -= I_INC;
        if (r < I_O) { const int kb = r / 32, n0 = 32 * (r % 32);
            const float* gn = (kb < 8) ? (I.aon + (size_t)l * 512) : (I.con + (size_t)l * 512 - 512);
            tr_item<true>(I.w_out + (size_t)l * DM * DM, DM, 0, DM, gn, (bf16*)(wl + WO_O), DM, n0, scr, kb, n0, lane); continue; } r -= I_O;
        if (r < I_W1) { const int kb = r / 8, n0 = 32 * (r % 8); tr_item<true>(I.w1_k + (size_t)l * 2048 * 256, 256, 0, 256, nullptr, (bf16*)(wl + WO_W1), 2048, n0, scr, kb, n0, lane); continue; } r -= I_W1;
        { const int kb = r / 8, n0 = 32 * (r % 8); tr_item<true>(I.w1_v + (size_t)l * 2048 * 256, 256, 0, 256, nullptr, (bf16*)(wl + WO_W1), 2048, 256 + n0, scr, kb, n0, lane); }
    }
    for (int i = gw * 64 + lane; i < NLAYER * 28672; i += NGW * 64) { const int l = i / 28672, q = i % 28672;
        *(GAS v4u*)(ws + WS_W + (size_t)l * W_LAYER + WO_IN + (size_t)2848 * DM * 2 + (size_t)q * 16) = (v4u){0u, 0u, 0u, 0u}; }
    for (int j = gw; j < 256; j += NGW) { const int vec = j >> 6, c = ((j >> 4) & 3) * 64 + lane, kc = j & 15, l = vec >> 1, kv = vec & 1;
        const float* pe = (kv == 0 ? I.pe_k : I.pe_v) + (size_t)l * 2048 + 128 * kc; const float* w1 = (kv == 0 ? I.w1_k : I.w1_v) + (size_t)l * 2048 * 256 + (size_t)128 * kc * 256;
        float s0 = 0.f, s1 = 0.f, s2 = 0.f, s3 = 0.f;
#pragma unroll 8
        for (int k = 0; k < 128; k += 4) { s0 += pe[k] * w1[(size_t)k * 256 + c]; s1 += pe[k + 1] * w1[(size_t)(k + 1) * 256 + c]; s2 += pe[k + 2] * w1[(size_t)(k + 2) * 256 + c]; s3 += pe[k + 3] * w1[(size_t)(k + 3) * 256 + c]; }
        ((float*)(ws + WS_BIASP))[(kc * 4 + vec) * 256 + c] = (s0 + s1) + (s2 + s3); }
}

__device__ __forceinline__ void pro_rope(const int* pos, float* rope, int gtid, int nthreads) {
    const double invf[8] = {1.0, 0.19392274474868576, 0.03760603093086393, 0.007292664737217109, 0.001414213562373095, 0.0002742481756762073, 5.318295896944988e-05, 1.031338537721246e-05};
    for (int e = gtid; e < M * 8; e += nthreads) { const int row = e >> 3, i = e & 7;
        double f = 1.0;
#pragma unroll
        for (int q = 0; q < 8; ++q) f = (i == q) ? invf[q] : f;
        const double ang = (double)pos[row] * f;
        const double k = __builtin_rint(ang * 0.15915494309189535);
        const double red = __builtin_fma(-k, 1.2246467991473532e-16 * 2.0, __builtin_fma(-k, 6.283185307179586, ang));
        const float rf = (float)red;
        rope[(size_t)row * 16 + i] = cosf(rf); rope[(size_t)row * 16 + 8 + i] = sinf(rf); }
}

__device__ __forceinline__ void pro_x(const float* x, bf16* xb, float* rstd, int gw, int NGW, int lane) {
    constexpr int R = 4;
    for (int row0 = gw * R; row0 < M; row0 += NGW * R) {
        f32x4 v[R][4]; float s[R];
#pragma unroll
        for (int r = 0; r < R; ++r) { const GAS f32x4* xr = (const GAS f32x4*)(x + (size_t)(row0 + r) * DM) + lane;
#pragma unroll
            for (int j = 0; j < 4; ++j) v[r][j] = xr[64 * j]; }
#pragma unroll
        for (int r = 0; r < R; ++r) { s[r] = 0.f; GAS v2u* o8 = (GAS v2u*)(xb + (size_t)(row0 + r) * DM) + lane;
#pragma unroll
            for (int j = 0; j < 4; ++j) { s[r] += (v[r][j].x * v[r][j].x + v[r][j].y * v[r][j].y) + (v[r][j].z * v[r][j].z + v[r][j].w * v[r][j].w); o8[64 * j] = (v2u){pkc(v[r][j].x, v[r][j].y), pkc(v[r][j].z, v[r][j].w)}; } }
#pragma unroll
        for (int o = 1; o < 64; o <<= 1) {
#pragma unroll
            for (int r = 0; r < R; ++r) s[r] += __shfl_xor(s[r], o); }
        if (lane < R) { float vv = s[0];
#pragma unroll
            for (int r = 1; r < R; ++r) vv = (lane == r) ? s[r] : vv;
            rstd[row0 + lane] = 1.0f / sqrtf(vv * (1.0f / DM) + EPS); }
    }
}

template <bool XIN_F32, bool OUT_F32>
__device__ __forceinline__ void rowpass(const void* xin, void* xout, const bf16* h, const float* gpost, float scale, float* rstd, int gw, int NGW, int lane) {
    constexpr int R = 4;
    f32x4 gv[4];
#pragma unroll
    for (int j = 0; j < 4; ++j) gv[j] = *((const GAS f32x4*)gpost + lane + 64 * j);
    for (int row0 = gw * R; row0 < M; row0 += NGW * R) {
        f32x4 xv[R][4]; v2u hw[R][4];
#pragma unroll
        for (int r = 0; r < R; ++r) { const GAS v2u* hr = (const GAS v2u*)(h + (size_t)(row0 + r) * DM) + lane;
#pragma unroll
            for (int j = 0; j < 4; ++j) { hw[r][j] = hr[64 * j];
                if (XIN_F32) xv[r][j] = *((const GAS f32x4*)((const float*)xin + (size_t)(row0 + r) * DM) + lane + 64 * j);
                else { const v2u w = *((const GAS v2u*)((const bf16*)xin + (size_t)(row0 + r) * DM) + lane + 64 * j); xv[r][j] = (f32x4){bf_lo(w.x), bf_hi(w.x), bf_lo(w.y), bf_hi(w.y)}; } } }
        float s[R];
#pragma unroll
        for (int r = 0; r < R; ++r) { s[r] = 0.f;
#pragma unroll
            for (int j = 0; j < 4; ++j) { const float a = bf_lo(hw[r][j].x), b = bf_hi(hw[r][j].x), c = bf_lo(hw[r][j].y), d = bf_hi(hw[r][j].y); s[r] += (a * a + b * b) + (c * c + d * d); } }
#pragma unroll
        for (int o = 1; o < 64; o <<= 1) {
#pragma unroll
            for (int r = 0; r < R; ++r) s[r] += __shfl_xor(s[r], o); }
        float s2[R];
#pragma unroll
        for (int r = 0; r < R; ++r) { const float rh = scale / sqrtf(s[r] * (1.0f / DM) + EPS); s2[r] = 0.f;
#pragma unroll
            for (int j = 0; j < 4; ++j) { const f32x4 hv = {bf_lo(hw[r][j].x), bf_hi(hw[r][j].x), bf_lo(hw[r][j].y), bf_hi(hw[r][j].y)};
                xv[r][j] = xv[r][j] + hv * gv[j] * rh; s2[r] += (xv[r][j].x * xv[r][j].x + xv[r][j].y * xv[r][j].y) + (xv[r][j].z * xv[r][j].z + xv[r][j].w * xv[r][j].w); } }
#pragma unroll
        for (int r = 0; r < R; ++r) {
#pragma unroll
            for (int j = 0; j < 4; ++j) {
                if (OUT_F32) *((GAS f32x4*)((float*)xout + (size_t)(row0 + r) * DM) + lane + 64 * j) = xv[r][j];
                else *((GAS v2u*)((bf16*)xout + (size_t)(row0 + r) * DM) + lane + 64 * j) = (v2u){pkc(xv[r][j].x, xv[r][j].y), pkc(xv[r][j].z, xv[r][j].w)}; } }
        if (!OUT_F32) {
#pragma unroll
            for (int o = 1; o < 64; o <<= 1) {
#pragma unroll
                for (int r = 0; r < R; ++r) s2[r] += __shfl_xor(s2[r], o); }
            if (lane < R) { float v = s2[0];
#pragma unroll
                for (int r = 1; r < R; ++r) v = (lane == r) ? s2[r] : v;
                rstd[row0 + lane] = 1.0f / sqrtf(v * (1.0f / DM) + EPS); }
        }
    }
}

__device__ __forceinline__ float gelu_tanh(float x) {
    const float u = 0.7978845608028654f * (x + 0.044715f * x * x * x);
    const float e = ex2(2.0f * 1.4426950408889634f * u);
    const float th = 1.0f - 2.0f * __builtin_amdgcn_rcpf(e + 1.0f);
    return 0.5f * x * (1.0f + th);
}
__device__ __forceinline__ int kt_off(int key, int d) { return (((key >> 4) * 2 + (d >> 5)) * 64 + ((d & 31) >> 3) * 16 + (key & 15)) * 8 + (d & 7); }
__device__ __forceinline__ int vt_off(int key, int d) { return ((((key >> 5) * 4 + (d >> 4)) * 64) + ((key & 15) >> 2) * 16 + (d & 15)) * 8 + (key & 3) + 4 * ((key >> 4) & 1); }

__device__ __forceinline__ void cmp2_phase(const float* hidp, const float* bias, const float* w2k, const float* w2v, bf16* kc_t, bf16* vc_t, float* kcn, int gw, int NGW, int lane) {
    const int col = lane & 15, g4 = lane >> 4;
    for (int task = gw; task < 512; task += NGW) {
        const int m0 = 16 * task, kv = m0 >> 12, bg = (m0 >> 10) & 3;
        const float* bs = bias + kv * 256; const float* w2 = kv == 0 ? w2k : w2v;
        f32x4 acc[4] = {{0.f, 0.f, 0.f, 0.f}, {0.f, 0.f, 0.f, 0.f}, {0.f, 0.f, 0.f, 0.f}, {0.f, 0.f, 0.f, 0.f}};
        const float* hrow = hidp + (size_t)(m0 + col) * 256 + 4 * g4;
        f32x4 hv[16];
#pragma unroll
        for (int kk = 0; kk < 16; ++kk) hv[kk] = *(const GAS f32x4*)(hrow + 16 * kk) + *(const GAS f32x4*)(bs + 16 * kk + 4 * g4);
#pragma unroll
        for (int p = 1; p < 4; ++p)
#pragma unroll
            for (int kk = 0; kk < 16; ++kk) hv[kk] = hv[kk] + *(const GAS f32x4*)(hrow + (size_t)p * 8192 * 256 + 16 * kk);
#pragma unroll
        for (int kk = 0; kk < 16; ++kk) {
#pragma unroll
            for (int j = 0; j < 4; ++j) { const float av = gelu_tanh(hv[kk][j]); const float* wr = w2 + (size_t)(16 * kk + 4 * g4 + j) * 64 + col;
#pragma unroll
                for (int nt = 0; nt < 4; ++nt) acc[nt] = __builtin_amdgcn_mfma_f32_16x16x4f32(av, wr[16 * nt], acc[nt], 0, 0, 0); }
        }
        float nmax = 0.f;
#pragma unroll
        for (int r = 0; r < 4; ++r) { const int n = (m0 + 4 * g4 + r) & 1023; float sq = 0.f;
#pragma unroll
            for (int nt = 0; nt < 4; ++nt) { const float o = (n == 1023) ? 0.f : acc[nt][r]; sq += o * o; const int d = 16 * nt + col;
                const unsigned short ob = (unsigned short)(pkc(o, 0.f) & 0xffffu);
                if (kv == 0) kc_t[(size_t)bg * 65536 + kt_off(n, d)] = ob; else vc_t[(size_t)bg * 65536 + vt_off(n, d)] = ob; }
#pragma unroll
            for (int o = 1; o < 16; o <<= 1) sq += __shfl_xor(sq, o);
            nmax = fmaxf(nmax, sq); }
        nmax = fmaxf(nmax, __shfl_xor(nmax, 16)); nmax = fmaxf(nmax, __shfl_xor(nmax, 32));
        if (kv == 0 && lane == 0) kcn[bg * 64 + ((m0 & 1023) >> 4)] = nmax;
    }
}
__device__ __forceinline__ void vretile(const bf16* vrm, bf16* vt, int gw, int NGW, int lane) {
    for (int it = gw; it < 4 * (SEQ / 32); it += NGW) {
        const int bg = it / (SEQ / 32), kg = it % (SEQ / 32);
        const bf16* src = vrm + ((size_t)bg * SEQ + kg * 32) * 64; bf16* dst = vt + (size_t)bg * SEQ * 64;
#pragma unroll
        for (int g4 = 0; g4 < 4; ++g4) { unsigned short e[8];
#pragma unroll
            for (int j = 0; j < 8; ++j) { const int key = 4 * g4 + (j & 3) + 16 * (j >> 2); e[j] = src[key * 64 + lane]; }
            v4u w; w.x = e[0] | ((unsigned)e[1] << 16); w.y = e[2] | ((unsigned)e[3] << 16); w.z = e[4] | ((unsigned)e[5] << 16); w.w = e[6] | ((unsigned)e[7] << 16);
            *(GAS v4u*)(dst + (size_t)((kg * 4 + (lane >> 4)) * 64 + g4 * 16 + (lane & 15)) * 8) = w; }
    }
}

__device__ __forceinline__ void unpack8(const v4u w, float (&f)[8]) { f[0] = bf_lo(w.x); f[1] = bf_hi(w.x); f[2] = bf_lo(w.y); f[3] = bf_hi(w.y); f[4] = bf_lo(w.z); f[5] = bf_hi(w.z); f[6] = bf_lo(w.w); f[7] = bf_hi(w.w); }

__device__ __forceinline__ float wave_max(float v) {
#pragma unroll
    for (int o = 1; o < 64; o <<= 1) v = fmaxf(v, __shfl_xor(v, o));
    return v;
}
__device__ __forceinline__ void knorm_pass(const bf16* k_t, float* kn, int gw, int NGW, int lane) {
    for (int it = gw; it < 4 * (SEQ / 16); it += NGW) {
        const bf16* p = k_t + (size_t)it * 1024 + lane * 8;
        const v4u a = *(const GAS v4u*)p, b = *(const GAS v4u*)(p + 512);
        float f[8], s = 0.f;
        unpack8(a, f);
#pragma unroll
        for (int j = 0; j < 8; ++j) s += f[j] * f[j];
        unpack8(b, f);
#pragma unroll
        for (int j = 0; j < 8; ++j) s += f[j] * f[j];
        s += __shfl_xor(s, 16); s += __shfl_xor(s, 32);
#pragma unroll
        for (int o = 1; o < 16; o <<= 1) s = fmaxf(s, __shfl_xor(s, o));
        if (lane == 0) kn[it] = s;
    }
}

__device__ __forceinline__ int mbcnt64(unsigned long long m) { return (int)__builtin_amdgcn_mbcnt_hi((unsigned)(m >> 32), __builtin_amdgcn_mbcnt_lo((unsigned)m, 0u)); }
__device__ __forceinline__ void sel_one(const f32x4 sv, int t, int* dst, int lane) {
    const int cur = t >> 6;
    unsigned u[4]; bool ok[4];
#pragma unroll
    for (int k = 0; k < 4; ++k) { const int j = 4 * lane + k; ok[k] = j <= cur; const bool forced = (j == 0) || (j == cur) || (j == cur - 1);
        const float v = forced ? 1e9f : fmaxf(sv[k], 0.f); u[k] = ok[k] ? __float_as_uint(v) : 0u; }
    bool sel[4];
    if (cur + 1 <= KTOP) {
#pragma unroll
        for (int k = 0; k < 4; ++k) sel[k] = ok[k];
    } else {
        unsigned tau = 0u;
#pragma unroll 1
        for (int bit = 30; bit >= 0; --bit) { const unsigned cand = tau | (1u << bit);
            const int cnt = __builtin_popcountll(__ballot(ok[0] && u[0] >= cand)) + __builtin_popcountll(__ballot(ok[1] && u[1] >= cand)) + __builtin_popcountll(__ballot(ok[2] && u[2] >= cand)) + __builtin_popcountll(__ballot(ok[3] && u[3] >= cand));
            if (cnt >= KTOP) tau = cand;
            if (cnt == KTOP) break; }
        bool gt[4], eq[4]; unsigned long long em[4]; int ngt = 0;
#pragma unroll
        for (int k = 0; k < 4; ++k) { gt[k] = ok[k] && u[k] > tau; eq[k] = ok[k] && u[k] == tau; ngt += __builtin_popcountll(__ballot(gt[k])); em[k] = __ballot(eq[k]); }
        const int need = KTOP - ngt;
        int rank = mbcnt64(em[0]) + mbcnt64(em[1]) + mbcnt64(em[2]) + mbcnt64(em[3]);
#pragma unroll
        for (int k = 0; k < 4; ++k) { sel[k] = gt[k] || (eq[k] && rank < need); rank += eq[k] ? 1 : 0; }
    }
    unsigned long long sm[4];
#pragma unroll
    for (int k = 0; k < 4; ++k) sm[k] = __ballot(sel[k]);
    int pos = mbcnt64(sm[0]) + mbcnt64(sm[1]) + mbcnt64(sm[2]) + mbcnt64(sm[3]);
    const int total = __builtin_popcountll(sm[0]) + __builtin_popcountll(sm[1]) + __builtin_popcountll(sm[2]) + __builtin_popcountll(sm[3]);
#pragma unroll
    for (int k = 0; k < 4; ++k) { if (sel[k] && pos < KTOP) dst[pos] = 4 * lane + k; pos += sel[k] ? 1 : 0; }
    if (lane >= total && lane < KTOP) dst[lane] = -1;
}

__device__ __forceinline__ void acmp_item(const bf16* qraw, bf16* ocmp, const bf16* kc_t, const bf16* vc_t, int* idx, const float* kcn, LAS float* sw, int bg, int qt, int lane) {
    const int col = lane & 15, g4 = lane >> 4, b = bg >> 1, g = bg & 1;
    const int t = 16 * qt + col; const size_t row = (size_t)b * SEQ + t;
    const int nmax = (t - 31) >> 4;
    const int ntiles = (qt + 15) >> 4;
    bf16x8 qf[4][2]; float shift[4];
    const float kmx = wave_max(kcn[bg * 64 + lane]);
#pragma unroll
    for (int hh = 0; hh < 4; ++hh) { float qn = 0.f;
#pragma unroll
        for (int s = 0; s < 2; ++s) { qf[hh][s] = *(const bf16x8*)(qraw + row * 512 + (4 * g + hh) * 64 + 32 * s + 8 * g4); float f[8]; unpack8(__builtin_bit_cast(v4u, qf[hh][s]), f);
#pragma unroll
            for (int j = 0; j < 8; ++j) qn += f[j] * f[j]; }
        qn += __shfl_xor(qn, 16); qn += __shfl_xor(qn, 32);
        shift[hh] = C2 * sqrtf(qn * kmx) * 1.01f + 1e-6f; }
    const bf16* kb = kc_t + (size_t)bg * 65536 + lane * 8; const bf16* vb = vc_t + (size_t)bg * 65536 + lane * 8;
    const f32x4 zero = {0.f, 0.f, 0.f, 0.f};
    if (__any(shift[0] > 60.f || shift[1] > 60.f || shift[2] > 60.f || shift[3] > 60.f)) {
        float mx[4] = {-1e30f, -1e30f, -1e30f, -1e30f};
        for (int T = 0; T < ntiles; ++T) { const bf16x8 k0 = *(const bf16x8*)(kb + (T * 2 + 0) * 512), k1 = *(const bf16x8*)(kb + (T * 2 + 1) * 512);
#pragma unroll
            for (int hh = 0; hh < 4; ++hh) { f32x4 s = mfma16(k0, qf[hh][0], zero); s = mfma16(k1, qf[hh][1], s);
#pragma unroll
                for (int r = 0; r < 4; ++r) mx[hh] = ((16 * T + 4 * g4 + r) <= nmax) ? fmaxf(mx[hh], s[r] * C2) : mx[hh]; } }
#pragma unroll
        for (int hh = 0; hh < 4; ++hh) { float m = fmaxf(mx[hh], __shfl_xor(mx[hh], 16)); m = fmaxf(m, __shfl_xor(m, 32)); shift[hh] = m; }
    }
    float ls[4] = {0.f, 0.f, 0.f, 0.f};
    if (ntiles > 0) {
        bf16x8 k0 = *(const bf16x8*)(kb), k1 = *(const bf16x8*)(kb + 512);
        for (int T = 0; T < ntiles; ++T) {
            const int Tn = (T + 1 < ntiles) ? T + 1 : T;
            const bf16x8 n0 = *(const bf16x8*)(kb + (Tn * 2 + 0) * 512), n1 = *(const bf16x8*)(kb + (Tn * 2 + 1) * 512);
            const bool full = (16 * T + 15) <= qt - 2;
#pragma unroll
            for (int hh = 0; hh < 4; ++hh) { f32x4 s = mfma16(k0, qf[hh][0], zero); s = mfma16(k1, qf[hh][1], s);
                if (full) {
#pragma unroll
                    for (int r = 0; r < 4; ++r) ls[hh] += ex2(__builtin_fmaf(s[r], C2, -shift[hh]));
                } else {
#pragma unroll
                    for (int r = 0; r < 4; ++r) ls[hh] += ((16 * T + 4 * g4 + r) <= nmax) ? ex2(__builtin_fmaf(s[r], C2, -shift[hh])) : 0.f; } }
            k0 = n0; k1 = n1;
        }
    }
#pragma unroll
    for (int hh = 0; hh < 4; ++hh) { float l = ls[hh]; l += __shfl_xor(l, 16); l += __shfl_xor(l, 32); ls[hh] = l > 0.f ? 1.0f / l : 0.f; }
    f32x4 O[4][4];
#pragma unroll
    for (int hh = 0; hh < 4; ++hh)
#pragma unroll
        for (int dt = 0; dt < 4; ++dt) O[hh][dt] = zero;
    float carry = 0.f;
    const int npairs = (ntiles + 1) >> 1;
    LAS float* srow = sw + col * 256;
    bf16x8 kfn[2][2];
    if (npairs > 0) {
#pragma unroll
        for (int tt = 0; tt < 2; ++tt)
#pragma unroll
            for (int s = 0; s < 2; ++s) kfn[tt][s] = *(const bf16x8*)(kb + (tt * 2 + s) * 512);
    }
    for (int kg = 0; kg < npairs; ++kg) {
        bf16x8 vf[4], kf[2][2];
#pragma unroll
        for (int dt = 0; dt < 4; ++dt) vf[dt] = *(const bf16x8*)(vb + (kg * 4 + dt) * 512);
#pragma unroll
        for (int tt = 0; tt < 2; ++tt)
#pragma unroll
            for (int s = 0; s < 2; ++s) kf[tt][s] = kfn[tt][s];
        { const int kn = (kg + 1 < npairs) ? kg + 1 : kg;
#pragma unroll
          for (int tt = 0; tt < 2; ++tt)
#pragma unroll
              for (int s = 0; s < 2; ++s) kfn[tt][s] = *(const bf16x8*)(kb + ((2 * kn + tt) * 2 + s) * 512); }
        float aa[2] = {0.f, 0.f}, bb[2] = {0.f, 0.f};
        const bool full0 = (32 * kg + 15) <= qt - 2, full1 = (32 * kg + 31) <= qt - 2;
#pragma unroll
        for (int hh = 0; hh < 4; ++hh) {
            f32x4 p[2];
#pragma unroll
            for (int tt = 0; tt < 2; ++tt) {
                const int T = 2 * kg + tt;
                f32x4 s = mfma16(kf[tt][0], qf[hh][0], zero); s = mfma16(kf[tt][1], qf[hh][1], s);
#pragma unroll
                for (int r = 0; r < 4; ++r) p[tt][r] = ex2(__builtin_fmaf(s[r], C2, -shift[hh])) * ls[hh];
                if (!(tt == 0 ? full0 : full1)) {
#pragma unroll
                    for (int r = 0; r < 4; ++r) p[tt][r] = ((16 * T + 4 * g4 + r) <= nmax) ? p[tt][r] : 0.f; }
                aa[tt] += 2.0f * (p[tt][0] + p[tt][1] + p[tt][2]) + p[tt][3]; bb[tt] += p[tt][3];
            }
            const bf16x8 pf = pack8(p[0], p[1]);
#pragma unroll
            for (int dt = 0; dt < 4; ++dt) O[hh][dt] = mfma16(vf[dt], pf, O[hh][dt]);
        }
#pragma unroll
        for (int tt = 0; tt < 2; ++tt) {
            const int T = 2 * kg + tt;
            const float bsh = __shfl(bb[tt], (lane + 48) & 63);
            const float val = aa[tt] + (g4 == 0 ? carry : bsh);
            carry = bsh;
            srow[4 * T + g4] = val;
        }
    }
    for (int j = 8 * npairs + g4; j < NSELB; j += 4) srow[j] = (j == 8 * npairs) ? carry : 0.f;
#pragma unroll
    for (int hh = 0; hh < 4; ++hh)
#pragma unroll
        for (int dt = 0; dt < 4; ++dt) { const f32x4 o = O[hh][dt];
            *(GAS v2u*)(ocmp + row * 512 + (4 * g + hh) * 64 + 16 * dt + 4 * g4) = (v2u){pkc(o[0], o[1]), pkc(o[2], o[3])}; }
    asm volatile("s_waitcnt lgkmcnt(0)" ::: "memory");
    for (int qi = 0; qi < 16; ++qi) {
        const f32x4 sv = *((const LAS f32x4*)(sw + qi * 256) + lane);
        const int tq = 16 * qt + qi;
        sel_one(sv, tq, idx + (((size_t)b * SEQ + tq) * 2 + g) * KTOP, lane);
    }
    asm volatile("s_waitcnt lgkmcnt(0)" ::: "memory");
}

typedef long fp8x8;
__device__ __forceinline__ f32x4 mfma8(fp8x8 a, fp8x8 b, f32x4 c) { return __builtin_amdgcn_mfma_f32_16x16x32_fp8_fp8(a, b, c, 0, 0, 0); }
__device__ __forceinline__ unsigned pk4_fp8(float a, float b, float c, float d) { int w = __builtin_amdgcn_cvt_pk_fp8_f32(a, b, 0, false); w = __builtin_amdgcn_cvt_pk_fp8_f32(c, d, w, true); return (unsigned)w; }
__device__ __forceinline__ fp8x8 mk64(unsigned lo, unsigned hi) { return (fp8x8)(((unsigned long long)hi << 32) | (unsigned long long)lo); }
struct K8 { v4u k[4]; };
struct V8 { v4u v[2][2]; };
__device__ __forceinline__ void k8_load(K8& f, const unsigned char* kg8, unsigned lane16, int blk) {
    const GAS unsigned char* pb = (const GAS unsigned char*)(kg8 + (size_t)blk * 4096); asm volatile("" : "+s"(pb));
#pragma unroll
    for (int T = 0; T < 4; ++T) f.k[T] = *(const GAS v4u*)(pb + T * 1024 + lane16);
}
__device__ __forceinline__ void v8_load(V8& f, const unsigned char* vg8, unsigned lane16, int blk) {
    const GAS unsigned char* pb = (const GAS unsigned char*)(vg8 + (size_t)blk * 4096); asm volatile("" : "+s"(pb));
#pragma unroll
    for (int ks = 0; ks < 2; ++ks)
#pragma unroll
        for (int dp = 0; dp < 2; ++dp) f.v[ks][dp] = *(const GAS v4u*)(pb + (ks * 2 + dp) * 1024 + lane16);
}
template <bool ONLINE>
__device__ __forceinline__ void slc8_qk(const K8& fk, const fp8x8 (&qf)[2], f32x4 (&e)[4], f32x4 (&O)[4], float shift, float& Mx, float& l, int blk, bool diag, int t, int g4) {
    const f32x4 zero = {0.f, 0.f, 0.f, 0.f};
#pragma unroll
    for (int T = 0; T < 4; ++T) { f32x4 s = mfma8(mk64(fk.k[T].x, fk.k[T].y), qf[0], zero); s = mfma8(mk64(fk.k[T].z, fk.k[T].w), qf[1], s);
#pragma unroll
        for (int r = 0; r < 4; ++r) e[T][r] = ONLINE ? s[r] * C2 : ex2(__builtin_fmaf(s[r], C2, 8.0f - shift)); }
    if (diag) {
#pragma unroll
        for (int T = 0; T < 4; ++T)
#pragma unroll
            for (int r = 0; r < 4; ++r) e[T][r] = ((64 * blk + 16 * T + 4 * g4 + r) <= t) ? e[T][r] : (ONLINE ? -1e30f : 0.f);
    }
    if (ONLINE) {
        float mt = -1e30f;
#pragma unroll
        for (int T = 0; T < 4; ++T) mt = fmaxf(mt, fmaxf(fmaxf(e[T][0], e[T][1]), fmaxf(e[T][2], e[T][3])));
        mt = fmaxf(mt, __shfl_xor(mt, 16)); mt = fmaxf(mt, __shfl_xor(mt, 32));
        const float Mn = fmaxf(Mx, mt), alpha = ex2(Mx - Mn); Mx = Mn; l *= alpha;
#pragma unroll
        for (int dt = 0; dt < 4; ++dt) O[dt] = O[dt] * alpha;
#pragma unroll
        for (int T = 0; T < 4; ++T)
#pragma unroll
            for (int r = 0; r < 4; ++r) e[T][r] = (e[T][r] > -1e29f) ? ex2(e[T][r] - Mn + 8.0f) : 0.f;
    }
    float add = 0.f;
#pragma unroll
    for (int T = 0; T < 4; ++T) add += (e[T][0] + e[T][1]) + (e[T][2] + e[T][3]);
    l += add;
}
__device__ __forceinline__ void slc8_pv(const V8& fv, const f32x4 (&e)[4], f32x4 (&O)[4]) {
#pragma unroll
    for (int ks = 0; ks < 2; ++ks) {
        const fp8x8 pf = mk64(pk4_fp8(e[2 * ks][0], e[2 * ks][1], e[2 * ks][2], e[2 * ks][3]), pk4_fp8(e[2 * ks + 1][0], e[2 * ks + 1][1], e[2 * ks + 1][2], e[2 * ks + 1][3]));
#pragma unroll
        for (int dp = 0; dp < 2; ++dp) { O[2 * dp] = mfma8(mk64(fv.v[ks][dp].x, fv.v[ks][dp].y), pf, O[2 * dp]); O[2 * dp + 1] = mfma8(mk64(fv.v[ks][dp].z, fv.v[ks][dp].w), pf, O[2 * dp + 1]); }
    }
}
template <bool ONLINE>
__device__ __forceinline__ void slc8_compute(const K8& fk, const V8& fv, const fp8x8 (&qf)[2], f32x4 (&O)[4], float shift, float& Mx, float& l, int blk, bool diag, int t, int g4) {
    f32x4 e[4]; slc8_qk<ONLINE>(fk, qf, e, O, shift, Mx, l, blk, diag, t, g4); slc8_pv(fv, e, O);
}
__device__ __forceinline__ unsigned opaque_u(unsigned v) { asm volatile("" : "+v"(v)); return v; }
template <bool ONLINE>
__device__ __forceinline__ void slc8_compute_lds(const LAS unsigned char* slot_, int lane, const fp8x8 (&qf)[2], f32x4 (&O)[4], float shift, float& Mx, float& l, int blk, bool diag, int t, int g4) {
    const LAS unsigned char* slot = (const LAS unsigned char*)(size_t)opaque_u((unsigned)(size_t)slot_) + lane * 16;
    f32x4 e[4];
    { K8 fk;
#pragma unroll
      for (int T = 0; T < 4; ++T) fk.k[T] = *(const LAS v4u*)(slot + T * 1024);
      slc8_qk<ONLINE>(fk, qf, e, O, shift, Mx, l, blk, diag, t, g4); }
    { V8 fv;
#pragma unroll
      for (int ks = 0; ks < 2; ++ks)
#pragma unroll
          for (int dp = 0; dp < 2; ++dp) fv.v[ks][dp] = *(const LAS v4u*)(slot + 4096 + (ks * 2 + dp) * 1024);
      slc8_pv(fv, e, O); }
}
struct KV8 { K8 k; V8 v; };
__device__ __forceinline__ void kv8_load(KV8& f, const unsigned char* kg8, const unsigned char* vg8, unsigned lane16, int blk) { k8_load(f.k, kg8, lane16, blk); v8_load(f.v, vg8, lane16, blk); }
template <bool ONLINE>
__device__ __forceinline__ void slc8_stream(KV8& sa, const unsigned char* kb8, const unsigned char* vb8, unsigned lane16, const fp8x8 (&qf)[2], f32x4 (&O)[4], float shift, float& Mx, float& l,
                                            int myidx, int k1, int nxt_blk, int t, int g4) {
    KV8 sb;
    for (int k = 1; k < k1; k += 2) {
        const int b0 = __builtin_amdgcn_readlane(myidx, k);
        const bool has1 = (k + 1 < k1);
        const int b1 = has1 ? __builtin_amdgcn_readlane(myidx, k + 1) : 0;
        if (has1) kv8_load(sb, kb8, vb8, lane16, b1);
        slc8_compute<ONLINE>(sa.k, sa.v, qf, O, shift, Mx, l, b0, false, t, g4);
        if (has1) {
            if (k + 2 < k1) kv8_load(sa, kb8, vb8, lane16, __builtin_amdgcn_readlane(myidx, k + 2));
            slc8_compute<ONLINE>(sb.k, sb.v, qf, O, shift, Mx, l, b1, false, t, g4);
        }
    }
    if (nxt_blk >= 0) kv8_load(sa, kb8, vb8, lane16, nxt_blk);
}
__device__ __forceinline__ void aslc8_group(const bf16* qrot, const unsigned char* ks8, const unsigned char* vs8, const int* idx, bf16* oslc, const float* ksn, LAS unsigned char* lds, int bg, int cb, int tid, int wave, int lane) {
    const int col = lane & 15, g4 = lane >> 4, b = bg >> 1, g = bg & 1;
    const int c = 8 * cb + wave, cur = c >> 1, t0 = 32 * c;
    const unsigned char* kg8 = ks8 + (size_t)bg * (SEQ * 64); const unsigned char* vg8 = vs8 + (size_t)bg * (SEQ * 64);
    { v4u st[6];
#pragma unroll
      for (int sl = 0; sl < 6; ++sl) { int blk = sl == 0 ? 0 : 4 * cb - 2 + sl; blk = blk < 0 ? 0 : blk;
          st[sl] = *(const GAS v4u*)((tid < 256 ? kg8 : vg8) + (size_t)blk * 4096 + (tid & 255) * 16); }
#pragma unroll
      for (int sl = 0; sl < 6; ++sl) *(LAS v4u*)(lds + sl * 8192 + tid * 16) = st[sl]; }
    __syncthreads();
    const LAS unsigned char* slot0 = lds; const LAS unsigned char* slotA = lds + (1 + (wave >> 1)) * 8192; const LAS unsigned char* slotB = lds + (2 + (wave >> 1)) * 8192;
    const unsigned lane16 = (unsigned)lane * 16u;
    const int ntail = cur >= 2 ? 2 : cur;
    const int* ip = idx + (((size_t)b * SEQ + t0) * 2 + g) * KTOP;
    int myidx = (lane < KTOP) ? ip[lane] : -1;
    int nsel = __builtin_popcountll(__ballot(myidx >= 0));
    KV8 sa;
    if (nsel - ntail > 1) kv8_load(sa, kg8, vg8, lane16, __builtin_amdgcn_readlane(myidx, 1));
    const f32x4 zero = {0.f, 0.f, 0.f, 0.f};
    for (int qi = 0; qi < 32; ++qi) {
        const int t = t0 + qi; const size_t row = (size_t)b * SEQ + t;
        const int k1 = nsel - ntail;
        int idx_next = -1, nsel_next = 0, nxt_blk = -1;
        if (qi + 1 < 32) { idx_next = (lane < KTOP) ? ip[(size_t)(qi + 1) * 2 * KTOP + lane] : -1; nsel_next = __builtin_popcountll(__ballot(idx_next >= 0));
            if (nsel_next - ntail > 1) nxt_blk = __builtin_amdgcn_readlane(idx_next, 1); }
        fp8x8 qf[2]; float qn = 0.f;
#pragma unroll
        for (int s = 0; s < 2; ++s) { float f[8];
            if (col < 4) unpack8(*(const GAS v4u*)(qrot + row * 512 + (4 * g + col) * 64 + 32 * s + 8 * g4), f); else {
#pragma unroll
                for (int j = 0; j < 8; ++j) f[j] = 0.f; }
            const unsigned w0 = pk4_fp8(f[0], f[1], f[2], f[3]), w1 = pk4_fp8(f[4], f[5], f[6], f[7]); qf[s] = mk64(w0, w1);
            { const float a0 = __builtin_amdgcn_cvt_f32_fp8((int)w0, 0), a1 = __builtin_amdgcn_cvt_f32_fp8((int)w0, 1), a2 = __builtin_amdgcn_cvt_f32_fp8((int)w0, 2), a3 = __builtin_amdgcn_cvt_f32_fp8((int)w0, 3);
              const float b0 = __builtin_amdgcn_cvt_f32_fp8((int)w1, 0), b1 = __builtin_amdgcn_cvt_f32_fp8((int)w1, 1), b2 = __builtin_amdgcn_cvt_f32_fp8((int)w1, 2), b3 = __builtin_amdgcn_cvt_f32_fp8((int)w1, 3);
              qn += (a0 * a0 + a1 * a1) + (a2 * a2 + a3 * a3) + (b0 * b0 + b1 * b1) + (b2 * b2 + b3 * b3); } }
        qn += __shfl_xor(qn, 16); qn += __shfl_xor(qn, 32);
        const int bsel = __shfl(myidx, lane >> 2);
        const float kmx = wave_max(bsel >= 0 ? ksn[bg * (SEQ / 16) + bsel * 4 + (lane & 3)] : 0.f);
        const float shift = C2 * sqrtf(qn * kmx) * 1.0001f + 1e-6f;
        f32x4 O[4] = {zero, zero, zero, zero}; float l = 0.f, Mx = -1e30f;
        if (!__any(shift > 60.0f)) {
            slc8_compute_lds<false>(slot0, lane, qf, O, shift, Mx, l, 0, cur == 0, t, g4);
            slc8_stream<false>(sa, kg8, vg8, lane16, qf, O, shift, Mx, l, myidx, k1, nxt_blk, t, g4);
            if (cur >= 2) slc8_compute_lds<false>(slotA, lane, qf, O, shift, Mx, l, cur - 1, false, t, g4);
            if (cur >= 1) slc8_compute_lds<false>(slotB, lane, qf, O, shift, Mx, l, cur, true, t, g4);
        } else {
            slc8_compute_lds<true>(slot0, lane, qf, O, shift, Mx, l, 0, cur == 0, t, g4);
            slc8_stream<true>(sa, kg8, vg8, lane16, qf, O, shift, Mx, l, myidx, k1, nxt_blk, t, g4);
            if (cur >= 2) slc8_compute_lds<true>(slotA, lane, qf, O, shift, Mx, l, cur - 1, false, t, g4);
            if (cur >= 1) slc8_compute_lds<true>(slotB, lane, qf, O, shift, Mx, l, cur, true, t, g4);
        }
        l += __shfl_xor(l, 16); l += __shfl_xor(l, 32);
        const float inv = l > 0.f ? 1.0f / l : 0.f;
        if (col < 4) {
#pragma unroll
            for (int dt = 0; dt < 4; ++dt) { const f32x4 o = O[dt] * inv;
                *(GAS v2u*)(oslc + row * 512 + (4 * g + col) * 64 + 16 * dt + 4 * g4) = (v2u){pkc(o[0], o[1]), pkc(o[2], o[3])}; }
        }
        myidx = idx_next; nsel = nsel_next;
    }
    __syncthreads();
}
__device__ __forceinline__ void vretile8(const bf16* vrm, unsigned char* vt8, int gw, int NGW, int lane) {
    for (int it = gw; it < 4 * (SEQ / 32); it += NGW) {
        const int bg = it / (SEQ / 32), kg = it % (SEQ / 32);
        const bf16* src = vrm + ((size_t)bg * SEQ + kg * 32) * 64; unsigned char* dst = vt8 + (size_t)bg * (SEQ * 64);
#pragma unroll
        for (int g4 = 0; g4 < 4; ++g4) { float e[8];
#pragma unroll
            for (int j = 0; j < 8; ++j) { const int key = 4 * g4 + (j & 3) + 16 * (j >> 2); e[j] = __uint_as_float((unsigned)src[key * 64 + lane] << 16); }
            const v2u w = {pk4_fp8(e[0], e[1], e[2], e[3]), pk4_fp8(e[4], e[5], e[6], e[7])};
            const int dt = lane >> 4;
            *(GAS v2u*)(dst + (size_t)((kg * 2 + (dt >> 1)) * 64 + g4 * 16 + (lane & 15)) * 16 + (dt & 1) * 8) = w; }
    }
}
__device__ __forceinline__ void knorm8_pass(const unsigned char* k8, float* kn, int gw, int NGW, int lane) {
    for (int it = gw; it < 4 * (SEQ / 16); it += NGW) {
        const v4u a = *(const GAS v4u*)(k8 + (size_t)it * 1024 + lane * 16);
        float s = 0.f;
#pragma unroll
        for (int q = 0; q < 4; ++q) { const int w = (int)a[q];
            const float f0 = __builtin_amdgcn_cvt_f32_fp8(w, 0), f1 = __builtin_amdgcn_cvt_f32_fp8(w, 1), f2 = __builtin_amdgcn_cvt_f32_fp8(w, 2), f3 = __builtin_amdgcn_cvt_f32_fp8(w, 3);
            s += (f0 * f0 + f1 * f1) + (f2 * f2 + f3 * f3); }
        s += __shfl_xor(s, 16); s += __shfl_xor(s, 32);
#pragma unroll
        for (int o = 1; o < 16; o <<= 1) s = fmaxf(s, __shfl_xor(s, o));
        if (lane == 0) kn[it] = s;
    }
}

struct WinFrags { bf16x8 kf[2][2], vf[4]; };
__device__ __forceinline__ void win_load(WinFrags& f, const bf16* kb, const bf16* vb, int kg) {
#pragma unroll
    for (int tt = 0; tt < 2; ++tt)
#pragma unroll
        for (int s = 0; s < 2; ++s) f.kf[tt][s] = *(const bf16x8*)(kb + (size_t)((2 * kg + tt) * 2 + s) * 512);
#pragma unroll
    for (int dt = 0; dt < 4; ++dt) f.vf[dt] = *(const bf16x8*)(vb + (size_t)(kg * 4 + dt) * 512);
}
__device__ __forceinline__ void win_compute_fs(const WinFrags& f, const bf16x8 (&qf)[2], f32x4 (&O)[4], float shift, float& l, int kg, int t, int g4, bool edge) {
    const f32x4 zero = {0.f, 0.f, 0.f, 0.f};
    f32x4 e[2];
#pragma unroll
    for (int tt = 0; tt < 2; ++tt) { f32x4 s = mfma16(f.kf[tt][0], qf[0], zero); s = mfma16(f.kf[tt][1], qf[1], s);
#pragma unroll
        for (int r = 0; r < 4; ++r) e[tt][r] = ex2(__builtin_fmaf(s[r], C2, -shift)); }
    if (edge) {
#pragma unroll
        for (int tt = 0; tt < 2; ++tt)
#pragma unroll
            for (int r = 0; r < 4; ++r) { const int df = t - (32 * kg + 16 * tt + 4 * g4 + r); e[tt][r] = (df >= 0 && df < 512) ? e[tt][r] : 0.f; }
    }
    l += ((e[0][0] + e[0][1]) + (e[0][2] + e[0][3])) + ((e[1][0] + e[1][1]) + (e[1][2] + e[1][3]));
    const bf16x8 pf = pack8(e[0], e[1]);
#pragma unroll
    for (int dt = 0; dt < 4; ++dt) O[dt] = mfma16(f.vf[dt], pf, O[dt]);
}
__device__ __forceinline__ void win_compute_on(const WinFrags& f, const bf16x8 (&qf)[2], f32x4 (&O)[4], float& Mx, float& l, int kg, int t, int g4) {
    const f32x4 zero = {0.f, 0.f, 0.f, 0.f};
    f32x4 e[2]; float mt = -1e30f;
#pragma unroll
    for (int tt = 0; tt < 2; ++tt) { f32x4 s = mfma16(f.kf[tt][0], qf[0], zero); s = mfma16(f.kf[tt][1], qf[1], s);
#pragma unroll
        for (int r = 0; r < 4; ++r) { const int df = t - (32 * kg + 16 * tt + 4 * g4 + r); const bool valid = df >= 0 && df < 512; e[tt][r] = valid ? s[r] * C2 : -1e30f; mt = fmaxf(mt, e[tt][r]); } }
    mt = fmaxf(mt, __shfl_xor(mt, 16)); mt = fmaxf(mt, __shfl_xor(mt, 32));
    const float Mn = fmaxf(Mx, mt), alpha = ex2(Mx - Mn); Mx = Mn;
    float add = 0.f;
#pragma unroll
    for (int tt = 0; tt < 2; ++tt)
#pragma unroll
        for (int r = 0; r < 4; ++r) { const float pv = (e[tt][r] > -1e29f) ? ex2(e[tt][r] - Mn) : 0.f; e[tt][r] = pv; add += pv; }
    l = l * alpha + add;
    const bf16x8 pf = pack8(e[0], e[1]);
#pragma unroll
    for (int dt = 0; dt < 4; ++dt) O[dt] = mfma16(f.vf[dt], pf, O[dt] * alpha);
}
__device__ __forceinline__ void awin_item(const bf16* qrot, bf16* owin, const bf16* kw_t, const bf16* vw_t, const float* kwn, int bg, int qt, int lane) {
    const int col = lane & 15, g4 = lane >> 4, b = bg >> 1, g = bg & 1;
    const int t = 16 * qt + col; const size_t row = (size_t)b * SEQ + t;
    const int tlo = qt - 32 > 0 ? qt - 32 : 0, kg0 = tlo >> 1, kg1 = qt >> 1;
    const float kmx = wave_max((2 * kg0 + lane <= 2 * kg1 + 1) ? kwn[bg * (SEQ / 16) + 2 * kg0 + lane] : 0.f);
    bf16x8 qf[4][2]; float shift[4];
#pragma unroll
    for (int hh = 0; hh < 4; ++hh) { float qn = 0.f;
#pragma unroll
        for (int s = 0; s < 2; ++s) { qf[hh][s] = *(const bf16x8*)(qrot + row * 512 + (4 * g + hh) * 64 + 32 * s + 8 * g4); float f[8]; unpack8(__builtin_bit_cast(v4u, qf[hh][s]), f);
#pragma unroll
            for (int j = 0; j < 8; ++j) qn += f[j] * f[j]; }
        qn += __shfl_xor(qn, 16); qn += __shfl_xor(qn, 32);
        shift[hh] = C2 * sqrtf(qn * kmx) * 1.0001f + 1e-6f; }
    const bf16* kb = kw_t + (size_t)bg * SEQ * 64 + lane * 8; const bf16* vb = vw_t + (size_t)bg * SEQ * 64 + lane * 8;
    const f32x4 zero = {0.f, 0.f, 0.f, 0.f};
    f32x4 O[4][4]; float l[4] = {0.f, 0.f, 0.f, 0.f};
#pragma unroll
    for (int hh = 0; hh < 4; ++hh)
#pragma unroll
        for (int dt = 0; dt < 4; ++dt) O[hh][dt] = zero;
    if (!__any(shift[0] > 60.f || shift[1] > 60.f || shift[2] > 60.f || shift[3] > 60.f)) {
        WinFrags fa, fb;
        win_load(fa, kb, vb, kg0);
        for (int kg = kg0; kg <= kg1; kg += 2) {
            const bool has1 = kg + 1 <= kg1;
            if (has1) win_load(fb, kb, vb, kg + 1);
            { const bool edge = (kg <= kg0 + 1) || (kg >= kg1 - 1);
#pragma unroll
              for (int hh = 0; hh < 4; ++hh) win_compute_fs(fa, qf[hh], O[hh], shift[hh], l[hh], kg, t, g4, edge); }
            if (has1) { if (kg + 2 <= kg1) win_load(fa, kb, vb, kg + 2);
                const bool edge = (kg + 1 <= kg0 + 1) || (kg + 1 >= kg1 - 1);
#pragma unroll
                for (int hh = 0; hh < 4; ++hh) win_compute_fs(fb, qf[hh], O[hh], shift[hh], l[hh], kg + 1, t, g4, edge); }
        }
    } else {
        float Mx[4] = {-1e30f, -1e30f, -1e30f, -1e30f};
        for (int kg = kg0; kg <= kg1; ++kg) { WinFrags fa; win_load(fa, kb, vb, kg);
#pragma unroll
            for (int hh = 0; hh < 4; ++hh) win_compute_on(fa, qf[hh], O[hh], Mx[hh], l[hh], kg, t, g4); }
    }
#pragma unroll
    for (int hh = 0; hh < 4; ++hh) { float ll = l[hh]; ll += __shfl_xor(ll, 16); ll += __shfl_xor(ll, 32);
        const float inv = ll > 0.f ? 1.0f / ll : 0.f;
#pragma unroll
        for (int dt = 0; dt < 4; ++dt) { const f32x4 o = O[hh][dt] * inv;
            *(GAS v2u*)(owin + row * 512 + (4 * g + hh) * 64 + 16 * dt + 4 * g4) = (v2u){pkc(o[0], o[1]), pkc(o[2], o[3])}; } }
}

__device__ __forceinline__ void mrg_phase(const bf16* ocmp, const bf16* oslc, const bf16* owin, const float* gates, const bf16* bgp, const bf16* cgp, const bf16* xcp, const float* convw, bf16* merged, int gw, int NGW, int lane) {
    float w0[8], w1[8], w2[8];
#pragma unroll
    for (int j = 0; j < 8; ++j) { w0[j] = convw[8 * lane + j]; w1[j] = convw[512 + 8 * lane + j]; w2[j] = convw[1024 + 8 * lane + j]; }
    for (int row = gw; row < M; row += NGW) {
        const int t = row & (SEQ - 1); const size_t o = (size_t)row * 512 + 8 * lane;
        float a[8], c[8], d[8], att[8];
        unpack8(*(const GAS v4u*)(ocmp + o), a); unpack8(*(const GAS v4u*)(oslc + o), c); unpack8(*(const GAS v4u*)(owin + o), d);
        const float* gr = gates + (size_t)row * NGATE + (lane >> 3) * 3; const float g0 = gr[0], g1 = gr[1], g2 = gr[2];
        float sa = 0.f;
#pragma unroll
        for (int j = 0; j < 8; ++j) { att[j] = g0 * a[j] + g1 * c[j] + g2 * d[j]; sa += att[j] * att[j]; }
        float bgv[8], u0[8], u1[8], u2[8], tmp[8];
        unpack8(*(const GAS v4u*)(bgp + o), bgv);
        unpack8(*(const GAS v4u*)(cgp + o), u2); unpack8(*(const GAS v4u*)(xcp + o), tmp);
#pragma unroll
        for (int j = 0; j < 8; ++j) u2[j] *= tmp[j];
        if (t >= 1) { unpack8(*(const GAS v4u*)(cgp + o - 512), u1); unpack8(*(const GAS v4u*)(xcp + o - 512), tmp);
#pragma unroll
            for (int j = 0; j < 8; ++j) u1[j] *= tmp[j]; }
        else {
#pragma unroll
            for (int j = 0; j < 8; ++j) u1[j] = 0.f; }
        if (t >= 2) { unpack8(*(const GAS v4u*)(cgp + o - 1024), u0); unpack8(*(const GAS v4u*)(xcp + o - 1024), tmp);
#pragma unroll
            for (int j = 0; j < 8; ++j) u0[j] *= tmp[j]; }
        else {
#pragma unroll
            for (int j = 0; j < 8; ++j) u0[j] = 0.f; }
        float y[8]; float sc = 0.f;
#pragma unroll
        for (int j = 0; j < 8; ++j) { y[j] = bgv[j] * (w0[j] * u0[j] + w1[j] * u1[j] + w2[j] * u2[j]); sc += y[j] * y[j]; }
        sa = wave_sum(sa); sc = wave_sum(sc);
        const float ra = 1.0f / sqrtf(sa * (1.0f / 512.0f) + EPS), rc = 1.0f / sqrtf(sc * (1.0f / 512.0f) + EPS);
        v4u wa, wc;
        wa.x = pkc(att[0] * ra, att[1] * ra); wa.y = pkc(att[2] * ra, att[3] * ra); wa.z = pkc(att[4] * ra, att[5] * ra); wa.w = pkc(att[6] * ra, att[7] * ra);
        wc.x = pkc(y[0] * rc, y[1] * rc); wc.y = pkc(y[2] * rc, y[3] * rc); wc.z = pkc(y[4] * rc, y[5] * rc); wc.w = pkc(y[6] * rc, y[7] * rc);
        *(GAS v4u*)(merged + (size_t)row * DM + 8 * lane) = wa; *(GAS v4u*)(merged + (size_t)row * DM + 512 + 8 * lane) = wc;
    }
}

struct Args { const void* in[25]; float* out; unsigned char* ws; int ph_lo, ph_hi, probe, pad; };
__device__ __forceinline__ unsigned char* opaque_ptr(unsigned char* p) { GAS unsigned char* g = (GAS unsigned char*)p; asm volatile("" : "+s"(g)); return (unsigned char*)g; }
__device__ __forceinline__ int opaque_v(int v) { asm volatile("" : "+v"(v)); return v; }
__device__ __forceinline__ int opaque_s(int v) { asm volatile("" : "+s"(v)); return v; }
#define PH_LOCALS \
    unsigned char* ws = opaque_ptr(args.ws); \
    const int tid = opaque_v((int)threadIdx.x), lane = tid & 63, wave = __builtin_amdgcn_readfirstlane(tid >> 6); \
    const int G = opaque_s((int)gridDim.x), bx = opaque_s((int)blockIdx.x), vcu = (G % 8 == 0) ? (bx % 8) * (G / 8) + bx / 8 : bx, gw = vcu * NWAVES + wave, NGW = G * NWAVES; \
    (void)lane; (void)gw; (void)NGW; (void)ws; (void)bx;
#define INF(k) ((const float*)args.in[k])
#define WSP(T, off) ((T*)(ws + (off)))

__global__ void __launch_bounds__(NWAVES * 64, 2) mk_fwd(Args args) {
    extern __shared__ __attribute__((aligned(16))) unsigned char lds_raw[];
    LAS unsigned char* lds = (LAS unsigned char*)lds_raw;
    const int lo = args.ph_lo, hi = args.ph_hi;
    XcdBarrier bar; bar.bar = (unsigned*)(args.ws + WS_CTL) + CW_BAR; bar.x = 0; bar.st = nullptr;
    {
        const int tid0 = threadIdx.x;
        for (int u = tid0; u < (LDS_BYTES - RING_BYTES) / 4; u += NWAVES * 64) ((LAS unsigned*)(lds + RING_BYTES))[u] = 0u;
        __syncthreads();
        if (hi - lo > 1) bar = xcd_barrier_post((unsigned*)(args.ws + WS_CTL) + CW_BAR, (volatile LAS unsigned*)(lds + MISC_OFF) + 8);
    }
#define IN(k) (lo <= (k) && (k) < hi)
#define SEAM(k) do { if (IN(k) && IN((k) + 1)) { XcdBarrier bb_ = bar; bb_.bar = (unsigned*)opaque_ptr((unsigned char*)bar.bar); asm volatile("" : "+s"(bb_.x)); xcd_barrier(bb_); } } while (0)

    if (EN(0) && IN(0)) {
        PH_LOCALS
        In I;
        I.x = INF(0); I.pos = (const int*)args.in[1]; I.f1_pre = INF(2); I.f1_wg = INF(3); I.f1_wu = INF(4); I.f1_wd = INF(5);
        I.f1_post = INF(6); I.mix_pre = INF(7); I.w_in = INF(8); I.pe_k = INF(9); I.w1_k = INF(10); I.w2_k = INF(11);
        I.pe_v = INF(12); I.w1_v = INF(13); I.w2_v = INF(14); I.conv_w = INF(15); I.aon = INF(16); I.con = INF(17);
        I.w_out = INF(18); I.mix_post = INF(19); I.f2_pre = INF(20); I.f2_wg = INF(21); I.f2_wu = INF(22); I.f2_wd = INF(23); I.f2_post = INF(24);
        pro_weights(I, ws, (LAS float*)(lds + wave * 16384), gw, NGW, lane);
        pro_rope(I.pos, WSP(float, WS_ROPE), vcu * NWAVES * 64 + tid, G * NWAVES * 64);
        pro_x(I.x, WSP(bf16, WS_XB), WSP(float, WS_RSTD), gw, NGW, lane);
    }
    SEAM(0);

    for (int l = 0; l < NLAYER; ++l) {
        const int P = 1 + l * PH_PER_LAYER;
        if (hi <= P || lo >= P + PH_PER_LAYER) continue;
        if (EN(1) && IN(P + 0)) {
            PH_LOCALS
            pg8::Gemm g{WSP(bf16, WS_XB), WSP(const bf16, WS_W + (size_t)l * W_LAYER + WO_GU1), M, 2 * DFF, DM, DM, DM}; pg8::StaticOrder S; S.init(M, 2 * DFF, G, bx);
            pg8::EpiSwiGLU E{WSP(bf16, WS_BIG), DFF, WSP(float, WS_RSTD)};
            pg8::gemm_phase<pg8::EpiSwiGLU, pg8::StaticOrder, true, true>(lds, g, S, E);
        }
        SEAM(P + 0);
        if (EN(2) && IN(P + 1)) {
            PH_LOCALS
            pg8::Gemm g{WSP(bf16, WS_BIG), WSP(const bf16, WS_W + (size_t)l * W_LAYER + WO_D1), M, DM, DFF, DFF, DFF}; pg8::StaticOrder S; S.init(M, DM, G, bx);
            pg8::EpiBf16<0> E{WSP(bf16, WS_H), DM, nullptr, 0, 0, 1.f};
            pg8::gemm_phase<pg8::EpiBf16<0>, pg8::StaticOrder, true, true>(lds, g, S, E);
        }
        SEAM(P + 1);
        if (EN(3) && IN(P + 2)) { PH_LOCALS
            bf16* xo = args.probe ? WSP(bf16, WS_BIG) : WSP(bf16, WS_XB); float* ro = args.probe ? WSP(float, WS_BIG + 170 * MiB) : WSP(float, WS_RSTD);
            if (l == 0) rowpass<true, false>(INF(0), xo, WSP(bf16, WS_H), INF(6) + (size_t)l * DM, 0.5f, ro, gw, NGW, lane);
            else rowpass<false, false>(WSP(bf16, WS_XB), xo, WSP(bf16, WS_H), INF(6) + (size_t)l * DM, 0.5f, ro, gw, NGW, lane); }
        SEAM(P + 2);
        if (EN(4) && IN(P + 3)) {
            PH_LOCALS
            pg8::Gemm g{WSP(bf16, WS_XB), WSP(const bf16, WS_W + (size_t)l * W_LAYER + WO_IN), M, NIN, DM, DM, DM}; pg8::StaticOrder S; S.init(M, NIN, G, bx);
            pg8::EpiInProj E{ws};
            pg8::gemm_phase<pg8::EpiInProj, pg8::StaticOrder, true, true>(lds, g, S, E);
        }
        SEAM(P + 3);
        if (EN(5) && IN(P + 4)) {
            PH_LOCALS
            vretile8(WSP(bf16, WS_VS_RM), WSP(unsigned char, WS_VS_T), gw, NGW, lane); vretile(WSP(bf16, WS_VW_RM), WSP(bf16, WS_VW_T), gw, NGW, lane);
            knorm8_pass(WSP(unsigned char, WS_KS_T), WSP(float, WS_KSN), gw, NGW, lane); knorm_pass(WSP(bf16, WS_KW_T), WSP(float, WS_KWN), gw, NGW, lane);
            if (gw < 8) { const int kv = gw >> 2, c = (gw & 3) * 64 + lane; float sacc = 0.f;
                for (int kc = 0; kc < 16; ++kc) sacc += WSP(float, WS_BIASP)[(kc * 4 + l * 2 + kv) * 256 + c];
                WSP(float, WS_BIAS)[(l * 2 + kv) * 256 + c] = sacc; }
            const int ks = (bx >> 5) & 3;
            pg8::Gemm g{WSP(bf16, WS_KRAW) + ks * 512, WSP(const bf16, WS_W + (size_t)l * W_LAYER + WO_W1) + ks * 512, 8192, 512, 512, 1024, 2048}; pg8::CmpOrder S{G, bx < 128 ? (bx & 31) : (1 << 20)};
            pg8::EpiHid E{WSP(float, WS_HIDP) + (size_t)ks * 8192 * 256};
            pg8::gemm_phase<pg8::EpiHid, pg8::CmpOrder, true, true>(lds, g, S, E);
        }
        SEAM(P + 4);
        if (EN(6) && IN(P + 5)) { PH_LOCALS cmp2_phase(WSP(float, WS_HIDP), WSP(float, WS_BIAS) + l * 512, INF(11) + (size_t)l * 256 * 64, INF(14) + (size_t)l * 256 * 64, WSP(bf16, WS_KC_T), WSP(bf16, WS_VC_T), WSP(float, WS_KCN), gw, NGW, lane); }
        SEAM(P + 5);
        if (EN(7) && IN(P + 6)) {
            PH_LOCALS
            for (int p = gw; p < 2048; p += NGW) { const int bg = p >> 9, i = p & 511;
                bf16* od = args.probe ? WSP(bf16, WS_HIDP) : WSP(bf16, WS_QRAW); int* id = args.probe ? WSP(int, WS_H) : WSP(int, WS_IDX);
                acmp_item(WSP(bf16, WS_QRAW), od, WSP(bf16, WS_KC_T), WSP(bf16, WS_VC_T), id, WSP(float, WS_KCN), (LAS float*)(lds + wave * 16384), bg, i, lane);
                acmp_item(WSP(bf16, WS_QRAW), od, WSP(bf16, WS_KC_T), WSP(bf16, WS_VC_T), id, WSP(float, WS_KCN), (LAS float*)(lds + wave * 16384), bg, 1023 - i, lane); }
        }
        SEAM(P + 6);
        if (EN(9) && IN(P + 8)) { PH_LOCALS
            for (int cbg = vcu; cbg < 4 * 64; cbg += G)
                aslc8_group(WSP(bf16, WS_QROT), WSP(unsigned char, WS_KS_T), WSP(unsigned char, WS_VS_T), WSP(int, WS_IDX), WSP(bf16, WS_OSLC), WSP(float, WS_KSN), lds, cbg >> 6, cbg & 63, tid, wave, lane);
        }
        SEAM(P + 8);
        if (EN(10) && IN(P + 9)) { PH_LOCALS for (int p = gw; p < 2048; p += NGW) { const int bg = p >> 9, i = p & 511; bf16* od = args.probe ? WSP(bf16, WS_HIDP) : WSP(bf16, WS_QROT);
            awin_item(WSP(bf16, WS_QROT), od, WSP(bf16, WS_KW_T), WSP(bf16, WS_VW_T), WSP(float, WS_KWN), bg, i, lane); awin_item(WSP(bf16, WS_QROT), od, WSP(bf16, WS_KW_T), WSP(bf16, WS_VW_T), WSP(float, WS_KWN), bg, 1023 - i, lane); } }
        SEAM(P + 9);
        if (EN(11) && IN(P + 10)) { PH_LOCALS mrg_phase(WSP(bf16, WS_QRAW), WSP(bf16, WS_OSLC), WSP(bf16, WS_QROT), WSP(float, WS_GATES), WSP(bf16, WS_BG), WSP(bf16, WS_CG), WSP(bf16, WS_XC), INF(15) + (size_t)l * 3 * 512, (bf16*)args.out, gw, NGW, lane); }
        SEAM(P + 10);
        if (EN(12) && IN(P + 11)) {
            PH_LOCALS
            pg8::Gemm g{(const bf16*)args.out, WSP(const bf16, WS_W + (size_t)l * W_LAYER + WO_O), M, DM, DM, DM, DM}; pg8::StaticOrder S; S.init(M, DM, G, bx);
            pg8::EpiBf16<0> E{WSP(bf16, WS_H), DM, nullptr, 0, 0, 1.f};
            pg8::gemm_phase<pg8::EpiBf16<0>, pg8::StaticOrder, true, true>(lds, g, S, E);
        }
        SEAM(P + 11);
        if (EN(13) && IN(P + 12)) { PH_LOCALS
            bf16* xo = args.probe ? WSP(bf16, WS_BIG) : WSP(bf16, WS_XB); float* ro = args.probe ? WSP(float, WS_BIG + 170 * MiB) : WSP(float, WS_RSTD);
            rowpass<false, false>(WSP(bf16, WS_XB), xo, WSP(bf16, WS_H), INF(19) + (size_t)l * DM, 1.0f, ro, gw, NGW, lane); }
        SEAM(P + 12);
        if (EN(14) && IN(P + 13)) {
            PH_LOCALS
            pg8::Gemm g{WSP(bf16, WS_XB), WSP(const bf16, WS_W + (size_t)l * W_LAYER + WO_GU2), M, 2 * DFF, DM, DM, DM}; pg8::StaticOrder S; S.init(M, 2 * DFF, G, bx);
            pg8::EpiSwiGLU E{WSP(bf16, WS_BIG), DFF, WSP(float, WS_RSTD)};
            pg8::gemm_phase<pg8::EpiSwiGLU, pg8::StaticOrder, true, true>(lds, g, S, E);
        }
        SEAM(P + 13);
        if (EN(15) && IN(P + 14)) {
            PH_LOCALS
            pg8::Gemm g{WSP(bf16, WS_BIG), WSP(const bf16, WS_W + (size_t)l * W_LAYER + WO_D2), M, DM, DFF, DFF, DFF}; pg8::StaticOrder S; S.init(M, DM, G, bx);
            pg8::EpiBf16<0> E{WSP(bf16, WS_H), DM, nullptr, 0, 0, 1.f};
            pg8::gemm_phase<pg8::EpiBf16<0>, pg8::StaticOrder, true, true>(lds, g, S, E);
        }
        SEAM(P + 14);
        if (EN(16) && IN(P + 15)) { PH_LOCALS
            float* ro = args.probe ? WSP(float, WS_BIG + 170 * MiB) : WSP(float, WS_RSTD);
            if (l == NLAYER - 1) rowpass<false, true>(WSP(bf16, WS_XB), args.probe ? (void*)WSP(float, WS_BIG) : (void*)args.out, WSP(bf16, WS_H), INF(24) + (size_t)l * DM, 0.5f, ro, gw, NGW, lane);
            else rowpass<false, false>(WSP(bf16, WS_XB), args.probe ? WSP(bf16, WS_BIG) : WSP(bf16, WS_XB), WSP(bf16, WS_H), INF(24) + (size_t)l * DM, 0.5f, ro, gw, NGW, lane); }
        if (l != NLAYER - 1) SEAM(P + 15);
    }
#undef IN
#undef SEAM
}

extern "C" void kernel_launch(void* const* d_in, const int* in_sizes, int n_in, void* d_out, int out_size, void* d_ws, size_t ws_size, hipStream_t stream) {
    static int grid = 0;
    if (grid == 0) {
        if (n_in != 25 || out_size != M * DM || ws_size < WS_END) { fprintf(stderr, "kernel_launch: unexpected shapes (n_in %d out %d ws %zu)\n", n_in, out_size, ws_size); grid = -1; return; }
        int dev = 0, cus = 0, per_cu = 0;
        if (hipGetDevice(&dev) != hipSuccess || hipDeviceGetAttribute(&cus, hipDeviceAttributeMultiprocessorCount, dev) != hipSuccess) { grid = -1; return; }
        if (hipFuncSetAttribute((const void*)mk_fwd, hipFuncAttributeMaxDynamicSharedMemorySize, LDS_BYTES) != hipSuccess) { fprintf(stderr, "kernel_launch: hipFuncSetAttribute failed\n"); grid = -1; return; }
        if (hipOccupancyMaxActiveBlocksPerMultiprocessor(&per_cu, (const void*)mk_fwd, NWAVES * 64, LDS_BYTES) != hipSuccess || per_cu < 1) fprintf(stderr, "kernel_launch: occupancy query reports %d\n", per_cu);
        (void)hipGetLastError();
        grid = cus;
    }
    if (grid < 0) return;
    if (hipMemsetAsync((char*)d_ws + WS_CTL, 0, CTL_ZERO_BYTES, stream) != hipSuccess) return;
    Args a{};
    for (int i = 0; i < 25; ++i) a.in[i] = d_in[i];
    a.out = (float*)d_out; a.ws = (unsigned char*)d_ws;
#if MK_ONE_LAUNCH
    a.ph_lo = 0; a.ph_hi = N_PHASES;
    hipLaunchKernelGGL(mk_fwd, dim3(grid), dim3(NWAVES * 64), LDS_BYTES, stream, a);
#else
    for (int p = 0; p < N_PHASES; ++p) { a.ph_lo = p; a.ph_hi = p + 1;
#ifdef REP_MASK
        { const int k = p == 0 ? 0 : 1 + (p - 1) % PH_PER_LAYER; if (((REP_MASK) >> k) & 1) { a.probe = 1; hipLaunchKernelGGL(mk_fwd, dim3(grid), dim3(NWAVES * 64), LDS_BYTES, stream, a); a.probe = 0; } }
#endif
        hipLaunchKernelGGL(mk_fwd, dim3(grid), dim3(NWAVES * 64), LDS_BYTES, stream, a);
    }
#endif
}
```
